# Optimizing an MI355X kernel written in HIP

```python
import math
import jax, jax.numpy as jnp
from jax import lax
import numpy as np

D_MODEL = 1024
BATCH = 4
SEQ = 8192
DEPTH = 2

N_A_LAYERS = DEPTH // 2
N_B_LAYERS = DEPTH - N_A_LAYERS
HG_HEADS = 8
HG_DK = D_MODEL // HG_HEADS
HG_DV = D_MODEL // HG_HEADS
HG_KEY = HG_HEADS * HG_DK
HG_VAL = HG_HEADS * HG_DV
HG_CHUNK = 64
ATT_HEADS = 8
ATT_HD = D_MODEL // ATT_HEADS
ATT_SCALE = ATT_HD ** -0.5
MOBA_BLOCK = 256
MOBA_TOPK = 3
Q_CHUNK = 16
NUM_BUCKETS = 32
MAX_DISTANCE = 1024
N_GROUPS = 4
EXPERTS_PER_GROUP = 8
N_EXPERTS = N_GROUPS * EXPERTS_PER_GROUP
EXPERT_TOPK = 2
EXPERT_FF = D_MODEL // 2
ROW_BLOCK = 128
EPS = 1e-6

kernel_name = 'hgrn2_moba_yoco_hmoe'


def rms_norm(x, w):
    xf = x.astype(jnp.float32)
    y = xf * lax.rsqrt(jnp.mean(xf * xf, axis=-1, keepdims=True) + EPS)
    return (y * w.astype(jnp.float32)).astype(x.dtype)


def _to_chunks(t, n_heads):
    b, l, _ = t.shape
    return t.reshape(b, l // HG_CHUNK, HG_CHUNK, n_heads, -1).transpose(1, 0, 3, 2, 4)


def _gla_chunk_step(state, inp):
    q, k, v, log_f = inp
    b = jnp.cumsum(log_f, axis=2)
    causal = jnp.tril(jnp.ones((HG_CHUNK, HG_CHUNK), dtype=bool))[:, :, None]
    diff = b[:, :, :, None, :] - b[:, :, None, :, :]
    decay = jnp.where(causal, jnp.exp(jnp.where(causal, diff, 0.0)), 0.0)
    scores = jnp.einsum('bhtsd,bhsd->bhts', q[:, :, :, None, :] * decay, k)
    o = (jnp.einsum('bhts,bhsv->bhtv', scores, v)
         + jnp.einsum('bhtd,bhdv->bhtv', q * jnp.exp(b), state))
    b_last = b[:, :, -1, :]
    k_dec = k * jnp.exp(b_last[:, :, None, :] - b)
    state = jnp.exp(b_last)[..., None] * state + jnp.einsum('bhsd,bhsv->bhdv', k_dec, v)
    return state, o


def hgrn2_mixer(h, w_in, lower_bound, o_norm, w_out):
    bsz, seqlen, _ = h.shape
    proj = h @ w_in
    q, f_logit, i, g = jnp.split(proj, [HG_KEY, 2 * HG_KEY, 2 * HG_KEY + HG_VAL], axis=-1)
    lb = lower_bound.astype(jnp.float32)
    f = lb + (1.0 - lb) * jax.nn.sigmoid(f_logit.astype(jnp.float32))
    log_f = jnp.log(f)
    k = 1.0 - f
    qs = _to_chunks(q.astype(jnp.float32) * HG_DK ** -0.5, HG_HEADS)
    ks = _to_chunks(k, HG_HEADS)
    vs = _to_chunks(i.astype(jnp.float32), HG_HEADS)
    gs = _to_chunks(log_f, HG_HEADS)
    state0 = jnp.zeros((bsz, HG_HEADS, HG_DK, HG_DV), jnp.float32)
    _, o = lax.scan(_gla_chunk_step, state0, (qs, ks, vs, gs))
    o = o.transpose(1, 0, 3, 2, 4).reshape(bsz, seqlen, HG_HEADS, HG_DV)
    gate = jax.nn.silu(g.astype(jnp.float32).reshape(bsz, seqlen, HG_HEADS, HG_DV))
    o = rms_norm(o, o_norm) * gate
    return o.reshape(bsz, seqlen, HG_VAL).astype(h.dtype) @ w_out


def shared_kv(mem, kv_norm, w_kv, k_norm):
    bsz, seqlen, _ = mem.shape
    n_blocks = -(-seqlen // MOBA_BLOCK)
    pad = n_blocks * MOBA_BLOCK - seqlen
    kv = rms_norm(mem, kv_norm) @ w_kv
    k, v = jnp.split(kv, 2, axis=-1)
    k = rms_norm(k.reshape(bsz, seqlen, ATT_HEADS, ATT_HD), k_norm)
    v = v.reshape(bsz, seqlen, ATT_HEADS, ATT_HD)

    def to_blocks(t):
        t = jnp.pad(t, ((0, 0), (0, pad), (0, 0), (0, 0)))
        return t.reshape(bsz, n_blocks, MOBA_BLOCK, ATT_HEADS, ATT_HD).transpose(0, 3, 1, 2, 4)

    k_blocks = to_blocks(k)
    v_blocks = to_blocks(v)
    k_mean = jnp.mean(k_blocks.astype(jnp.float32), axis=3).astype(k.dtype)
    return k_blocks, v_blocks, k_mean


def t5_bucket(dist):
    n = jnp.maximum(dist, 0)
    max_exact = NUM_BUCKETS // 2
    log_ratio = (jnp.log(jnp.maximum(n, max_exact).astype(jnp.float32) / max_exact)
                 / math.log(MAX_DISTANCE / max_exact))
    large = max_exact + (log_ratio * (NUM_BUCKETS - max_exact)).astype(jnp.int32)
    large = jnp.minimum(large, NUM_BUCKETS - 1)
    return jnp.where(n < max_exact, n, large)


def moba_mixer(h, w_q, q_norm, w_o, k_blocks, v_blocks, k_mean, rel_bias):
    bsz, seqlen, _ = h.shape
    n_blocks = k_blocks.shape[2]
    topk = min(MOBA_TOPK, n_blocks)
    q = rms_norm((h @ w_q).reshape(bsz, seqlen, ATT_HEADS, ATT_HD), q_norm)
    q = q.transpose(0, 2, 1, 3)
    bias_tab = rel_bias.astype(jnp.float32)
    b_ix = jnp.arange(bsz)[:, None, None, None]
    h_ix = jnp.arange(ATT_HEADS)[None, :, None, None]
    key_off = jnp.arange(MOBA_BLOCK)

    def attend(c):
        start = c * Q_CHUNK
        blk = start // MOBA_BLOCK
        q_c = lax.dynamic_slice_in_dim(q, start, Q_CHUNK, axis=2)
        q_pos = start + jnp.arange(Q_CHUNK)
        gate = jnp.einsum('bhqd,bhnd->bhqn', q_c, k_mean, preferred_element_type=jnp.float32)
        gate = jnp.where(jnp.arange(n_blocks) < blk, gate, -jnp.inf)
        _, sel = lax.top_k(gate, topk)
        valid = jnp.arange(topk) < blk
        k_sel = k_blocks[b_ix, h_ix, sel]
        v_sel = v_blocks[b_ix, h_ix, sel]
        s_sel = jnp.einsum('bhqd,bhqnkd->bhqnk', q_c, k_sel,
                           preferred_element_type=jnp.float32) * ATT_SCALE
        dist_sel = q_pos[None, None, :, None, None] - (sel[..., None] * MOBA_BLOCK + key_off)
        s_sel = s_sel + bias_tab[t5_bucket(dist_sel), h_ix[..., None]]
        s_sel = jnp.where(valid[:, None], s_sel, -jnp.inf)
        k_own = lax.dynamic_index_in_dim(k_blocks, blk, axis=2, keepdims=False)
        v_own = lax.dynamic_index_in_dim(v_blocks, blk, axis=2, keepdims=False)
        s_own = jnp.einsum('bhqd,bhkd->bhqk', q_c, k_own,
                           preferred_element_type=jnp.float32) * ATT_SCALE
        dist_own = q_pos[:, None] - (blk * MOBA_BLOCK + key_off)[None, :]
        s_own = s_own + bias_tab[t5_bucket(dist_own)].transpose(2, 0, 1)
        s_own = jnp.where(dist_own >= 0, s_own, -jnp.inf)
        logits = jnp.concatenate([s_sel.reshape(bsz, ATT_HEADS, Q_CHUNK, topk * MOBA_BLOCK), s_own], axis=-1)
        p = jax.nn.softmax(logits, axis=-1).astype(v_blocks.dtype)
        p_sel = p[..., :topk * MOBA_BLOCK].reshape(bsz, ATT_HEADS, Q_CHUNK, topk, MOBA_BLOCK)
        p_own = p[..., topk * MOBA_BLOCK:]
        return (jnp.einsum('bhqnk,bhqnkd->bhqd', p_sel, v_sel)
                + jnp.einsum('bhqk,bhkd->bhqd', p_own, v_own))

    o = lax.map(attend, jnp.arange(seqlen // Q_CHUNK))
    o = o.transpose(1, 0, 3, 2, 4).reshape(bsz, seqlen, ATT_HEADS * ATT_HD)
    return o @ w_o


def hier_moe(h, w_group, b_group, w_expert, b_expert, w_in, w_out):
    bsz, seqlen, d = h.shape
    ht = h.reshape(-1, d)
    n_tok = ht.shape[0]
    g_logits = (ht @ w_group).astype(jnp.float32) + b_group.astype(jnp.float32)
    g_prob = jax.nn.softmax(g_logits, axis=-1)
    g_idx = jnp.argmax(g_logits, axis=-1)
    g_w = jnp.take_along_axis(g_prob, g_idx[:, None], axis=1)
    e_logits = ((ht @ w_expert).astype(jnp.float32) + b_expert.astype(jnp.float32)).reshape(
        n_tok, N_GROUPS, EXPERTS_PER_GROUP)
    e_logits = jnp.take_along_axis(e_logits, g_idx[:, None, None], axis=1)[:, 0]
    top_p, top_i = lax.top_k(jax.nn.softmax(e_logits, axis=-1), EXPERT_TOPK)
    weights = g_w * (top_p / jnp.sum(top_p, axis=-1, keepdims=True))
    expert_id = (g_idx[:, None] * EXPERTS_PER_GROUP + top_i).astype(jnp.int32)
    flat_id = expert_id.reshape(-1)
    flat_w = weights.reshape(-1)
    n_assign = flat_id.shape[0]
    order = jnp.argsort(flat_id)
    sorted_id = flat_id[order]
    token_of = order // EXPERT_TOPK
    counts = jnp.bincount(flat_id, length=N_EXPERTS).astype(jnp.int32)
    padded = (counts + ROW_BLOCK - 1) // ROW_BLOCK * ROW_BLOCK
    seg_start = jnp.cumsum(counts) - counts
    pad_end = jnp.cumsum(padded)
    pad_start = pad_end - padded
    dest = pad_start[sorted_id] + jnp.arange(n_assign, dtype=jnp.int32) - seg_start[sorted_id]
    n_rb = -(-n_assign // ROW_BLOCK) + N_EXPERTS
    cap = n_rb * ROW_BLOCK
    row_token = jnp.zeros((cap,), jnp.int32).at[dest].set(token_of.astype(jnp.int32))
    x_buf = ht[row_token].reshape(n_rb, ROW_BLOCK, d)
    block_expert = jnp.minimum(
        jnp.searchsorted(pad_end, jnp.arange(n_rb, dtype=jnp.int32) * ROW_BLOCK, side='right'),
        N_EXPERTS - 1)

    def expert_block(args):
        xb, e = args
        hu = xb @ w_in[e]
        return (jax.nn.silu(hu[:, :EXPERT_FF]) * hu[:, EXPERT_FF:]) @ w_out[e]

    y_buf = lax.map(expert_block, (x_buf, block_expert)).reshape(cap, d)
    y = y_buf[dest] * flat_w[order][:, None].astype(y_buf.dtype)
    out = jnp.zeros_like(ht).at[token_of].add(y)
    return out.reshape(bsz, seqlen, d)


def setup_inputs(seed: int = 0) -> dict:
    key = jax.random.key(seed)
    ks = jax.random.split(key, 24)

    def nrm(k, shape, scale):
        return jax.random.normal(k, shape, jnp.float32) * scale

    res = (2.0 * DEPTH) ** -0.5
    return {
        'x': nrm(ks[0], (BATCH, SEQ, D_MODEL), 1.0),
        'mix_norm': 1.0 + nrm(ks[1], (DEPTH, D_MODEL), 0.05),
        'ffn_norm': 1.0 + nrm(ks[2], (DEPTH, D_MODEL), 0.05),
        'hg_w_in': nrm(ks[3], (N_A_LAYERS, D_MODEL, 2 * HG_KEY + 2 * HG_VAL), D_MODEL ** -0.5),
        'hg_lb': nrm(ks[4], (N_A_LAYERS + 1, HG_KEY), 0.5),
        'hg_o_norm': 1.0 + nrm(ks[5], (N_A_LAYERS, HG_DV), 0.05),
        'hg_w_out': nrm(ks[6], (N_A_LAYERS, HG_VAL, D_MODEL), HG_VAL ** -0.5 * res),
        'kv_norm': 1.0 + nrm(ks[7], (D_MODEL,), 0.05),
        'w_kv': nrm(ks[8], (D_MODEL, 2 * ATT_HEADS * ATT_HD), D_MODEL ** -0.5),
        'k_norm': 1.0 + nrm(ks[9], (ATT_HD,), 0.05),
        'att_w_q': nrm(ks[10], (N_B_LAYERS, D_MODEL, ATT_HEADS * ATT_HD), D_MODEL ** -0.5),
        'q_norm': 1.0 + nrm(ks[11], (N_B_LAYERS, ATT_HD), 0.05),
        'att_w_o': nrm(ks[12], (N_B_LAYERS, ATT_HEADS * ATT_HD, D_MODEL), (ATT_HEADS * ATT_HD) ** -0.5 * res),
        'rel_bias': nrm(ks[13], (NUM_BUCKETS, ATT_HEADS), 0.5),
        'moe_w_group': nrm(ks[14], (DEPTH, D_MODEL, N_GROUPS), D_MODEL ** -0.5),
        'moe_b_group': nrm(ks[15], (DEPTH, N_GROUPS), 0.01),
        'moe_w_expert': nrm(ks[16], (DEPTH, D_MODEL, N_EXPERTS), D_MODEL ** -0.5),
        'moe_b_expert': nrm(ks[17], (DEPTH, N_EXPERTS), 0.01),
        'moe_w_in': nrm(ks[18], (DEPTH, N_EXPERTS, D_MODEL, 2 * EXPERT_FF), D_MODEL ** -0.5),
        'moe_w_out': nrm(ks[19], (DEPTH, N_EXPERTS, EXPERT_FF, D_MODEL), EXPERT_FF ** -0.5 * res),
    }


def reference(x, mix_norm, ffn_norm, hg_w_in, hg_lb, hg_o_norm, hg_w_out, kv_norm, w_kv, k_norm,
              att_w_q, q_norm, att_w_o, rel_bias, moe_w_group, moe_b_group, moe_w_expert,
              moe_b_expert, moe_w_in, moe_w_out):
    lower_bounds = jnp.cumsum(jax.nn.softmax(hg_lb.astype(jnp.float32), axis=0), axis=0)
    k_blocks = v_blocks = k_mean = None
    for layer in range(DEPTH):
        hmix = rms_norm(x, mix_norm[layer])
        if layer < N_A_LAYERS:
            x = x + hgrn2_mixer(hmix, hg_w_in[layer], lower_bounds[layer], hg_o_norm[layer], hg_w_out[layer])
        else:
            j = layer - N_A_LAYERS
            x = x + moba_mixer(hmix, att_w_q[j], q_norm[j], att_w_o[j], k_blocks, v_blocks, k_mean, rel_bias)
        x = x + hier_moe(rms_norm(x, ffn_norm[layer]), moe_w_group[layer], moe_b_group[layer],
                         moe_w_expert[layer], moe_b_expert[layer], moe_w_in[layer], moe_w_out[layer])
        if layer == N_A_LAYERS - 1:
            k_blocks, v_blocks, k_mean = shared_kv(x, kv_norm, w_kv, k_norm)
    return x
```

```cpp
#include <hip/hip_runtime.h>
#include <cstdio>
#include <cstdint>
#include <cmath>
#ifndef HYB_PER_PHASE
#define HYB_PER_PHASE false
#endif
#ifndef DBG_STAGE
#define DBG_STAGE 0
#endif
namespace slow {
constexpr int B = 4, L = 8192, D = 1024, T = B * L, NH = 8, HD = 128, NEXP = 32, FF = 512, NBLK = 32, BLK = 256;
constexpr int CAP = T * 2 + NEXP * 256;
constexpr float EPS = 1e-6f;

__device__ __forceinline__ float wsum(float v) {
#pragma unroll
    for (int o = 1; o < 64; o <<= 1) v += __shfl_xor(v, o);
    return v;
}
__device__ __forceinline__ float wmax(float v) {
#pragma unroll
    for (int o = 1; o < 64; o <<= 1) v = fmaxf(v, __shfl_xor(v, o));
    return v;
}
__device__ __forceinline__ int t5_bucket(int n) {
    if (n < 16) return n;
    const float lr = logf((float)n / 16.0f) / 4.1588830833596715f;
    int large = 16 + (int)(lr * 16.0f);
    return large < 31 ? large : 31;
}
__global__ void k_prep(const float* __restrict__ hg_lb, const float* __restrict__ rel_bias, float* lb, float* bias_tab) {
    const int i = blockIdx.x * blockDim.x + threadIdx.x;
    if (i < 1024) { const float a = hg_lb[i], b = hg_lb[1024 + i], m = fmaxf(a, b), ea = expf(a - m), eb = expf(b - m); lb[i] = ea / (ea + eb); }
    if (i < 8 * 1024) { const int h = i >> 10, d = i & 1023; bias_tab[i] = rel_bias[t5_bucket(d) * 8 + h]; }
}
template <int N> __global__ void k_rmsnorm(const float* __restrict__ x, const float* __restrict__ w, float* __restrict__ y, int rows) {
    const int row = blockIdx.x * (blockDim.x >> 6) + (threadIdx.x >> 6), lane = threadIdx.x & 63;
    if (row >= rows) return;
    const float* xr = x + (size_t)row * N; float* yr = y + (size_t)row * N;
    float s = 0.f;
    for (int i = lane; i < N; i += 64) { const float v = xr[i]; s += v * v; }
    s = wsum(s);
    const float r = rsqrtf(s * (1.0f / N) + EPS);
    for (int i = lane; i < N; i += 64) yr[i] = xr[i] * r * w[i];
}
__global__ void k_headnorm(const float* __restrict__ x, int ld, int col0, const float* __restrict__ w, float* __restrict__ y, int ldy) {
    const int gw = blockIdx.x * (blockDim.x >> 6) + (threadIdx.x >> 6), lane = threadIdx.x & 63;
    if (gw >= T * NH) return;
    const int t = gw >> 3, h = gw & 7;
    const float* xr = x + (size_t)t * ld + col0 + h * HD;
    const float a = xr[lane], b = xr[lane + 64];
    const float s = wsum(a * a + b * b);
    const float r = rsqrtf(s * (1.0f / HD) + EPS);
    float* yr = y + (size_t)t * ldy + h * HD;
    yr[lane] = a * r * w[lane]; yr[lane + 64] = b * r * w[lane + 64];
}
struct GemmP {
    const float* A; int lda; const int* arow;
    const float* W; int ldw; size_t wstride; const int* tile_e;
    float* C; int ldc; const int* crow; const float* cscale; const float* R;
    int M, N, K, pad;
};
__global__ __launch_bounds__(256) void k_gemm(GemmP p) {
    __shared__ float As[16][68];
    __shared__ float Ws[16][68];
    const int tm = blockIdx.y, tn = blockIdx.x, tid = threadIdx.x;
    int e = 0;
    if (p.tile_e) { e = p.tile_e[tm]; if (e < 0) return; }
    const float* W = p.W + (size_t)e * p.wstride;
    const int ar = tid >> 2, ak = (tid & 3) * 4;
    const int wk = tid >> 4, wn = (tid & 15) * 4;
    const int m0 = tm * 64, n0 = tn * 64;
    int arow = m0 + ar; if (p.arow) { arow = p.arow[m0 + ar]; if (arow < 0) arow = 0; }
    const float* Ap = p.A + (size_t)arow * p.lda + ak;
    const float* Wp = W + (size_t)wk * p.ldw + n0 + wn;
    const int ty = tid >> 4, tx = tid & 15;
    float acc[4][4];
#pragma unroll
    for (int i = 0; i < 4; ++i)
#pragma unroll
        for (int j = 0; j < 4; ++j) acc[i][j] = 0.f;
    for (int k0 = 0; k0 < p.K; k0 += 16) {
        const float4 av = *(const float4*)(Ap + k0);
        const float4 wv = *(const float4*)(Wp + (size_t)k0 * p.ldw);
        __syncthreads();
        As[ak + 0][ar] = av.x; As[ak + 1][ar] = av.y; As[ak + 2][ar] = av.z; As[ak + 3][ar] = av.w;
        *(float4*)&Ws[wk][wn] = wv;
        __syncthreads();
#pragma unroll
        for (int kk = 0; kk < 16; ++kk) {
            const float4 a = *(const float4*)&As[kk][ty * 4];
            const float4 b = *(const float4*)&Ws[kk][tx * 4];
            const float aa[4] = {a.x, a.y, a.z, a.w}, bb[4] = {b.x, b.y, b.z, b.w};
#pragma unroll
            for (int i = 0; i < 4; ++i)
#pragma unroll
                for (int j = 0; j < 4; ++j) acc[i][j] += aa[i] * bb[j];
        }
    }
#pragma unroll
    for (int i = 0; i < 4; ++i) {
        const int m = m0 + ty * 4 + i;
        int cr = m; float sc = 1.f;
        if (p.crow) { cr = p.crow[m]; if (cr < 0) continue; }
        if (p.cscale) sc = p.cscale[cr];
        float* Cp = p.C + (size_t)cr * p.ldc + n0 + tx * 4;
        float4 o = make_float4(acc[i][0] * sc, acc[i][1] * sc, acc[i][2] * sc, acc[i][3] * sc);
        if (p.R) { const float4 r = *(const float4*)(p.R + (size_t)cr * p.ldc + n0 + tx * 4); o.x += r.x; o.y += r.y; o.z += r.z; o.w += r.w; }
        *(float4*)Cp = o;
    }
}
__global__ void k_hg_gates(float* proj, const float* __restrict__ lb) {
    const size_t i = (size_t)blockIdx.x * blockDim.x + threadIdx.x;
    if (i >= (size_t)T * 1024) return;
    const size_t t = i >> 10; const int c = (int)(i & 1023);
    float* row = proj + t * 4096;
    row[c] *= 0.08838834764831845f;
    const float l = lb[c], z = row[1024 + c];
    row[1024 + c] = l + (1.f - l) * (1.f / (1.f + expf(-z)));
}
__global__ __launch_bounds__(128) void k_gla(const float* __restrict__ proj, float* __restrict__ o) {
    const int bh = blockIdx.x, b = bh >> 3, h = bh & 7, dv = threadIdx.x;
    float S[128];
#pragma unroll
    for (int d = 0; d < 128; ++d) S[d] = 0.f;
    const float* base = proj + (size_t)b * L * 4096 + h * 128;
    for (int t = 0; t < L; ++t) {
        const float* row = base + (size_t)t * 4096;
        const float v = row[2048 + dv];
        float acc = 0.f;
#pragma unroll
        for (int d = 0; d < 128; ++d) { const float f = row[1024 + d], q = row[d]; S[d] = f * S[d] + (1.f - f) * v; acc += q * S[d]; }
        o[((size_t)b * L + t) * 1024 + h * 128 + dv] = acc;
    }
}
__global__ void k_onorm_gate(const float* __restrict__ o, const float* __restrict__ proj, const float* __restrict__ w, float* __restrict__ og) {
    const int gw = blockIdx.x * (blockDim.x >> 6) + (threadIdx.x >> 6), lane = threadIdx.x & 63;
    if (gw >= T * NH) return;
    const int t = gw >> 3, h = gw & 7;
    const float* xr = o + (size_t)t * 1024 + h * HD;
    const float a = xr[lane], b = xr[lane + 64];
    const float r = rsqrtf(wsum(a * a + b * b) * (1.0f / HD) + EPS);
    const float* g = proj + (size_t)t * 4096 + 3072 + h * HD;
    const float g0 = g[lane], g1 = g[lane + 64];
    float* yr = og + (size_t)t * 1024 + h * HD;
    yr[lane] = a * r * w[lane] * (g0 / (1.f + expf(-g0)));
    yr[lane + 64] = b * r * w[lane + 64] * (g1 / (1.f + expf(-g1)));
}
__global__ void k_route(const float* __restrict__ h2, const float* __restrict__ wg, const float* __restrict__ bg, const float* __restrict__ we, const float* __restrict__ be,
                        int* cnt, int* list, float* wgt) {
    const int t = blockIdx.x * (blockDim.x >> 6) + (threadIdx.x >> 6), lane = threadIdx.x & 63;
    if (t >= T) return;
    const float* xr = h2 + (size_t)t * D;
    float acc = 0.f;
    const bool isg = lane < 4, ise = lane >= 32;
    for (int k = 0; k < D; ++k) {
        const float xv = xr[k];
        float w = 0.f;
        if (isg) w = wg[k * 4 + lane]; else if (ise) w = we[k * 32 + (lane - 32)];
        acc += xv * w;
    }
    if (isg) acc += bg[lane]; else if (ise) acc += be[lane - 32];
    float gl[4];
#pragma unroll
    for (int i = 0; i < 4; ++i) gl[i] = __shfl(acc, i);
    int gi = 0; float gm = gl[0];
#pragma unroll
    for (int i = 1; i < 4; ++i) if (gl[i] > gm) { gm = gl[i]; gi = i; }
    float gs = 0.f;
#pragma unroll
    for (int i = 0; i < 4; ++i) gs += expf(gl[i] - gm);
    const float gw_ = 1.0f / gs;
    float el[8];
#pragma unroll
    for (int i = 0; i < 8; ++i) el[i] = __shfl(acc, 32 + gi * 8 + i);
    int i0 = 0; float m0 = el[0];
#pragma unroll
    for (int i = 1; i < 8; ++i) if (el[i] > m0) { m0 = el[i]; i0 = i; }
    int i1 = -1; float m1 = -INFINITY;
#pragma unroll
    for (int i = 0; i < 8; ++i) if (i != i0 && el[i] > m1) { m1 = el[i]; i1 = i; }
    const float p1 = expf(m1 - m0);
    const float w0 = gw_ / (1.f + p1), w1 = gw_ * p1 / (1.f + p1);
    if (lane == 0) {
        const int e0 = gi * 8 + i0, e1 = gi * 8 + i1;
        const int r0 = atomicAdd(&cnt[e0], 1); list[(size_t)e0 * (2 * T) + r0] = t * 2;     wgt[t * 2] = w0;
        const int r1 = atomicAdd(&cnt[e1], 1); list[(size_t)e1 * (2 * T) + r1] = t * 2 + 1; wgt[t * 2 + 1] = w1;
    }
}
__global__ void k_moe_rows(const int* __restrict__ cnt, const int* __restrict__ list, int* row_src, int* row_dst, int* tile_e) {
    const int r = blockIdx.x * blockDim.x + threadIdx.x;
    if (r >= CAP) return;
    int start = 0, e = -1, rank = 0;
    for (int i = 0; i < NEXP; ++i) { const int c = cnt[i], pc = (c + 255) & ~255; if (r >= start && r < start + pc) { e = i; rank = r - start; } start += pc; }
    int src = -1, dst = -1;
    if (e >= 0 && rank < cnt[e]) { dst = list[(size_t)e * (2 * T) + rank]; src = dst >> 1; }
    row_src[r] = src; row_dst[r] = dst;
    if ((r & 63) == 0) tile_e[r >> 6] = e;
}
__global__ void k_silu_mul(const float* __restrict__ hu, float* __restrict__ act) {
    const size_t i = (size_t)blockIdx.x * blockDim.x + threadIdx.x;
    if (i >= (size_t)CAP * FF) return;
    const size_t r = i / FF; const int c = (int)(i % FF);
    const float a = hu[r * 1024 + c], b = hu[r * 1024 + 512 + c];
    act[i] = a / (1.f + expf(-a)) * b;
}
__global__ void k_combine(float* x, const float* __restrict__ ybuf) {
    const size_t i = (size_t)blockIdx.x * blockDim.x + threadIdx.x;
    if (i >= (size_t)T * D) return;
    const size_t t = i >> 10; const int c = (int)(i & 1023);
    x[i] += ybuf[(t * 2) * D + c] + ybuf[(t * 2 + 1) * D + c];
}
__global__ void k_kv_split(const float* __restrict__ kv, const float* __restrict__ knw, float* __restrict__ K, float* __restrict__ V) {
    const int gw = blockIdx.x * (blockDim.x >> 6) + (threadIdx.x >> 6), lane = threadIdx.x & 63;
    if (gw >= T * NH) return;
    const int t = gw >> 3, h = gw & 7, b = t / L, pos = t % L;
    const float* kr = kv + (size_t)t * 2048 + h * HD;
    const float a = kr[lane], c = kr[lane + 64];
    const float r = rsqrtf(wsum(a * a + c * c) * (1.0f / HD) + EPS);
    const size_t o = (((size_t)b * NH + h) * L + pos) * HD;
    K[o + lane] = a * r * knw[lane]; K[o + lane + 64] = c * r * knw[lane + 64];
    V[o + lane] = kr[1024 + lane]; V[o + lane + 64] = kr[1024 + lane + 64];
}
__global__ void k_kmean(const float* __restrict__ K, float* __restrict__ km) {
    const int bhn = blockIdx.x, d = threadIdx.x;
    const float* p = K + (size_t)bhn * BLK * HD + d;
    float s = 0.f;
    for (int j = 0; j < BLK; ++j) s += p[(size_t)j * HD];
    km[(size_t)bhn * HD + d] = s * (1.0f / BLK);
}
__global__ __launch_bounds__(256) void k_moba(const float* __restrict__ q, const float* __restrict__ K, const float* __restrict__ V, const float* __restrict__ km,
                                              const float* __restrict__ bias_tab, float* __restrict__ att, int* __restrict__ sel_out, const int* __restrict__ sel_in) {
    __shared__ float qs[128];
    __shared__ float gate[32];
    __shared__ int selb[4];
    __shared__ float lg[4][256];
    __shared__ float red[8];
    __shared__ float osum[128];
    const int bid = blockIdx.x, t = bid >> 3, h = bid & 7, b = t / L, pos = t % L, blk = pos >> 8, tid = threadIdx.x, lane = tid & 63, wv = tid >> 6;
    if (tid < 128) qs[tid] = q[(size_t)t * 1024 + h * HD + tid];
    __syncthreads();
    const size_t bh = (size_t)b * NH + h;
    if (tid < 32) {
        float g = -INFINITY;
        if (tid < blk) { const float* kp = km + (bh * NBLK + tid) * HD; float s = 0.f; for (int d = 0; d < HD; ++d) s += qs[d] * kp[d]; g = s; }
        gate[tid] = g;
    }
    __syncthreads();
    const int nsel = blk < 3 ? blk : 3;
    if (tid == 0 && sel_in) { selb[0] = sel_in[(size_t)bid * 3 + 0]; selb[1] = sel_in[(size_t)bid * 3 + 1]; selb[2] = sel_in[(size_t)bid * 3 + 2]; selb[3] = blk; }
    if (tid == 0 && !sel_in) {
        int u0 = -1, u1 = -1;
        for (int s = 0; s < 3; ++s) {
            int bi = -1; float bv = -INFINITY;
            for (int n = 0; n < blk; ++n) { if (n == u0 || n == u1) continue; if (bi < 0 || gate[n] > bv) { bv = gate[n]; bi = n; } }
            selb[s] = bi; if (s == 0) u0 = bi; else if (s == 1) u1 = bi;
        }
        selb[3] = blk;
        if (sel_out) { sel_out[(size_t)bid * 3 + 0] = selb[0]; sel_out[(size_t)bid * 3 + 1] = selb[1]; sel_out[(size_t)bid * 3 + 2] = selb[2]; }
    }
    __syncthreads();
    const float scale = 0.08838834764831845f;
    float mx = -INFINITY;
    for (int s = 0; s < 4; ++s) {
        float l = -INFINITY;
        const bool on = (s == 3) || (s < nsel);
        if (on) {
            const int kb = selb[s], kpos = kb * BLK + tid, dist = pos - kpos;
            if (dist >= 0) {
                const float* kp = K + (bh * L + kpos) * HD; float a = 0.f;
                for (int d = 0; d < HD; ++d) a += qs[d] * kp[d];
                l = a * scale + bias_tab[h * 1024 + (dist < 1023 ? dist : 1023)];
            }
        }
        lg[s][tid] = l; mx = fmaxf(mx, l);
    }
    mx = wmax(mx); if (lane == 0) red[wv] = mx; __syncthreads();
    mx = fmaxf(fmaxf(red[0], red[1]), fmaxf(red[2], red[3])); __syncthreads();
    float sm = 0.f;
    for (int s = 0; s < 4; ++s) { const float l = lg[s][tid]; const float p = (l == -INFINITY) ? 0.f : expf(l - mx); lg[s][tid] = p; sm += p; }
    sm = wsum(sm); if (lane == 0) red[4 + wv] = sm; __syncthreads();
    sm = red[4] + red[5] + red[6] + red[7];
    const int d = tid & 127, half = tid >> 7;
    float o = 0.f;
    for (int s = 0; s < 4; ++s) {
        const bool on = (s == 3) || (s < nsel);
        if (!on) continue;
        const float* vp = V + (bh * L + (size_t)selb[s] * BLK + half * 128) * HD + d;
        for (int j = 0; j < 128; ++j) o += lg[s][half * 128 + j] * vp[(size_t)j * HD];
    }
    if (half == 1) osum[d] = o;
    __syncthreads();
    if (half == 0) att[(size_t)t * 1024 + h * HD + d] = (o + osum[d]) / sm;
}

struct Bufs {
    float *lb, *bias_tab, *wgt, *km; int *cnt, *list, *row_src, *row_dst, *tile_e, *sel;
    float *HN, *BIG, *O;
};
constexpr size_t MiB = 1u << 20;
static void launch_gemm(hipStream_t s, GemmP p) { dim3 g(p.N / 64, p.M / 64); hipLaunchKernelGGL(k_gemm, g, dim3(256), 0, s, p); }

static void moe_layer(hipStream_t s, const Bufs& bf, float* X, int layer, void* const* d_in) {
    const float* ffn_norm = (const float*)d_in[2] + layer * D;
    const float* wg = (const float*)d_in[14] + (size_t)layer * D * 4;  const float* bg = (const float*)d_in[15] + layer * 4;
    const float* we = (const float*)d_in[16] + (size_t)layer * D * 32; const float* be = (const float*)d_in[17] + layer * 32;
    const float* win = (const float*)d_in[18] + (size_t)layer * NEXP * D * 1024;
    const float* wout = (const float*)d_in[19] + (size_t)layer * NEXP * FF * D;
    float* HU = bf.BIG;
    float* ACT = bf.BIG + (size_t)CAP * 1024;
    float* YB = bf.O;
    hipLaunchKernelGGL(k_rmsnorm<1024>, dim3(T / 4), dim3(256), 0, s, X, ffn_norm, bf.HN, T);
    (void)hipMemsetAsync(bf.cnt, 0, 32 * sizeof(int), s);
    hipLaunchKernelGGL(k_route, dim3(T / 4), dim3(256), 0, s, bf.HN, wg, bg, we, be, bf.cnt, bf.list, bf.wgt);
    hipLaunchKernelGGL(k_moe_rows, dim3((CAP + 255) / 256), dim3(256), 0, s, bf.cnt, bf.list, bf.row_src, bf.row_dst, bf.tile_e);
    GemmP p1{}; p1.A = bf.HN; p1.lda = D; p1.arow = bf.row_src; p1.W = win; p1.ldw = 1024; p1.wstride = (size_t)D * 1024; p1.tile_e = bf.tile_e;
    p1.C = HU; p1.ldc = 1024; p1.M = CAP; p1.N = 1024; p1.K = D; launch_gemm(s, p1);
    hipLaunchKernelGGL(k_silu_mul, dim3((unsigned)(((size_t)CAP * FF + 255) / 256)), dim3(256), 0, s, HU, ACT);
    GemmP p2{}; p2.A = ACT; p2.lda = FF; p2.W = wout; p2.ldw = D; p2.wstride = (size_t)FF * D; p2.tile_e = bf.tile_e;
    p2.C = YB; p2.ldc = D; p2.crow = bf.row_dst; p2.cscale = bf.wgt; p2.M = CAP; p2.N = D; p2.K = FF; launch_gemm(s, p2);
    hipLaunchKernelGGL(k_combine, dim3((unsigned)(((size_t)T * D + 255) / 256)), dim3(256), 0, s, X, YB);
}

static Bufs make_bufs(unsigned char* ws) {
    Bufs bf;
    bf.cnt = (int*)(ws + 0); bf.lb = (float*)(ws + 4096); bf.bias_tab = (float*)(ws + 8192);
    bf.wgt = (float*)(ws + 1 * MiB); bf.km = (float*)(ws + 2 * MiB);
    bf.row_src = (int*)(ws + 3 * MiB); bf.row_dst = (int*)(ws + 4 * MiB); bf.tile_e = (int*)(ws + 5 * MiB);
    bf.sel = (int*)(ws + 6 * MiB);
    bf.list = (int*)(ws + 16 * MiB);
    bf.HN = (float*)(ws + 32 * MiB);
    bf.BIG = (float*)(ws + 160 * MiB);
    bf.O = (float*)(ws + 672 * MiB);
    return bf;
}
static void stage1(void* const* d_in, float* X, unsigned char* ws, hipStream_t s) {
    Bufs bf = make_bufs(ws);
    const float* x = (const float*)d_in[0]; const float* mix_norm = (const float*)d_in[1];
    const float* hg_w_in = (const float*)d_in[3]; const float* hg_lb = (const float*)d_in[4]; const float* hg_o_norm = (const float*)d_in[5]; const float* hg_w_out = (const float*)d_in[6];
    hipLaunchKernelGGL(k_prep, dim3(32), dim3(256), 0, s, hg_lb, (const float*)d_in[13], bf.lb, bf.bias_tab);
    hipLaunchKernelGGL(k_rmsnorm<1024>, dim3(T / 4), dim3(256), 0, s, x, mix_norm, bf.HN, T);
    float* PROJ = bf.BIG;
    { GemmP p{}; p.A = bf.HN; p.lda = D; p.W = hg_w_in; p.ldw = 4096; p.C = PROJ; p.ldc = 4096; p.M = T; p.N = 4096; p.K = D; launch_gemm(s, p); }
    hipLaunchKernelGGL(k_hg_gates, dim3((unsigned)(((size_t)T * 1024 + 255) / 256)), dim3(256), 0, s, PROJ, bf.lb);
    hipLaunchKernelGGL(k_gla, dim3(B * NH), dim3(128), 0, s, PROJ, bf.O);
    hipLaunchKernelGGL(k_onorm_gate, dim3(T * NH / 4), dim3(256), 0, s, bf.O, PROJ, hg_o_norm, bf.HN);
    { GemmP p{}; p.A = bf.HN; p.lda = D; p.W = hg_w_out; p.ldw = D; p.C = X; p.ldc = D; p.R = x; p.M = T; p.N = D; p.K = D; launch_gemm(s, p); }
}
static void stage_moe(void* const* d_in, float* X, unsigned char* ws, hipStream_t s, int layer) { Bufs bf = make_bufs(ws); moe_layer(s, bf, X, layer, d_in); }
__global__ void k_add(float* x, const float* __restrict__ y, size_t n) { for (size_t i = (size_t)blockIdx.x * blockDim.x + threadIdx.x; i < n; i += (size_t)gridDim.x * blockDim.x) x[i] += y[i]; }
static void stage3(void* const* d_in, float* X, unsigned char* ws, hipStream_t s, const int* sel_in = nullptr, float* branch_out = nullptr) {
    Bufs bf = make_bufs(ws);
    const float* mix_norm = (const float*)d_in[1];
    const float* kv_norm = (const float*)d_in[7]; const float* w_kv = (const float*)d_in[8]; const float* k_norm = (const float*)d_in[9];
    const float* att_w_q = (const float*)d_in[10]; const float* q_norm = (const float*)d_in[11]; const float* att_w_o = (const float*)d_in[12]; const float* rel_bias = (const float*)d_in[13];
    hipLaunchKernelGGL(k_prep, dim3(32), dim3(256), 0, s, (const float*)d_in[4], rel_bias, bf.lb, bf.bias_tab);
    hipLaunchKernelGGL(k_rmsnorm<1024>, dim3(T / 4), dim3(256), 0, s, X, kv_norm, bf.HN, T);
    float* KV = bf.BIG; float* Kb = bf.BIG + (size_t)T * 2048; float* Vb = Kb + (size_t)T * 1024;
    { GemmP p{}; p.A = bf.HN; p.lda = D; p.W = w_kv; p.ldw = 2048; p.C = KV; p.ldc = 2048; p.M = T; p.N = 2048; p.K = D; launch_gemm(s, p); }
    hipLaunchKernelGGL(k_kv_split, dim3(T * NH / 4), dim3(256), 0, s, KV, k_norm, Kb, Vb);
    hipLaunchKernelGGL(k_kmean, dim3(B * NH * NBLK), dim3(128), 0, s, Kb, bf.km);
    hipLaunchKernelGGL(k_rmsnorm<1024>, dim3(T / 4), dim3(256), 0, s, X, mix_norm + D, bf.HN, T);
    float* Q = bf.BIG; float* ATT = bf.BIG + (size_t)T * 1024;
    { GemmP p{}; p.A = bf.HN; p.lda = D; p.W = att_w_q; p.ldw = D; p.C = Q; p.ldc = D; p.M = T; p.N = D; p.K = D; launch_gemm(s, p); }
    hipLaunchKernelGGL(k_headnorm, dim3(T * NH / 4), dim3(256), 0, s, Q, D, 0, q_norm, Q, D);
    hipLaunchKernelGGL(k_moba, dim3(T * NH), dim3(256), 0, s, Q, Kb, Vb, bf.km, bf.bias_tab, ATT, bf.sel, sel_in);
    if (branch_out) { GemmP p{}; p.A = ATT; p.lda = D; p.W = att_w_o; p.ldw = D; p.C = branch_out; p.ldc = D; p.M = T; p.N = D; p.K = D; launch_gemm(s, p);
        hipLaunchKernelGGL(k_add, dim3(4096), dim3(256), 0, s, X, (const float*)branch_out, (size_t)T * D); }
    else { GemmP p{}; p.A = ATT; p.lda = D; p.W = att_w_o; p.ldw = D; p.C = X; p.ldc = D; p.R = X; p.M = T; p.N = D; p.K = D; launch_gemm(s, p); }
}
}
namespace dbg {
__device__ __forceinline__ unsigned f2bf(float f) { unsigned u = __builtin_bit_cast(unsigned, f); return (u + 0x7fffu + ((u >> 16) & 1u)) >> 16; }
__global__ void k_store(const float* __restrict__ a, const float* __restrict__ b, unsigned short* __restrict__ out, size_t n) {
    for (size_t i = (size_t)blockIdx.x * blockDim.x + threadIdx.x; i < n; i += (size_t)gridDim.x * blockDim.x) out[i] = (unsigned short)f2bf(a[i] - b[i]);
}
__global__ void k_cmp(const unsigned short* __restrict__ fb, const float* __restrict__ s1, const float* __restrict__ s2, int mode, double* acc, size_t n) {
    double num = 0.0, den = 0.0;
    for (size_t i = (size_t)blockIdx.x * blockDim.x + threadIdx.x; i < n; i += (size_t)gridDim.x * blockDim.x) {
        float sl;
        if (mode == 0) sl = s1[i] - s2[i];
        else if (mode == 1) { const size_t t = i >> 10, c = i & 1023; sl = s1[(2 * t) * 1024 + c] + s1[(2 * t + 1) * 1024 + c]; }
        else sl = s1[i];
        const float f = __builtin_bit_cast(float, (unsigned)fb[i] << 16);
        const double d = (double)f - (double)sl; num += d * d; den += (double)sl * (double)sl;
    }
    for (int o = 32; o >= 1; o >>= 1) { num += __shfl_xor(num, o); den += __shfl_xor(den, o); }
    if ((threadIdx.x & 63) == 0) { atomicAdd(acc, num); atomicAdd(acc + 1, den); }
}
__global__ void k_scale(float* out, const double* acc, size_t n) {
    const float f = 1.0f + (float)sqrt(acc[0] / acc[1]);
    for (size_t i = (size_t)blockIdx.x * blockDim.x + threadIdx.x; i < n; i += (size_t)gridDim.x * blockDim.x) out[i] *= f;
}
}
namespace fk {
constexpr int B = 4, L = 8192, D = 1024, T = B * L, NH = 8, HD = 128, NEXP = 32, FF = 512, NBLK = 32, BLK = 256;
constexpr float EPS = 1e-6f;
#define LAS __attribute__((address_space(3)))
#define GAS __attribute__((address_space(1)))
typedef unsigned short bf16_t;
typedef short bf16x8 __attribute__((ext_vector_type(8)));
typedef short bf16x4 __attribute__((ext_vector_type(4)));
typedef float f32x4 __attribute__((ext_vector_type(4)));
typedef float f32x2 __attribute__((ext_vector_type(2)));
typedef unsigned u32x4 __attribute__((ext_vector_type(4)));
typedef unsigned u32x2 __attribute__((ext_vector_type(2)));
#define LDS_WAIT() asm volatile("s_waitcnt lgkmcnt(0)" ::: "memory")
#define VM_WAIT() asm volatile("s_waitcnt vmcnt(0)" ::: "memory")
__device__ __forceinline__ unsigned f2bf(float f) { unsigned u = __builtin_bit_cast(unsigned, f); return (u + 0x7fffu + ((u >> 16) & 1u)) >> 16; }
__device__ __forceinline__ unsigned pk2(float lo, float hi) { return f2bf(lo) | (f2bf(hi) << 16); }
__device__ __forceinline__ float bf_lo(unsigned u) { return __builtin_bit_cast(float, u << 16); }
__device__ __forceinline__ float bf_hi(unsigned u) { return __builtin_bit_cast(float, u & 0xffff0000u); }
__device__ __forceinline__ float wave_sum(float v) {
#pragma unroll
    for (int o = 1; o < 64; o <<= 1) v += __shfl_xor(v, o);
    return v;
}
__device__ __forceinline__ float sigmoidf_(float z) { return 1.0f / (1.0f + __expf(-z)); }

#define XB_TMO      128
#define XB_XCNT(j)  (256  + 64 * (j))
#define XB_XSUB(j)  (1280 + 64 * (j))
#define XB_XGEN(j)  (2304 + 64 * (j))
#define XB_TOP      3328
#define XB_TOPGEN   3392
#define XCD_BAR_WORDS 3456
#define XB_SPIN_CAP (1u << 18)
__device__ __forceinline__ unsigned xb_ld(unsigned* p)              { return __hip_atomic_load(p, __ATOMIC_RELAXED, __HIP_MEMORY_SCOPE_AGENT); }
__device__ __forceinline__ unsigned xb_add(unsigned* p, unsigned v) { return __hip_atomic_fetch_add(p, v, __ATOMIC_RELAXED, __HIP_MEMORY_SCOPE_AGENT); }
__device__ __forceinline__ unsigned xb_xcc_id() { return (unsigned)__builtin_amdgcn_s_getreg((3 << 11) | 20) & 0xFu; }
#define XB_SPIN(cond, bar) do { unsigned _sp = 0; while (cond) { __builtin_amdgcn_s_sleep(1); \
    if ((++_sp & 255u) == 0u) { if (xb_ld(&(bar)[XB_TMO])) break; if (_sp > XB_SPIN_CAP) { atomicAdd(&(bar)[XB_TMO], 1u); break; } } } } while (0)
struct XcdBarrier { unsigned* bar; unsigned x; volatile LAS unsigned* st; };
__device__ __forceinline__ XcdBarrier xcd_barrier_post(unsigned* bar, volatile LAS unsigned* st) {
    XcdBarrier b; b.bar = bar; b.x = xb_xcc_id(); b.st = st;
    if (threadIdx.x == 0) (void)xb_add(&bar[XB_XCNT(b.x)], 1u);
    return b;
}
__device__ __forceinline__ void xcd_barrier_complete(unsigned* bar, unsigned x, unsigned& nloc, unsigned& nx) {
    const unsigned G = gridDim.x * gridDim.y * gridDim.z;
    unsigned sum, cnt, mine, sp = 0u;
    for (;;) {
        sum = 0u; cnt = 0u; mine = 0u;
#pragma unroll
        for (unsigned j = 0; j < 16; ++j) { const unsigned c = xb_ld(&bar[XB_XCNT(j)]); sum += c; cnt += (c > 0u) ? 1u : 0u; mine = (j == x) ? c : mine; }
        if (sum == G) break;
        __builtin_amdgcn_s_sleep(1);
        if ((++sp & 255u) == 0u) { if (xb_ld(&bar[XB_TMO])) break; if (sp > XB_SPIN_CAP) { atomicAdd(&bar[XB_TMO], 1u); break; } }
    }
    nloc = mine > 0u ? mine : 1u; nx = cnt > 0u ? cnt : 1u;
}
__device__ __forceinline__ void xcd_barrier(const XcdBarrier& b) {
    asm volatile("s_waitcnt vmcnt(0)" ::: "memory");
    __syncthreads();
    if (threadIdx.x == 0) {
        unsigned* bar = b.bar;
        __builtin_amdgcn_s_waitcnt(0);
        unsigned nloc = b.st[0], nx = b.st[1];
        if (nloc == 0u) { xcd_barrier_complete(bar, b.x, nloc, nx); b.st[0] = nloc; b.st[1] = nx; }
        const unsigned old = xb_add(&bar[XB_XSUB(b.x)], 1u);
        const unsigned gen = old / nloc;
        if (old + 1u == (gen + 1u) * nloc) {
            __builtin_amdgcn_fence(__ATOMIC_RELEASE, "agent");
            asm volatile("s_waitcnt vmcnt(0)" ::: "memory");
            const unsigned og = xb_add(&bar[XB_TOP], 1u);
            const unsigned tg = og / nx;
            if (og + 1u == (tg + 1u) * nx) xb_add(&bar[XB_TOPGEN], 1u);
            else XB_SPIN(xb_ld(&bar[XB_TOPGEN]) == tg, bar);
            __builtin_amdgcn_fence(__ATOMIC_ACQUIRE, "agent");
            xb_add(&bar[XB_XGEN(b.x)], 1u);
            asm volatile("s_waitcnt vmcnt(0)" ::: "memory");
        } else {
            XB_SPIN(xb_ld(&bar[XB_XGEN(b.x)]) == gen, bar);
            __builtin_amdgcn_fence(__ATOMIC_ACQUIRE, "agent");
            asm volatile("s_waitcnt vmcnt(0)" ::: "memory");
        }
    }
    __syncthreads();
}

constexpr int BM = 256, BK = 64, HALF = 128, HTB = HALF * BK * 2, STAGE_BYTES = 8 * HTB, NXCD = 8, WGM = 8;
__host__ __device__ __forceinline__ int lds_byte(int r, int c) { const int st = (r >> 4) * 2 + (c >> 5), rr = r & 15, cc = c & 31, ob = rr * 64 + cc * 2; return st * 1024 + (ob ^ (((ob >> 9) & 1) << 5)); }
__host__ __device__ __forceinline__ void stage_rc(int b, int& R, int& C) { const int st = b / 1024, sb = b % 1024, swz = sb ^ (((sb >> 9) & 1) << 5); R = (st >> 1) * 16 + swz / 64; C = (st & 1) * 32 + (swz % 64) / 2; }
__host__ __device__ __forceinline__ int perm32(int rho) { const int n = rho >> 4, i = rho & 15; return 8 * (i >> 2) + 4 * n + (i & 3); }
struct Unit { int pm, pn, e, aux; };
__device__ __forceinline__ unsigned cvt_pk_bf16(float lo, float hi) { unsigned r; asm volatile("v_cvt_pk_bf16_f32 %0, %1, %2" : "=v"(r) : "v"(lo), "v"(hi)); return r; }

struct DenseOrder {
    static constexpr bool GATHER = false;
    const bf16_t* A; const bf16_t* Bt; int K;
    int nM, nN, nwg, G, c;
    __device__ void init(const bf16_t* A_, const bf16_t* Bt_, int M, int N, int K_, int G_, int c_) { A = A_; Bt = Bt_; K = K_; nM = M / BM; nN = N / BM; nwg = nM * nN; G = G_; c = c_; }
    __device__ bool next(int i, Unit& u) const {
        const long Lx = (long)i * G + c; if (Lx >= nwg) return false;
        int wgid = (int)Lx; { const int q = nwg / NXCD, r = nwg % NXCD, xcd = wgid % NXCD, off = wgid / NXCD; wgid = (xcd < r ? xcd * (q + 1) : r * (q + 1) + (xcd - r) * q) + off; }
        const int nig = WGM * nN, gid = wgid / nig, fm = gid * WGM, gsz = (nM - fm) < WGM ? (nM - fm) : WGM;
        u.pm = fm + ((wgid % nig) % gsz); u.pn = (wgid % nig) / gsz; u.e = 0; u.aux = 0; return true;
    }
    __device__ __forceinline__ const char* a_base(const Unit& u) const { return (const char*)A + (size_t)u.pm * 256 * K * 2; }
    __device__ __forceinline__ const char* b_base(const Unit& u) const { return (const char*)Bt + (size_t)u.pn * 256 * K * 2; }
    __device__ __forceinline__ void a_offs(const Unit&, const int (&)[2], const int (&)[2], unsigned (&)[2][2]) const {}
};

template <class Epi, class Sched>
__device__ __forceinline__ void gemm_phase(LAS unsigned char* lds, const Sched& S, const Epi& E) {
    const int tid = threadIdx.x, wid = __builtin_amdgcn_readfirstlane(tid >> 6), lane = tid & 63, wr = wid >> 2, wc = wid & 3, fr = lane & 15, fq = lane >> 4;
    const int K = S.K, nt = K / BK;
    unsigned voffA[2], voffB[2]; int RR[2], CC[2];
#pragma unroll
    for (int i = 0; i < 2; ++i) { int R, C; stage_rc(tid * 16 + i * 8192, R, C); const int Rb = Epi::PERM ? ((R & ~31) + perm32(R & 31)) : R; RR[i] = R; CC[i] = C;
        voffA[i] = (unsigned)(R * K + C) * 2u; voffB[i] = (unsigned)(Rb * K + C) * 2u; }
    const size_t kstep = (size_t)(BK * 2);
    const size_t hstep = (size_t)HALF * K * 2;
    const unsigned ldsw = (unsigned)wid * 1024u;
    const int aoff = lds_byte(wr * 64 + fr, fq * 8), boff = lds_byte(wc * 32 + fr, fq * 8);
#define PG8_SA(b, h) (((b) * 2 + (h)) * HTB)
#define PG8_SB(b, h) ((4 + (b) * 2 + (h)) * HTB)
#define PG8_STAGE(bufoff, gbase, voff) do { _Pragma("unroll") for (int _i = 0; _i < 2; ++_i) \
        __builtin_amdgcn_global_load_lds((const unsigned*)((const char*)(gbase) + (voff)[_i]), (LAS unsigned*)(lds + (bufoff) + ldsw + _i * 8192), 16, 0, 0); } while (0)
#define PG8_STAGE_A(bufoff, ap, h, go) do { if constexpr (Sched::GATHER) { PG8_STAGE(bufoff, ap, (go)[h]); } else { PG8_STAGE(bufoff, (ap) + (h) * hstep, voffA); } } while (0)
#define PG8_LDA(dst, b, h) do { _Pragma("unroll") for (int m = 0; m < 4; ++m) _Pragma("unroll") for (int k = 0; k < 2; ++k) dst[m][k] = *(const LAS bf16x8*)(lds + PG8_SA(b, h) + aoff + m * 2048 + k * 1024); } while (0)
#define PG8_LDB(dst, b, h) do { _Pragma("unroll") for (int n = 0; n < 2; ++n) _Pragma("unroll") for (int k = 0; k < 2; ++k) dst[n][k] = *(const LAS bf16x8*)(lds + PG8_SB(b, h) + boff + n * 2048 + k * 1024); } while (0)
#define PG8_MMA(ai, bj, At, Bt) do { __builtin_amdgcn_s_setprio(1); _Pragma("unroll") for (int m = 0; m < 4; ++m) _Pragma("unroll") for (int n = 0; n < 2; ++n) _Pragma("unroll") for (int k = 0; k < 2; ++k) \
        acc[ai][bj][m][n] = __builtin_amdgcn_mfma_f32_16x16x32_bf16(Bt[n][k], At[m][k], acc[ai][bj][m][n], 0, 0, 0); __builtin_amdgcn_s_setprio(0); } while (0)
#define PG8_WAIT_V(n) asm volatile("s_waitcnt vmcnt(" #n ")" ::: "memory")
#define PG8_WAIT_L(n) asm volatile("s_waitcnt lgkmcnt(" #n ")" ::: "memory")
#define PG8_BAR __builtin_amdgcn_s_barrier()
#define PG8_SCHED __builtin_amdgcn_sched_barrier(0)
    Unit cur, nxt; int ui = 0;
    if (!S.next(0, cur)) return;
    f32x4 acc[2][2][4][2];
#pragma unroll
    for (int a = 0; a < 2; ++a)
#pragma unroll
        for (int b = 0; b < 2; ++b)
#pragma unroll
            for (int m = 0; m < 4; ++m)
#pragma unroll
                for (int n = 0; n < 2; ++n) acc[a][b][m][n] = (f32x4){0.f, 0.f, 0.f, 0.f};
    bf16x8 At[4][2], B0[2][2], B1[2][2];
    const char* cA = S.a_base(cur); const char* cB = S.b_base(cur);
    unsigned ca[2][2] = {{0u, 0u}, {0u, 0u}}, na[2][2] = {{0u, 0u}, {0u, 0u}};
    if constexpr (Sched::GATHER) S.a_offs(cur, RR, CC, ca);
    PG8_STAGE(PG8_SB(0, 0), cB, voffB); PG8_STAGE(PG8_SB(0, 1), cB + hstep, voffB); PG8_STAGE_A(PG8_SA(0, 0), cA, 0, ca); PG8_STAGE_A(PG8_SA(0, 1), cA, 1, ca);
    if (wr == 1) PG8_BAR;
    PG8_WAIT_V(2); PG8_BAR;
    PG8_STAGE(PG8_SB(1, 0), cB + kstep, voffB); PG8_STAGE_A(PG8_SA(1, 0), cA + kstep, 0, ca); PG8_STAGE(PG8_SB(1, 1), cB + hstep + kstep, voffB);
    PG8_WAIT_V(6); PG8_BAR;
    for (;;) {
        const bool has_next = S.next(ui + 1, nxt);
        const char* nA = has_next ? S.a_base(nxt) : cA; const char* nB = has_next ? S.b_base(nxt) : cB;
        if constexpr (Sched::GATHER) { if (has_next) S.a_offs(nxt, RR, CC, na); else {
#pragma unroll
            for (int h = 0; h < 2; ++h)
#pragma unroll
                for (int i = 0; i < 2; ++i) na[h][i] = ca[h][i]; } }
        for (int t = 0; t < nt; t += 2) {
            const bool last = (t == nt - 2);
            const char* a1 = cA + (size_t)(t + 1) * kstep;
            const char* a2 = last ? nA : cA + (size_t)(t + 2) * kstep; const char* b2 = last ? nB : cB + (size_t)(t + 2) * kstep;
            const char* a3 = a2 + kstep; const char* b3 = b2 + kstep;
            unsigned o2[2][2];
#pragma unroll
            for (int h = 0; h < 2; ++h)
#pragma unroll
                for (int i = 0; i < 2; ++i) o2[h][i] = last ? na[h][i] : ca[h][i];
            PG8_LDB(B0, 0, 0); PG8_LDB(B1, 0, 1); PG8_SCHED; PG8_LDA(At, 0, 0); PG8_STAGE_A(PG8_SA(1, 1), a1, 1, ca);
            PG8_WAIT_V(8); PG8_WAIT_L(0); PG8_BAR; PG8_MMA(0, 0, At, B0); PG8_MMA(0, 1, At, B1); PG8_BAR; PG8_SCHED;
            PG8_LDA(At, 0, 1); PG8_STAGE(PG8_SB(0, 0), b2, voffB); PG8_STAGE(PG8_SB(0, 1), b2 + hstep, voffB); PG8_STAGE_A(PG8_SA(0, 0), a2, 0, o2);
            PG8_WAIT_V(8); PG8_WAIT_L(0); PG8_BAR; PG8_MMA(1, 0, At, B0); PG8_MMA(1, 1, At, B1); PG8_BAR; PG8_SCHED;
            PG8_LDB(B0, 1, 0); PG8_LDB(B1, 1, 1); PG8_SCHED; PG8_LDA(At, 1, 0); PG8_STAGE_A(PG8_SA(0, 1), a2, 1, o2);
            PG8_WAIT_V(8); PG8_WAIT_L(0); PG8_BAR; PG8_MMA(0, 0, At, B0); PG8_MMA(0, 1, At, B1); PG8_BAR; PG8_SCHED;
            PG8_LDA(At, 1, 1); PG8_STAGE(PG8_SB(1, 0), b3, voffB); PG8_STAGE(PG8_SB(1, 1), b3 + hstep, voffB); PG8_STAGE_A(PG8_SA(1, 0), a3, 0, o2);
            PG8_WAIT_V(8); PG8_WAIT_L(0); PG8_BAR; PG8_MMA(1, 0, At, B0); PG8_MMA(1, 1, At, B1); PG8_BAR; PG8_SCHED;
        }
        if (wr == 0) PG8_BAR;
        E(acc, cur, wr, wc, fr, fq);
        if (!has_next) break;
#pragma unroll
        for (int a = 0; a < 2; ++a)
#pragma unroll
            for (int b = 0; b < 2; ++b)
#pragma unroll
                for (int m = 0; m < 4; ++m)
#pragma unroll
                    for (int n = 0; n < 2; ++n) acc[a][b][m][n] = (f32x4){0.f, 0.f, 0.f, 0.f};
        cur = nxt; cA = nA; cB = nB; ++ui;
#pragma unroll
        for (int h = 0; h < 2; ++h)
#pragma unroll
            for (int i = 0; i < 2; ++i) ca[h][i] = na[h][i];
        if (wr == 1) PG8_BAR;
    }
    PG8_WAIT_V(0);
    PG8_BAR;
#undef PG8_SA
#undef PG8_SB
#undef PG8_STAGE
#undef PG8_STAGE_A
#undef PG8_LDA
#undef PG8_LDB
#undef PG8_MMA
#undef PG8_WAIT_V
#undef PG8_WAIT_L
#undef PG8_BAR
#undef PG8_SCHED
}
constexpr size_t MiB = 1u << 20;
constexpr size_t WS_CTL = 0, CTL_ZERO_BYTES = 256 * 1024;
constexpr size_t WS_SMALL = 1 * MiB;
constexpr size_t WS_DEC = 2 * MiB;
constexpr size_t WS_KM = 3 * MiB;
constexpr size_t WS_LIST = 4 * MiB;
constexpr size_t WS_WGT = 12 * MiB;
constexpr size_t WS_SELCNT = 13 * MiB;
constexpr size_t WS_SEL = 16 * MiB;
constexpr size_t WS_WIN = 40 * MiB, WS_WOUT = 48 * MiB, WS_WKVQ = 50 * MiB, WS_WO = 56 * MiB;
constexpr size_t WS_MWIN = 64 * MiB, WS_MWOUT = 192 * MiB;
constexpr size_t WS_XN = 256 * MiB;
constexpr size_t WS_Q = 320 * MiB, WS_LF = 384 * MiB, WS_V = 448 * MiB, WS_G = 512 * MiB;
constexpr size_t WS_STATE = 576 * MiB;
constexpr size_t WS_OG = 640 * MiB;
constexpr size_t WS_ACT = 320 * MiB;
constexpr size_t WS_YB = 392 * MiB;
constexpr size_t WS_END = 1024 * MiB;
constexpr int CW_BAR = 1024;
constexpr int CW_CNT = 8192;
constexpr int LDS_BYTES = 163840;
constexpr int LDS_MISC = LDS_BYTES - 64;

struct Args {
    const float* in[20]; const float* xin; float* out; unsigned char* ws; int ph_lo, ph_hi;
};

__device__ __forceinline__ void p0_item(const float* W, int K, int N, bf16_t* WT, int dst_row0, const float* kscale, LAS float* scr, int k0, int n0, int lane) {
#pragma unroll 8
    for (int i = 0; i < 32; ++i) { const int kk = 2 * i + (lane >> 5); float w = W[(size_t)(k0 + kk) * N + n0 + (lane & 31)]; if (kscale) w *= kscale[k0 + kk]; scr[kk * 33 + (lane & 31)] = w; }
    LDS_WAIT(); asm volatile("" ::: "memory");
    const int c = lane & 7;
#pragma unroll
    for (int j = 0; j < 4; ++j) { const int n = (lane >> 3) + 8 * j; const LAS float* s = scr + (8 * c) * 33 + n;
        u32x4 o; o.x = pk2(s[0 * 33], s[1 * 33]); o.y = pk2(s[2 * 33], s[3 * 33]); o.z = pk2(s[4 * 33], s[5 * 33]); o.w = pk2(s[6 * 33], s[7 * 33]);
        *(GAS u32x4*)(WT + (size_t)(dst_row0 + n) * K + k0 + 8 * c) = o; }
    LDS_WAIT(); asm volatile("" ::: "memory");
}
__device__ __forceinline__ int t5_bucket(int n) {
    if (n < 16) return n;
    const float lr = logf((float)n / 16.0f) / 4.1588830833596715f;
    int large = 16 + (int)(lr * 16.0f);
    return large < 31 ? large : 31;
}
__device__ __forceinline__ void norm_row_bf16(const float* xrow, const float* w, bf16_t* orow, int lane) {
    const GAS f32x4* xr = (const GAS f32x4*)xrow + lane;
    f32x4 v[4]; float s = 0.f;
#pragma unroll
    for (int j = 0; j < 4; ++j) { v[j] = xr[64 * j]; s += (v[j].x * v[j].x + v[j].y * v[j].y) + (v[j].z * v[j].z + v[j].w * v[j].w); }
    const float r = rsqrtf(wave_sum(s) * (1.f / D) + EPS);
    GAS u32x2* o8 = (GAS u32x2*)orow + lane;
#pragma unroll
    for (int j = 0; j < 4; ++j) { f32x4 ww = (f32x4){1.f, 1.f, 1.f, 1.f}; if (w) ww = ((const GAS f32x4*)w)[lane + 64 * j];
        u32x2 o; o.x = pk2(v[j].x * r * ww.x, v[j].y * r * ww.y); o.y = pk2(v[j].z * r * ww.z, v[j].w * r * ww.w); o8[64 * j] = o; }
}
__device__ __forceinline__ void p0_prologue(const Args& a, LAS unsigned char* lds, int wave, int lane) {
    LAS float* scr = (LAS float*)(lds + wave * 16384);
    const int gw = blockIdx.x * 8 + wave, NGW = gridDim.x * 8;
    unsigned char* ws = a.ws;
    constexpr int J0 = 2048, J1 = J0 + 512, J2 = J1 + 1024, J3 = J2 + 512, J4 = J3 + 512, J5 = J4 + 64 * 512, J6 = J5 + 64 * 256;
    for (int it = gw; it < J6; it += NGW) {
        if (it < J0) { const int r = it, nblk = 4096 / 32, kb = r / nblk, nb = r % nblk; p0_item(a.in[3], 1024, 4096, (bf16_t*)(ws + WS_WIN), 32 * nb, nullptr, scr, 64 * kb, 32 * nb, lane); }
        else if (it < J1) { const int r = it - J0, kb = r / 32, nb = r % 32; p0_item(a.in[6], 1024, 1024, (bf16_t*)(ws + WS_WOUT), 32 * nb, nullptr, scr, 64 * kb, 32 * nb, lane); }
        else if (it < J2) { const int r = it - J1, kb = r / 64, nb = r % 64; p0_item(a.in[8], 1024, 2048, (bf16_t*)(ws + WS_WKVQ), 32 * nb, a.in[7], scr, 64 * kb, 32 * nb, lane); }
        else if (it < J3) { const int r = it - J2, kb = r / 32, nb = r % 32; p0_item(a.in[10], 1024, 1024, (bf16_t*)(ws + WS_WKVQ), 2048 + 32 * nb, a.in[1] + D, scr, 64 * kb, 32 * nb, lane); }
        else if (it < J4) { const int r = it - J3, kb = r / 32, nb = r % 32; p0_item(a.in[12], 1024, 1024, (bf16_t*)(ws + WS_WO), 32 * nb, nullptr, scr, 64 * kb, 32 * nb, lane); }
        else if (it < J5) { const int r = it - J4, mat = r / 512, q = r % 512, kb = q / 32, nb = q % 32; const int n0 = 32 * nb;
            const int dst = (n0 < 512) ? ((n0 >> 7) * 256 + (n0 & 127)) : ((((n0 - 512) >> 7) * 256) + 128 + ((n0 - 512) & 127));
            p0_item(a.in[18] + (size_t)mat * 1024 * 1024, 1024, 1024, (bf16_t*)(ws + WS_MWIN) + (size_t)mat * 1024 * 1024, dst, nullptr, scr, 64 * kb, n0, lane); }
        else { const int r = it - J5, mat = r / 256, q = r % 256, kb = q / 32, nb = q % 32;
            p0_item(a.in[19] + (size_t)mat * 512 * 1024, 512, 1024, (bf16_t*)(ws + WS_MWOUT) + (size_t)mat * 1024 * 512, 32 * nb, nullptr, scr, 64 * kb, 32 * nb, lane); }
    }
    for (int m = gw; m < T; m += NGW) norm_row_bf16(a.in[0] + (size_t)m * D, a.in[1], (bf16_t*)(ws + WS_XN) + (size_t)m * D, lane);
    if (blockIdx.x == 0) {
        float* lb = (float*)(ws + WS_SMALL); float* bt = lb + 2048;
        for (int i = threadIdx.x; i < 1024; i += 512) { const float x0 = a.in[4][i], x1 = a.in[4][1024 + i], m = fmaxf(x0, x1), e0 = expf(x0 - m), e1 = expf(x1 - m); lb[i] = e0 / (e0 + e1); }
        for (int i = threadIdx.x; i < 8192; i += 512) { const int h = i >> 10, d = i & 1023; bt[i] = a.in[13][t5_bucket(d) * 8 + h]; }
    }
}

struct EpiHG {
    static constexpr bool PERM = true;
    bf16_t* Qo; const float* lb;
    __device__ __forceinline__ void operator()(const f32x4 (&acc)[2][2][4][2], const Unit& u, int wr, int wc, int fr, int fq) const {
        const int quarter = u.pn >> 2, colq = (u.pn & 3) * 256 + wc * 32 + 8 * fq;
        bf16_t* base = Qo + (size_t)quarter * (64 * MiB / 2);
        const int row0 = u.pm * BM + wr * 64 + fr;
        f32x4 l0[2], l1[2];
#pragma unroll
        for (int bj = 0; bj < 2; ++bj) { l0[bj] = *(const f32x4*)(lb + colq + bj * HALF); l1[bj] = *(const f32x4*)(lb + colq + bj * HALF + 4); }
#pragma unroll
        for (int ai = 0; ai < 2; ++ai)
#pragma unroll
            for (int m = 0; m < 4; ++m) { bf16_t* rowp = base + (size_t)(row0 + ai * HALF + m * 16) * 1024 + colq;
#pragma unroll
                for (int bj = 0; bj < 2; ++bj) { f32x4 v0 = acc[ai][bj][m][0], v1 = acc[ai][bj][m][1];
                    if (quarter == 0) { v0 = v0 * 0.08838834764831845f; v1 = v1 * 0.08838834764831845f; }
                    else if (quarter == 1) {
#pragma unroll
                        for (int j = 0; j < 4; ++j) { v0[j] = __logf(l0[bj][j] + (1.f - l0[bj][j]) * sigmoidf_(v0[j])); v1[j] = __logf(l1[bj][j] + (1.f - l1[bj][j]) * sigmoidf_(v1[j])); } }
                    else if (quarter == 3) {
#pragma unroll
                        for (int j = 0; j < 4; ++j) { v0[j] = v0[j] * sigmoidf_(v0[j]); v1[j] = v1[j] * sigmoidf_(v1[j]); } }
                    u32x4 w; w.x = cvt_pk_bf16(v0[0], v0[1]); w.y = cvt_pk_bf16(v0[2], v0[3]); w.z = cvt_pk_bf16(v1[0], v1[1]); w.w = cvt_pk_bf16(v1[2], v1[3]);
                    *(u32x4*)(rowp + bj * HALF) = w; } }
    }
};
struct EpiRes {
    static constexpr bool PERM = false;
    float* C; const float* R; int ldc;
    __device__ __forceinline__ void operator()(const f32x4 (&acc)[2][2][4][2], const Unit& u, int wr, int wc, int fr, int fq) const {
        const int row0 = u.pm * BM + wr * 64 + fr, col0 = u.pn * BM + wc * 32 + 4 * fq;
#pragma unroll
        for (int ai = 0; ai < 2; ++ai)
#pragma unroll
            for (int m = 0; m < 4; ++m) { const size_t off = (size_t)(row0 + ai * HALF + m * 16) * ldc + col0;
#pragma unroll
                for (int bj = 0; bj < 2; ++bj)
#pragma unroll
                    for (int n = 0; n < 2; ++n) { const f32x4 r = *(const f32x4*)(R + off + bj * HALF + n * 16); *(f32x4*)(C + off + bj * HALF + n * 16) = r + acc[ai][bj][m][n]; }
                asm volatile("" ::: "memory"); }
    }
};

__device__ __forceinline__ unsigned off_b(unsigned row, unsigned ch) { return 256u * row + 16u * (ch ^ (((row & 3) << 2) | ((row >> 2) & 3))); }
__device__ __forceinline__ unsigned row_rd16(unsigned lane, unsigned rb, unsigned s) { return off_b((lane & 15) + 16 * rb, 4 * s + (lane >> 4)); }
__device__ __forceinline__ unsigned tr_rd16(unsigned lane, unsigned c, unsigned ks, unsigned t) { const unsigned g = lane >> 4, q = (lane & 15) >> 2, p = lane & 3; return off_b(32 * ks + 8 * g + 4 * t + q, 2 * c + (p >> 1)) + 8 * (p & 1); }
__device__ __forceinline__ unsigned elem_off(unsigned row, unsigned col) { return off_b(row, col >> 3) + (col & 7) * 2; }
__device__ __forceinline__ bf16x8 tr_frag(unsigned a0, unsigned a1) {
    bf16x4 lo, hi;
    asm volatile("ds_read_b64_tr_b16 %0, %2\n\tds_read_b64_tr_b16 %1, %3\n\ts_waitcnt lgkmcnt(0)" : "=&v"(lo), "=&v"(hi) : "v"(a0), "v"(a1) : "memory");
    bf16x8 r; r[0] = lo[0]; r[1] = lo[1]; r[2] = lo[2]; r[3] = lo[3]; r[4] = hi[0]; r[5] = hi[1]; r[6] = hi[2]; r[7] = hi[3]; return r;
}
constexpr int GI_Q = 0, GI_K = 16384, GI_KH = 32768, GI_V = 49152, GI_A = 65536, GI_ST = 81920, GI_O = 114688, GI_GTOT = 148480, GI_EBT = 152576;
constexpr int O_PITCH = 132;

template <bool WITH_Q>
__device__ __forceinline__ void gla_prep(LAS unsigned char* lds, const unsigned (&lfw)[8], const unsigned (&qw)[8], const unsigned (&vw)[8], int g, int lane, float& totsum0, float& totsum1) {
    float b0[8], b1[8]; float s0 = 0.f, s1 = 0.f;
#pragma unroll
    for (int i = 0; i < 8; ++i) { s0 += bf_lo(lfw[i]); s1 += bf_hi(lfw[i]); b0[i] = s0; b1[i] = s1; }
    LAS float* gtot = (LAS float*)(lds + GI_GTOT);
    *(LAS f32x2*)(gtot + g * 128 + 2 * lane) = (f32x2){s0, s1};
    __syncthreads();
    float pre0 = 0.f, pre1 = 0.f, tot0 = 0.f, tot1 = 0.f;
#pragma unroll
    for (int gg = 0; gg < 8; ++gg) { const f32x2 v = *(LAS f32x2*)(gtot + gg * 128 + 2 * lane); tot0 += v.x; tot1 += v.y; if (gg < g) { pre0 += v.x; pre1 += v.y; } }
    totsum0 += tot0; totsum1 += tot1;
    if (g == 0) *(LAS f32x2*)((LAS float*)(lds + GI_EBT) + 2 * lane) = (f32x2){__expf(tot0), __expf(tot1)};
    const unsigned d = 2 * lane;
#pragma unroll
    for (int i = 0; i < 8; ++i) {
        const unsigned t = 8 * g + i, eo = elem_off(t, d);
        const float B0 = b0[i] + pre0, B1 = b1[i] + pre1;
        const float k0 = 1.f - __expf(bf_lo(lfw[i])), k1 = 1.f - __expf(bf_hi(lfw[i]));
        *(LAS unsigned*)(lds + GI_KH + eo) = pk2(k0 * __expf(tot0 - B0), k1 * __expf(tot1 - B1));
        *(LAS unsigned*)(lds + GI_V + eo) = vw[i];
        if (WITH_Q) {
            *(LAS unsigned*)(lds + GI_Q + eo) = pk2(bf_lo(qw[i]) * __expf(B0), bf_hi(qw[i]) * __expf(B1));
            *(LAS unsigned*)(lds + GI_K + eo) = pk2(k0 * __expf(fminf(-B0, 80.f)), k1 * __expf(fminf(-B1, 80.f)));
        }
    }
}
__device__ __forceinline__ void gla_state_update(LAS unsigned char* lds, unsigned lds0, f32x4 (&S)[8], const bf16x8 (&vf)[2], int w, int lane) {
    const int fr = lane & 15, fq = lane >> 4;
#pragma unroll
    for (int mb = 0; mb < 8; ++mb) {
        const f32x4 e4 = *(LAS f32x4*)((LAS float*)(lds + GI_EBT) + 16 * mb + 4 * fq);
        f32x4 s = S[mb] * e4;
#pragma unroll
        for (int ks = 0; ks < 2; ++ks) { const bf16x8 kh = tr_frag(lds0 + GI_KH + tr_rd16(lane, mb, ks, 0), lds0 + GI_KH + tr_rd16(lane, mb, ks, 1)); s = __builtin_amdgcn_mfma_f32_16x16x32_bf16(kh, vf[ks], s, 0, 0, 0); }
        S[mb] = s;
        u32x2 o; o.x = pk2(s[0], s[1]); o.y = pk2(s[2], s[3]);
        *(LAS u32x2*)(lds + GI_ST + elem_off(16 * w + fr, 16 * mb + 4 * fq)) = o;
    }
}
template <int PASS>
__device__ __forceinline__ void gla_phase(const Args& a, LAS unsigned char* lds, int wave, int lane) {
    unsigned char* ws = a.ws;
    const unsigned lds0 = (unsigned)(size_t)lds;
    const bf16_t* Qg = (const bf16_t*)(ws + WS_Q); const bf16_t* LFg = (const bf16_t*)(ws + WS_LF); const bf16_t* Vg = (const bf16_t*)(ws + WS_V); const bf16_t* Gg = (const bf16_t*)(ws + WS_G);
    float* STATE = (float*)(ws + WS_STATE); float* DEC = (float*)(ws + WS_DEC); bf16_t* OG = (bf16_t*)(ws + WS_OG);
    const float* onw = a.in[5];
    const int g = wave, w = wave, fr = lane & 15, fq = lane >> 4;
    for (int item = blockIdx.x; item < 1024; item += gridDim.x) {
        const int bh = item >> 5, sc = item & 31, b = bh >> 3, h = bh & 7;
        const size_t tok0 = (size_t)b * L + (size_t)sc * 256;
        const size_t colb = (size_t)h * 128 + 2 * lane;
        f32x4 S[8];
        if (PASS == 1) {
            const float* sp = STATE + (size_t)item * 16384 + (size_t)(16 * w + fr) * 128 + 4 * fq;
#pragma unroll
            for (int mb = 0; mb < 8; ++mb) { S[mb] = *(const f32x4*)(sp + 16 * mb);
                u32x2 o; o.x = pk2(S[mb][0], S[mb][1]); o.y = pk2(S[mb][2], S[mb][3]);
                *(LAS u32x2*)(lds + GI_ST + elem_off(16 * w + fr, 16 * mb + 4 * fq)) = o; }
        } else {
#pragma unroll
            for (int mb = 0; mb < 8; ++mb) S[mb] = (f32x4){0.f, 0.f, 0.f, 0.f};
        }
        float ts0 = 0.f, ts1 = 0.f;
        for (int c = 0; c < 4; ++c) {
            unsigned lfw[8], qw[8], vw[8];
#pragma unroll
            for (int i = 0; i < 8; ++i) { const size_t o = (tok0 + c * 64 + 8 * g + i) * 1024 + colb;
                lfw[i] = *(const unsigned*)(LFg + o); vw[i] = *(const unsigned*)(Vg + o); qw[i] = (PASS == 1) ? *(const unsigned*)(Qg + o) : 0u; }
            gla_prep<PASS == 1>(lds, lfw, qw, vw, g, lane, ts0, ts1);
            __syncthreads();
            bf16x8 vf[2];
#pragma unroll
            for (int ks = 0; ks < 2; ++ks) vf[ks] = tr_frag(lds0 + GI_V + tr_rd16(lane, w, ks, 0), lds0 + GI_V + tr_rd16(lane, w, ks, 1));
            if (PASS == 1) {
                const int tb = w >> 1;
#pragma unroll
                for (int x = 0; x < 2; ++x) { const int sb = 2 * (w & 1) + x;
                    f32x4 acc = (f32x4){0.f, 0.f, 0.f, 0.f};
#pragma unroll
                    for (int ks = 0; ks < 4; ++ks) { const bf16x8 ka = *(const LAS bf16x8*)(lds + GI_K + row_rd16(lane, sb, ks)); const bf16x8 qb = *(const LAS bf16x8*)(lds + GI_Q + row_rd16(lane, tb, ks));
                        acc = __builtin_amdgcn_mfma_f32_16x16x32_bf16(ka, qb, acc, 0, 0, 0); }
                    const int t = tb * 16 + fr, s0 = sb * 16 + 4 * fq;
#pragma unroll
                    for (int r = 0; r < 4; ++r) if (s0 + r > t) acc[r] = 0.f;
                    u32x2 o; o.x = pk2(acc[0], acc[1]); o.y = pk2(acc[2], acc[3]);
                    *(LAS u32x2*)(lds + GI_A + elem_off(t, s0)) = o; }
                bf16x8 stf[4];
#pragma unroll
                for (int ks = 0; ks < 4; ++ks) stf[ks] = *(const LAS bf16x8*)(lds + GI_ST + row_rd16(lane, w, ks));
                __syncthreads();
#pragma unroll
                for (int tb2 = 0; tb2 < 4; ++tb2) {
                    f32x4 acc = (f32x4){0.f, 0.f, 0.f, 0.f};
#pragma unroll
                    for (int ks = 0; ks < 2; ++ks) { const bf16x8 ab = *(const LAS bf16x8*)(lds + GI_A + row_rd16(lane, tb2, ks)); acc = __builtin_amdgcn_mfma_f32_16x16x32_bf16(vf[ks], ab, acc, 0, 0, 0); }
#pragma unroll
                    for (int ks = 0; ks < 4; ++ks) { const bf16x8 qb = *(const LAS bf16x8*)(lds + GI_Q + row_rd16(lane, tb2, ks)); acc = __builtin_amdgcn_mfma_f32_16x16x32_bf16(stf[ks], qb, acc, 0, 0, 0); }
                    *(LAS f32x4*)((LAS float*)(lds + GI_O) + (16 * tb2 + fr) * O_PITCH + 16 * w + 4 * fq) = acc;
                }
            }
            if (PASS == 0 || c < 3) gla_state_update(lds, lds0, S, vf, w, lane);
            __syncthreads();
            if (PASS == 1) {
#pragma unroll
                for (int i = 0; i < 8; ++i) { const int t = 8 * g + i;
                    const f32x2 o = *(LAS f32x2*)((LAS float*)(lds + GI_O) + t * O_PITCH + 2 * lane);
                    const float r = rsqrtf(wave_sum(o.x * o.x + o.y * o.y) * (1.f / 128.f) + EPS);
                    const size_t go = (tok0 + c * 64 + t) * 1024 + colb;
                    const unsigned gw = *(const unsigned*)(Gg + go);
                    const f32x2 nw = *(const f32x2*)(onw + 2 * lane);
                    *(unsigned*)(OG + go) = pk2(o.x * r * nw.x * bf_lo(gw), o.y * r * nw.y * bf_hi(gw)); }
            }
        }
        if (PASS == 0) {
            float* sp = STATE + (size_t)item * 16384 + (size_t)(16 * w + fr) * 128 + 4 * fq;
#pragma unroll
            for (int mb = 0; mb < 8; ++mb) *(f32x4*)(sp + 16 * mb) = S[mb];
            if (g == 0) *(f32x2*)(DEC + (size_t)item * 128 + 2 * lane) = (f32x2){__expf(ts0), __expf(ts1)};
        }
        __syncthreads();
    }
}
__device__ __forceinline__ void gla_scan(const Args& a) {
    float* STATE = (float*)(a.ws + WS_STATE); const float* DEC = (const float*)(a.ws + WS_DEC);
    for (int e = blockIdx.x * 512 + threadIdx.x; e < 32 * 4096; e += gridDim.x * 512) {
        const int bh = e >> 12, q = e & 4095, dk0 = (q & 31) * 4;
        f32x4 carry = (f32x4){0.f, 0.f, 0.f, 0.f};
        float* p = STATE + (size_t)bh * 32 * 16384 + (size_t)q * 4;
        const float* dp = DEC + (size_t)bh * 32 * 128 + dk0;
#pragma unroll 4
        for (int sc = 0; sc < 32; ++sc) { const f32x4 loc = *(const f32x4*)(p + (size_t)sc * 16384); const f32x4 dec = *(const f32x4*)(dp + sc * 128);
            *(f32x4*)(p + (size_t)sc * 16384) = carry; carry = dec * carry + loc; }
    }
}
constexpr int MOE_CAPROWS = T * 2 + NEXP * 256;
constexpr int LDS_MOE_TAB = 131072;

__device__ __forceinline__ void moe_route_phase(const Args& a, LAS unsigned char* lds, int layer, const float* xin, int wave, int lane) {
    unsigned char* ws = a.ws;
    LAS float* WT = (LAS float*)lds;
    const float* wg = a.in[14] + (size_t)layer * D * 4; const float* bg = a.in[15] + layer * 4;
    const float* we = a.in[16] + (size_t)layer * D * 32; const float* be = a.in[17] + layer * 32;
    const float* nw = a.in[2] + (size_t)layer * D;
    for (int i = threadIdx.x; i < 4096; i += 512) WT[(i & 3) * 1024 + (i >> 2)] = wg[i];
    for (int i = threadIdx.x; i < 32768; i += 512) WT[(4 + (i & 31)) * 1024 + (i >> 5)] = we[i];
    __syncthreads();
    unsigned* cnt = (unsigned*)(ws + WS_CTL) + CW_CNT + 64 * layer;
    int* list = (int*)(ws + WS_LIST); float* wgt = (float*)(ws + WS_WGT); bf16_t* H2 = (bf16_t*)(ws + WS_XN);
    const int gw = blockIdx.x * 8 + wave, NGW = gridDim.x * 8;
    f32x4 wv[4];
#pragma unroll
    for (int j = 0; j < 4; ++j) wv[j] = ((const GAS f32x4*)nw)[lane + 64 * j];
    LAS float* wscr = (LAS float*)(lds + 147456) + wave * 64; LAS float* bsh = (LAS float*)(lds + 147456 + 2048);
    if (threadIdx.x < 4) bsh[threadIdx.x] = bg[threadIdx.x];
    if (threadIdx.x < 32) bsh[4 + threadIdx.x] = be[threadIdx.x];
    __syncthreads();
    for (int t = gw; t < T; t += NGW) {
        const GAS f32x4* xr = (const GAS f32x4*)(xin + (size_t)t * D) + lane;
        f32x4 v[4]; float s = 0.f;
#pragma unroll
        for (int j = 0; j < 4; ++j) { v[j] = xr[64 * j]; s += (v[j].x * v[j].x + v[j].y * v[j].y) + (v[j].z * v[j].z + v[j].w * v[j].w); }
        const float r = rsqrtf(wave_sum(s) * (1.f / D) + EPS);
        GAS u32x2* o8 = (GAS u32x2*)(H2 + (size_t)t * D) + lane;
#pragma unroll
        for (int j = 0; j < 4; ++j) { v[j] = v[j] * r * wv[j]; u32x2 o; o.x = pk2(v[j].x, v[j].y); o.y = pk2(v[j].z, v[j].w); o8[64 * j] = o; }
#pragma unroll 1
        for (int c = 0; c < 36; ++c) {
            float p = 0.f;
#pragma unroll
            for (int j = 0; j < 4; ++j) { const f32x4 w4 = *(const LAS f32x4*)(WT + c * 1024 + 4 * (lane + 64 * j)); p += (v[j].x * w4.x + v[j].y * w4.y) + (v[j].z * w4.z + v[j].w * w4.w); }
            p = wave_sum(p);
            if (lane == 0) wscr[c] = p + bsh[c];
        }
        float lg[36];
#pragma unroll
        for (int c = 0; c < 36; ++c) lg[c] = wscr[c];
        int gi = 0; float gm = lg[0];
#pragma unroll
        for (int i = 1; i < 4; ++i) if (lg[i] > gm) { gm = lg[i]; gi = i; }
        float gs = 0.f;
#pragma unroll
        for (int i = 0; i < 4; ++i) gs += expf(lg[i] - gm);
        const float gw_ = 1.0f / gs;
        float el[8];
#pragma unroll
        for (int i = 0; i < 8; ++i) el[i] = gi == 0 ? lg[4 + i] : gi == 1 ? lg[12 + i] : gi == 2 ? lg[20 + i] : lg[28 + i];
        int i0 = 0; float m0 = el[0];
#pragma unroll
        for (int i = 1; i < 8; ++i) if (el[i] > m0) { m0 = el[i]; i0 = i; }
        int i1 = -1; float m1 = -INFINITY;
#pragma unroll
        for (int i = 0; i < 8; ++i) if (i != i0 && el[i] > m1) { m1 = el[i]; i1 = i; }
        const float p1 = expf(m1 - m0);
        const float w0 = gw_ / (1.f + p1), w1 = gw_ * p1 / (1.f + p1);
        if (lane == 0) {
            const int e0 = gi * 8 + i0, e1 = gi * 8 + i1;
            const unsigned r0 = __hip_atomic_fetch_add(cnt + e0, 1u, __ATOMIC_RELAXED, __HIP_MEMORY_SCOPE_AGENT); list[(size_t)e0 * (2 * T) + r0] = t * 2;     wgt[t * 2] = w0;
            const unsigned r1 = __hip_atomic_fetch_add(cnt + e1, 1u, __ATOMIC_RELAXED, __HIP_MEMORY_SCOPE_AGENT); list[(size_t)e1 * (2 * T) + r1] = t * 2 + 1; wgt[t * 2 + 1] = w1;
        }
    }
}
__device__ __forceinline__ void moe_tables(const Args& a, LAS unsigned char* lds, int layer) {
    LAS int* tst = (LAS int*)(lds + LDS_MOE_TAB); LAS int* cn = tst + 64;
    const unsigned* cnt = (const unsigned*)(a.ws + WS_CTL) + CW_CNT + 64 * layer;
    if (threadIdx.x == 0) { int acc = 0; for (int e = 0; e < NEXP; ++e) { const int c = (int)__hip_atomic_load(cnt + e, __ATOMIC_RELAXED, __HIP_MEMORY_SCOPE_AGENT); tst[e] = acc; cn[e] = c; acc += (c + 255) >> 8; } tst[NEXP] = acc; }
    __syncthreads();
}
struct MoeOrder {
    const LAS int* tst; const LAS int* cn; const int* list;
    const bf16_t* A; const bf16_t* Bt; int K; size_t bstride;
    int G, c, ntot;
    __device__ bool next(int i, Unit& u) const {
        const int Lx = i * G + c; if (Lx >= ntot * 4) return false;
        u.pm = Lx >> 2; u.pn = Lx & 3; int e = 0;
#pragma unroll 1
        for (int k = 1; k < NEXP; ++k) if (tst[k] <= u.pm) e = k;
        u.e = e; u.aux = u.pm - tst[e]; return true;
    }
    __device__ __forceinline__ const char* b_base(const Unit& u) const { return (const char*)Bt + (size_t)u.e * bstride + (size_t)u.pn * 256 * K * 2; }
};
struct MoeOrder1 : MoeOrder {
    static constexpr bool GATHER = true;
    __device__ __forceinline__ const char* a_base(const Unit&) const { return (const char*)A; }
    __device__ __forceinline__ void a_offs(const Unit& u, const int (&RR)[2], const int (&CC)[2], unsigned (&o)[2][2]) const {
        const int cnte = cn[u.e]; const int* le = list + (size_t)u.e * (2 * T);
#pragma unroll
        for (int h = 0; h < 2; ++h)
#pragma unroll
            for (int i = 0; i < 2; ++i) { const int rank = u.aux * 256 + h * 128 + RR[i]; const int tok = rank < cnte ? (le[rank] >> 1) : 0; o[h][i] = (unsigned)(tok * K + CC[i]) * 2u; }
    }
};
struct MoeOrder2 : MoeOrder {
    static constexpr bool GATHER = false;
    __device__ __forceinline__ const char* a_base(const Unit& u) const { return (const char*)A + (size_t)u.pm * 256 * K * 2; }
    __device__ __forceinline__ void a_offs(const Unit&, const int (&)[2], const int (&)[2], unsigned (&)[2][2]) const {}
};
struct EpiAct {
    static constexpr bool PERM = true;
    bf16_t* ACT;
    __device__ __forceinline__ void operator()(const f32x4 (&acc)[2][2][4][2], const Unit& u, int wr, int wc, int fr, int fq) const {
        const int row0 = u.pm * BM + wr * 64 + fr, col0 = u.pn * 128 + wc * 32 + 8 * fq;
#pragma unroll
        for (int ai = 0; ai < 2; ++ai)
#pragma unroll
            for (int m = 0; m < 4; ++m) { bf16_t* rowp = ACT + (size_t)(row0 + ai * HALF + m * 16) * FF + col0;
                f32x4 g0 = acc[ai][0][m][0], g1 = acc[ai][0][m][1]; const f32x4 u0 = acc[ai][1][m][0], u1 = acc[ai][1][m][1];
#pragma unroll
                for (int j = 0; j < 4; ++j) { g0[j] = g0[j] * sigmoidf_(g0[j]) * u0[j]; g1[j] = g1[j] * sigmoidf_(g1[j]) * u1[j]; }
                u32x4 w; w.x = cvt_pk_bf16(g0[0], g0[1]); w.y = cvt_pk_bf16(g0[2], g0[3]); w.z = cvt_pk_bf16(g1[0], g1[1]); w.w = cvt_pk_bf16(g1[2], g1[3]);
                *(u32x4*)rowp = w; }
    }
};
struct EpiY {
    static constexpr bool PERM = true;
    bf16_t* YB; const int* list; const float* wgt; const LAS int* cn;
    __device__ __forceinline__ void operator()(const f32x4 (&acc)[2][2][4][2], const Unit& u, int wr, int wc, int fr, int fq) const {
        const int cnte = cn[u.e]; const int* le = list + (size_t)u.e * (2 * T);
        const int col0 = u.pn * BM + wc * 32 + 8 * fq;
#pragma unroll
        for (int ai = 0; ai < 2; ++ai)
#pragma unroll
            for (int m = 0; m < 4; ++m) { const int rank = u.aux * 256 + ai * HALF + wr * 64 + m * 16 + fr;
                if (rank < cnte) { const int entry = le[rank]; const float w = wgt[entry]; bf16_t* rowp = YB + (size_t)entry * D + col0;
#pragma unroll
                    for (int bj = 0; bj < 2; ++bj) { const f32x4 v0 = acc[ai][bj][m][0] * w, v1 = acc[ai][bj][m][1] * w;
                        u32x4 o; o.x = cvt_pk_bf16(v0[0], v0[1]); o.y = cvt_pk_bf16(v0[2], v0[3]); o.z = cvt_pk_bf16(v1[0], v1[1]); o.w = cvt_pk_bf16(v1[2], v1[3]);
                        *(u32x4*)(rowp + bj * HALF) = o; } } }
    }
};
__device__ __forceinline__ void moe_combine_phase(const Args& a, const float* xin, float* xout, int wave, int lane) {
    const bf16_t* YB = (const bf16_t*)(a.ws + WS_YB);
    const int gw = blockIdx.x * 8 + wave, NGW = gridDim.x * 8;
    for (int t = gw; t < T; t += NGW) {
        const GAS f32x4* xr = (const GAS f32x4*)(xin + (size_t)t * D) + lane; GAS f32x4* xo = (GAS f32x4*)(xout + (size_t)t * D) + lane;
        const GAS u32x2* y0 = (const GAS u32x2*)(YB + (size_t)(2 * t) * D) + lane; const GAS u32x2* y1 = (const GAS u32x2*)(YB + (size_t)(2 * t + 1) * D) + lane;
#pragma unroll
        for (int j = 0; j < 4; ++j) { f32x4 v = xr[64 * j]; const u32x2 p = y0[64 * j], q = y1[64 * j];
            v.x += bf_lo(p.x) + bf_lo(q.x); v.y += bf_hi(p.x) + bf_hi(q.x); v.z += bf_lo(p.y) + bf_lo(q.y); v.w += bf_hi(p.y) + bf_hi(q.y); xo[64 * j] = v; }
    }
}
constexpr size_t WS_K2 = 320 * MiB, WS_V2 = 384 * MiB, WS_Q2 = 448 * MiB;
constexpr size_t WS_OP = 512 * MiB;
constexpr size_t WS_LP = 704 * MiB;
constexpr size_t WS_ATT = 708 * MiB;
constexpr size_t WS_SELX = 1001 * MiB;
constexpr int CW_TOT = 16384;
constexpr float ATT_C1 = 0.08838834764831845f * 1.4426950408889634f;

__device__ __forceinline__ void att_norm_phase(const Args& a, int wave, int lane) {
    const int gw = blockIdx.x * 8 + wave, NGW = gridDim.x * 8;
    for (int m = gw; m < T; m += NGW) norm_row_bf16(a.xin + (size_t)m * D, nullptr, (bf16_t*)(a.ws + WS_XN) + (size_t)m * D, lane);
}
struct EpiKVQ {
    static constexpr bool PERM = true;
    bf16_t* Ko;
    __device__ __forceinline__ void operator()(const f32x4 (&acc)[2][2][4][2], const Unit& u, int wr, int wc, int fr, int fq) const {
        const int sec = u.pn >> 2, hp = (u.pn & 3) * 2, d0 = wc * 32 + 8 * fq;
        bf16_t* base = Ko + (size_t)sec * (64 * MiB / 2);
#pragma unroll
        for (int ai = 0; ai < 2; ++ai)
#pragma unroll
            for (int m = 0; m < 4; ++m) { const int r = u.pm * BM + ai * HALF + wr * 64 + m * 16 + fr, b = r >> 13, pos = r & 8191;
#pragma unroll
                for (int bj = 0; bj < 2; ++bj) { const f32x4 v0 = acc[ai][bj][m][0], v1 = acc[ai][bj][m][1];
                    u32x4 w; w.x = cvt_pk_bf16(v0[0], v0[1]); w.y = cvt_pk_bf16(v0[2], v0[3]); w.z = cvt_pk_bf16(v1[0], v1[1]); w.w = cvt_pk_bf16(v1[2], v1[3]);
                    *(u32x4*)(base + (((size_t)(b * NH + hp + bj) * L + pos) * HD + d0)) = w; } }
    }
};
__device__ __forceinline__ void att_post_phase(const Args& a, LAS unsigned char* lds, int wave, int lane) {
    bf16_t* Kb = (bf16_t*)(a.ws + WS_K2); bf16_t* Qb = (bf16_t*)(a.ws + WS_Q2); float* KM = (float*)(a.ws + WS_KM);
    const f32x2 kw = *(const f32x2*)(a.in[9] + 2 * lane), qw = *(const f32x2*)(a.in[11] + 2 * lane);
    LAS float* cs = (LAS float*)lds;
    for (int item = blockIdx.x; item < B * NH * NBLK; item += gridDim.x) {
        const size_t row0 = (size_t)(item >> 5) * L + (size_t)(item & 31) * 256 + 32 * wave;
        float c0 = 0.f, c1 = 0.f;
#pragma unroll 4
        for (int i = 0; i < 32; ++i) {
            unsigned* kp = (unsigned*)(Kb + (row0 + i) * HD) + lane; unsigned* qp = (unsigned*)(Qb + (row0 + i) * HD) + lane;
            const unsigned ku = *kp, qu = *qp;
            float k0 = bf_lo(ku), k1 = bf_hi(ku), q0 = bf_lo(qu), q1 = bf_hi(qu);
            const float rk = rsqrtf(wave_sum(k0 * k0 + k1 * k1) * (1.f / HD) + EPS), rq = rsqrtf(wave_sum(q0 * q0 + q1 * q1) * (1.f / HD) + EPS);
            k0 *= rk * kw.x; k1 *= rk * kw.y; q0 *= rq * qw.x; q1 *= rq * qw.y;
            c0 += k0; c1 += k1;
            *kp = pk2(k0, k1); *qp = pk2(q0, q1);
        }
        *(LAS f32x2*)(cs + wave * 128 + 2 * lane) = (f32x2){c0, c1};
        __syncthreads();
        if (threadIdx.x < 128) { float s = 0.f;
#pragma unroll
            for (int w8 = 0; w8 < 8; ++w8) s += cs[w8 * 128 + threadIdx.x];
            KM[(size_t)item * HD + threadIdx.x] = s * (1.f / 256.f); }
        __syncthreads();
    }
}
__device__ __forceinline__ void att_sel_phase(const Args& a, LAS unsigned char* lds, int wave, int lane) {
    const bf16_t* Qb = (const bf16_t*)(a.ws + WS_Q2); const float* KM = (const float*)(a.ws + WS_KM);
    unsigned short* LISTS = (unsigned short*)(a.ws + WS_SEL); int* CNTS = (int*)(a.ws + WS_SELCNT); unsigned* TOT = (unsigned*)(a.ws + WS_CTL) + CW_TOT; int* SELX = (int*)(a.ws + WS_SELX);
    LAS float* kms = (LAS float*)lds;
    LAS int* cnts = (LAS int*)(lds + 16384);
    const int tid = threadIdx.x;
    for (int item = blockIdx.x; item < B * NH * NBLK; item += gridDim.x) {
        const int bh = item >> 5, qb = item & 31, b = bh >> 3, h = bh & 7;
        for (int i = tid; i < qb * 128; i += 512) kms[i] = KM[(size_t)bh * NBLK * HD + i];
        if (tid < 32) cnts[tid] = 0;
        __syncthreads();
        if (tid < 256) {
            const size_t qrow = (size_t)bh * L + (size_t)qb * 256 + tid;
            u32x4 qv[16];
#pragma unroll
            for (int i = 0; i < 16; ++i) qv[i] = ((const GAS u32x4*)(Qb + qrow * HD))[i];
            float v0 = -INFINITY, v1 = -INFINITY, v2 = -INFINITY; int i0 = -1, i1 = -1, i2 = -1;
#pragma unroll 1
            for (int n = 0; n < qb; ++n) {
                const LAS f32x4* kp = (const LAS f32x4*)(kms + n * 128);
                float g = 0.f;
#pragma unroll
                for (int i = 0; i < 16; ++i) { const f32x4 ka = kp[2 * i], kb2 = kp[2 * i + 1];
                    g += bf_lo(qv[i].x) * ka.x + bf_hi(qv[i].x) * ka.y + bf_lo(qv[i].y) * ka.z + bf_hi(qv[i].y) * ka.w
                       + bf_lo(qv[i].z) * kb2.x + bf_hi(qv[i].z) * kb2.y + bf_lo(qv[i].w) * kb2.z + bf_hi(qv[i].w) * kb2.w; }
                if (g > v0) { v2 = v1; i2 = i1; v1 = v0; i1 = i0; v0 = g; i0 = n; }
                else if (g > v1) { v2 = v1; i2 = i1; v1 = g; i1 = n; }
                else if (g > v2) { v2 = g; i2 = n; }
            }
            const int sel[3] = {i0, i1, i2};
#pragma unroll
            for (int s = 0; s < 3; ++s) {
                const int j = sel[s];
                if (j >= 0) { const int p = __hip_atomic_fetch_add(&cnts[j], 1, __ATOMIC_RELAXED, __HIP_MEMORY_SCOPE_WORKGROUP); LISTS[((size_t)(bh * NBLK + j) * NBLK + qb) * 256 + p] = (unsigned short)(tid | (s << 8)); }
                SELX[((size_t)(b * L + qb * 256 + tid) * NH + h) * 3 + s] = j;
            }
        }
        __syncthreads();
        if (tid < qb) { const int c = cnts[tid]; CNTS[(size_t)(bh * NBLK + tid) * NBLK + qb] = c; if (c) __hip_atomic_fetch_add(TOT + bh * NBLK + tid, (unsigned)c, __ATOMIC_RELAXED, __HIP_MEMORY_SCOPE_AGENT); }
        __syncthreads();
    }
}

constexpr int AL_K = 0, AL_V = 32768, AL_P = 65536, AL_BT = 131072, AL_TAB = 135168;
struct QRow { int qpos; int valid; };
__device__ __forceinline__ void att_stage(LAS unsigned char* lds, const bf16_t* Kg, const bf16_t* Vg, int c, int buf, int wave) {
    const int tid = threadIdx.x;
#pragma unroll
    for (int i = 0; i < 2; ++i) { const int e = tid + 512 * i, row = e >> 4, p = e & 15, ch = p ^ (((row & 3) << 2) | ((row >> 2) & 3));
        const size_t o = (size_t)c * 64 * HD + (size_t)row * HD + ch * 8;
        __builtin_amdgcn_global_load_lds((const unsigned*)(Kg + o), (LAS unsigned*)(lds + AL_K + buf * 16384 + wave * 1024 + i * 8192), 16, 0, 0);
        __builtin_amdgcn_global_load_lds((const unsigned*)(Vg + o), (LAS unsigned*)(lds + AL_V + buf * 16384 + wave * 1024 + i * 8192), 16, 0, 0); }
}
template <bool OWN>
__device__ __forceinline__ void att_tile(LAS unsigned char* lds, const bf16_t* Kg, const bf16_t* Vg, const bf16_t* const (&qptr)[2], const QRow (&qr)[2], const int (&xblk)[2], int kbase,
                                         f32x4 (&O)[8][2], float (&lsum)[2], int wave, int lane) {
    const int fr = lane & 15, fq = lane >> 4;
    const unsigned lds0 = (unsigned)(size_t)lds;
    LAS unsigned char* Pw = lds + AL_P + wave * 8192;
    const LAS float* bt = (const LAS float*)(lds + AL_BT);
    bf16x8 qf[2][4];
#pragma unroll
    for (int x = 0; x < 2; ++x)
#pragma unroll
        for (int ks = 0; ks < 4; ++ks) qf[x][ks] = *(const GAS bf16x8*)(qptr[x] + 32 * ks + 8 * fq);
#pragma unroll
    for (int db = 0; db < 8; ++db)
#pragma unroll
        for (int x = 0; x < 2; ++x) O[db][x] = (f32x4){0.f, 0.f, 0.f, 0.f};
    lsum[0] = 0.f; lsum[1] = 0.f;
    __syncthreads();
    att_stage(lds, Kg, Vg, 0, 0, wave);
    asm volatile("s_waitcnt vmcnt(0)" ::: "memory");
    __syncthreads();
    for (int c = 0; c < 4; ++c) {
        const int buf = c & 1;
        if (c < 3) att_stage(lds, Kg, Vg, c + 1, buf ^ 1, wave);
        bool act[2];
#pragma unroll
        for (int x = 0; x < 2; ++x) act[x] = OWN ? (64 * c <= 16 * xblk[x] + 15) : true;
        if (act[0] || act[1]) {
#pragma unroll
            for (int kb = 0; kb < 4; ++kb) {
                bf16x8 ka[4];
#pragma unroll
                for (int ks = 0; ks < 4; ++ks) ka[ks] = *(const LAS bf16x8*)(lds + AL_K + buf * 16384 + row_rd16(lane, kb, ks));
#pragma unroll
                for (int x = 0; x < 2; ++x) {
                    if (!act[x]) continue;
                    f32x4 s = (f32x4){0.f, 0.f, 0.f, 0.f};
#pragma unroll
                    for (int ks = 0; ks < 4; ++ks) s = __builtin_amdgcn_mfma_f32_16x16x32_bf16(ka[ks], qf[x][ks], s, 0, 0, 0);
                    const int key0 = kbase + 64 * c + 16 * kb + 4 * fq;
                    float p[4];
#pragma unroll
                    for (int r = 0; r < 4; ++r) { const int dist = qr[x].qpos - (key0 + r); const int idx = dist < 0 ? 0 : (dist > 1023 ? 1023 : dist);
                        const float e = __builtin_amdgcn_exp2f(s[r] * ATT_C1 + bt[idx]);
                        p[r] = (qr[x].valid && dist >= 0) ? e : 0.f; lsum[x] += p[r]; }
                    u32x2 o; o.x = pk2(p[0], p[1]); o.y = pk2(p[2], p[3]);
                    *(LAS u32x2*)(Pw + elem_off(16 * x + fr, 16 * kb + 4 * fq)) = o;
                }
            }
#pragma unroll
            for (int db = 0; db < 8; ++db) {
                bf16x8 vf[2];
#pragma unroll
                for (int ks = 0; ks < 2; ++ks) vf[ks] = tr_frag(lds0 + AL_V + buf * 16384 + tr_rd16(lane, db, ks, 0), lds0 + AL_V + buf * 16384 + tr_rd16(lane, db, ks, 1));
#pragma unroll
                for (int x = 0; x < 2; ++x) {
                    if (!act[x]) continue;
#pragma unroll
                    for (int ks = 0; ks < 2; ++ks) { const bf16x8 pb = *(const LAS bf16x8*)(Pw + row_rd16(lane, x, ks)); O[db][x] = __builtin_amdgcn_mfma_f32_16x16x32_bf16(vf[ks], pb, O[db][x], 0, 0, 0); }
                }
            }
        }
        asm volatile("s_waitcnt vmcnt(0)" ::: "memory");
        __syncthreads();
    }
#pragma unroll
    for (int x = 0; x < 2; ++x) { lsum[x] += __shfl_xor(lsum[x], 16); lsum[x] += __shfl_xor(lsum[x], 32); }
}
__device__ __forceinline__ void att_load_bias(const Args& a, LAS unsigned char* lds, int h) {
    LAS float* bt = (LAS float*)(lds + AL_BT); LAS float* red = (LAS float*)(lds + AL_TAB + 8192);
    const int tid = threadIdx.x;
    float m = 0.f;
    if (tid < 128) m = fabsf(a.in[11][tid]);
    else if (tid < 256) m = fabsf(a.in[9][tid - 128]);
    else m = fabsf(a.in[13][tid - 256]);
#pragma unroll
    for (int o = 1; o < 64; o <<= 1) m = fmaxf(m, __shfl_xor(m, o));
    if ((tid & 63) == 0) red[tid >> 6] = m;
    __syncthreads();
    const float mq = fmaxf(red[0], red[1]), mk = fmaxf(red[2], red[3]), mb = fmaxf(fmaxf(red[4], red[5]), fmaxf(red[6], red[7]));
    const float M = 128.f * 0.08838834764831845f * mq * mk * 1.02f + mb;
    const float* bias_tab = (const float*)(a.ws + WS_SMALL) + 2048 + h * 1024;
    for (int i = tid; i < 1024; i += 512) bt[i] = (bias_tab[i] - M) * 1.4426950408889634f;
    __syncthreads();
}
__device__ __forceinline__ void att_selatt_phase(const Args& a, LAS unsigned char* lds, int wave, int lane) {
    const bf16_t* Kb = (const bf16_t*)(a.ws + WS_K2); const bf16_t* Vb = (const bf16_t*)(a.ws + WS_V2); const bf16_t* Qb = (const bf16_t*)(a.ws + WS_Q2);
    const unsigned short* LISTS = (const unsigned short*)(a.ws + WS_SEL); const int* CNTS = (const int*)(a.ws + WS_SELCNT); const unsigned* TOT = (const unsigned*)(a.ws + WS_CTL) + CW_TOT;
    bf16_t* OP = (bf16_t*)(a.ws + WS_OP); float* LP = (float*)(a.ws + WS_LP);
    LAS int* pfx = (LAS int*)(lds + AL_TAB);
    LAS int* seg = (LAS int*)(lds + AL_TAB + 4352);
    const int tid = threadIdx.x, fr = lane & 15, fq = lane >> 4;
    if (wave == 0) {
        int loc[16]; int s = 0;
#pragma unroll
        for (int i = 0; i < 16; ++i) { const unsigned t = __hip_atomic_load(TOT + lane * 16 + i, __ATOMIC_RELAXED, __HIP_MEMORY_SCOPE_AGENT); loc[i] = s; s += (int)((t + 255u) >> 8); }
        int inc = s;
#pragma unroll
        for (int o = 1; o < 64; o <<= 1) { const int v = __shfl_up(inc, o); if (lane >= o) inc += v; }
        const int excl = inc - s;
#pragma unroll
        for (int i = 0; i < 16; ++i) pfx[lane * 16 + i] = excl + loc[i];
        if (lane == 63) pfx[1024] = inc;
    }
    __syncthreads();
    const int ntiles = pfx[1024];
    int cur_h = -1;
    for (int g = blockIdx.x; g < ntiles; g += gridDim.x) {
        int lo = 0, hi = 1024;
        while (hi - lo > 1) { const int mid = (lo + hi) >> 1; if (pfx[mid] <= g) lo = mid; else hi = mid; }
        const int lid = lo, ti = g - pfx[lid], bh = lid >> 5, j = lid & 31, h = bh & 7;
        __syncthreads();
        if (h != cur_h) { att_load_bias(a, lds, h); cur_h = h; }
        if (tid == 0) { int s = 0; for (int qb = 0; qb < NBLK; ++qb) { seg[qb] = s; if (qb > j) s += CNTS[(size_t)lid * NBLK + qb]; } seg[NBLK] = s; }
        __syncthreads();
        const int total = seg[NBLK];
        const bf16_t* qptr[2]; QRow qr[2]; int slot[2]; int xblk[2] = {0, 0};
#pragma unroll
        for (int x = 0; x < 2; ++x) {
            const int R = ti * 256 + 32 * wave + 16 * x + fr;
            qr[x].valid = R < total; qr[x].qpos = 0; slot[x] = 0;
            if (qr[x].valid) { int qb = j + 1;
#pragma unroll 1
                for (int k = j + 2; k < NBLK; ++k) if (seg[k] <= R) qb = k;
                const unsigned e = LISTS[((size_t)lid * NBLK + qb) * 256 + (R - seg[qb])];
                qr[x].qpos = qb * 256 + (int)(e & 255u); slot[x] = (int)(e >> 8); }
            qptr[x] = Qb + ((size_t)bh * L + qr[x].qpos) * HD;
        }
        f32x4 O[8][2]; float lsum[2];
        att_tile<false>(lds, Kb + ((size_t)bh * L + j * 256) * HD, Vb + ((size_t)bh * L + j * 256) * HD, qptr, qr, xblk, j * 256, O, lsum, wave, lane);
#pragma unroll
        for (int x = 0; x < 2; ++x) if (qr[x].valid) {
            const size_t ro = ((size_t)bh * L + qr[x].qpos) * 3 + slot[x];
#pragma unroll
            for (int db = 0; db < 8; ++db) { u32x2 o; o.x = pk2(O[db][x][0], O[db][x][1]); o.y = pk2(O[db][x][2], O[db][x][3]); *(u32x2*)(OP + ro * HD + 16 * db + 4 * fq) = o; }
            if (fq == 0) LP[ro] = lsum[x];
        }
    }
}
__device__ __forceinline__ void att_own_phase(const Args& a, LAS unsigned char* lds, int wave, int lane) {
    const bf16_t* Kb = (const bf16_t*)(a.ws + WS_K2); const bf16_t* Vb = (const bf16_t*)(a.ws + WS_V2); const bf16_t* Qb = (const bf16_t*)(a.ws + WS_Q2);
    const bf16_t* OP = (const bf16_t*)(a.ws + WS_OP); const float* LP = (const float*)(a.ws + WS_LP); bf16_t* ATT = (bf16_t*)(a.ws + WS_ATT);
    const int fr = lane & 15, fq = lane >> 4;
    int cur_h = -1;
    for (int item = blockIdx.x; item < B * NH * NBLK; item += gridDim.x) {
        const int bh = item >> 5, qb = item & 31, b = bh >> 3, h = bh & 7;
        __syncthreads();
        if (h != cur_h) { att_load_bias(a, lds, h); cur_h = h; }
        const bf16_t* qptr[2]; QRow qr[2]; int xblk[2] = {wave, 15 - wave};
#pragma unroll
        for (int x = 0; x < 2; ++x) { qr[x].valid = 1; qr[x].qpos = qb * 256 + 16 * xblk[x] + fr; qptr[x] = Qb + ((size_t)bh * L + qr[x].qpos) * HD; }
        f32x4 O[8][2]; float lsum[2];
        att_tile<true>(lds, Kb + ((size_t)bh * L + qb * 256) * HD, Vb + ((size_t)bh * L + qb * 256) * HD, qptr, qr, xblk, qb * 256, O, lsum, wave, lane);
        const int nsel = qb < 3 ? qb : 3;
#pragma unroll
        for (int x = 0; x < 2; ++x) {
            const size_t ro = ((size_t)bh * L + qr[x].qpos) * 3;
            float l = lsum[x];
            for (int s = 0; s < nsel; ++s) { l += LP[ro + s];
#pragma unroll
                for (int db = 0; db < 8; ++db) { const u32x2 p = *(const u32x2*)(OP + (ro + s) * HD + 16 * db + 4 * fq);
                    O[db][x][0] += bf_lo(p.x); O[db][x][1] += bf_hi(p.x); O[db][x][2] += bf_lo(p.y); O[db][x][3] += bf_hi(p.y); } }
            const float inv = 1.0f / l;
            bf16_t* orow = ATT + ((size_t)b * L + qr[x].qpos) * D + h * HD;
#pragma unroll
            for (int db = 0; db < 8; ++db) { u32x2 o; o.x = pk2(O[db][x][0] * inv, O[db][x][1] * inv); o.y = pk2(O[db][x][2] * inv, O[db][x][3] * inv); *(u32x2*)(orow + 16 * db + 4 * fq) = o; }
        }
    }
}
enum Phase { PH_PROLOGUE = 0, PH_INPROJ, PH_GLA_A, PH_GLA_SCAN, PH_GLA_C, PH_OUTPROJ, PH_END_S1,
             PH_M0_ROUTE = PH_END_S1, PH_M0_G1, PH_M0_G2, PH_M0_COMB, PH_END_S2,
             PH_A_NORM = PH_END_S2, PH_A_KVQ, PH_A_POST, PH_A_SEL, PH_A_SELATT, PH_A_OWN, PH_A_OPROJ, PH_END_S3,
             PH_M1_ROUTE = PH_END_S3, PH_M1_G1, PH_M1_G2, PH_M1_COMB, PH_END_S4,
             PH_COUNT = PH_END_S4 };
#define MOE_PHASES(base, layer) \
    if (IN(base)) moe_route_phase(a, lds, layer, a.xin, wave, lane); \
    SEAM(base); \
    if (IN((base) + 1)) { moe_tables(a, lds, layer); MoeOrder1 S; S.tst = (const LAS int*)(lds + LDS_MOE_TAB); S.cn = S.tst + 64; S.list = (const int*)(ws + WS_LIST); \
        S.A = (const bf16_t*)(ws + WS_XN); S.Bt = (const bf16_t*)(ws + WS_MWIN) + (size_t)(layer) * NEXP * 1024 * 1024; S.K = D; S.bstride = (size_t)1024 * 1024 * 2; S.G = gridDim.x; S.c = blockIdx.x; S.ntot = S.tst[NEXP]; \
        EpiAct E{(bf16_t*)(ws + WS_ACT)}; gemm_phase<EpiAct, MoeOrder1>(lds, S, E); } \
    SEAM((base) + 1); \
    if (IN((base) + 2)) { moe_tables(a, lds, layer); MoeOrder2 S; S.tst = (const LAS int*)(lds + LDS_MOE_TAB); S.cn = S.tst + 64; S.list = (const int*)(ws + WS_LIST); \
        S.A = (const bf16_t*)(ws + WS_ACT); S.Bt = (const bf16_t*)(ws + WS_MWOUT) + (size_t)(layer) * NEXP * 1024 * 512; S.K = FF; S.bstride = (size_t)1024 * 512 * 2; S.G = gridDim.x; S.c = blockIdx.x; S.ntot = S.tst[NEXP]; \
        EpiY E{(bf16_t*)(ws + WS_YB), (const int*)(ws + WS_LIST), (const float*)(ws + WS_WGT), S.cn}; gemm_phase<EpiY, MoeOrder2>(lds, S, E); } \
    SEAM((base) + 2); \
    if (IN((base) + 3)) moe_combine_phase(a, a.xin, a.out, wave, lane);


__global__ void __launch_bounds__(512, 2) fwd(Args a) {
    extern __shared__ __attribute__((aligned(16))) unsigned char smem[];
    LAS unsigned char* lds = (LAS unsigned char*)smem;
    const int tid = threadIdx.x, lane = tid & 63, wave = __builtin_amdgcn_readfirstlane(tid >> 6);
    volatile LAS unsigned* MISC = (volatile LAS unsigned*)(lds + LDS_MISC);
    if (tid < 4) MISC[tid] = 0u;
    __syncthreads();
    unsigned* ctl = (unsigned*)(a.ws + WS_CTL);
    XcdBarrier bar = xcd_barrier_post(ctl + CW_BAR, MISC);
    const int lo = a.ph_lo, hi = a.ph_hi;
    unsigned char* ws = a.ws;
#define IN(k) (lo <= (k) && (k) < hi)
#define SEAM(k) do { if (IN(k) && IN((k) + 1)) xcd_barrier(bar); } while (0)
    if (IN(PH_PROLOGUE)) { p0_prologue(a, lds, wave, lane); }
    SEAM(PH_PROLOGUE);
    if (IN(PH_INPROJ)) {
        DenseOrder S; S.init((const bf16_t*)(ws + WS_XN), (const bf16_t*)(ws + WS_WIN), T, 4096, D, gridDim.x, blockIdx.x);
        EpiHG E{(bf16_t*)(ws + WS_Q), (const float*)(ws + WS_SMALL)};
        gemm_phase<EpiHG, DenseOrder>(lds, S, E);
    }
    SEAM(PH_INPROJ);
    if (IN(PH_GLA_A)) gla_phase<0>(a, lds, wave, lane);
    SEAM(PH_GLA_A);
    if (IN(PH_GLA_SCAN)) gla_scan(a);
    SEAM(PH_GLA_SCAN);
    if (IN(PH_GLA_C)) gla_phase<1>(a, lds, wave, lane);
    SEAM(PH_GLA_C);
    if (IN(PH_OUTPROJ)) {
        DenseOrder S; S.init((const bf16_t*)(ws + WS_OG), (const bf16_t*)(ws + WS_WOUT), T, D, D, gridDim.x, blockIdx.x);
        EpiRes E{a.out, a.in[0], D};
        gemm_phase<EpiRes, DenseOrder>(lds, S, E);
    }
    SEAM(PH_OUTPROJ);
    MOE_PHASES(PH_M0_ROUTE, 0)
    SEAM(PH_M0_COMB);
    if (IN(PH_A_NORM)) att_norm_phase(a, wave, lane);
    SEAM(PH_A_NORM);
    if (IN(PH_A_KVQ)) {
        DenseOrder S; S.init((const bf16_t*)(ws + WS_XN), (const bf16_t*)(ws + WS_WKVQ), T, 3072, D, gridDim.x, blockIdx.x);
        EpiKVQ E{(bf16_t*)(ws + WS_K2)};
        gemm_phase<EpiKVQ, DenseOrder>(lds, S, E);
    }
    SEAM(PH_A_KVQ);
    if (IN(PH_A_POST)) att_post_phase(a, lds, wave, lane);
    SEAM(PH_A_POST);
    if (IN(PH_A_SEL)) att_sel_phase(a, lds, wave, lane);
    SEAM(PH_A_SEL);
    if (IN(PH_A_SELATT)) att_selatt_phase(a, lds, wave, lane);
    SEAM(PH_A_SELATT);
    if (IN(PH_A_OWN)) att_own_phase(a, lds, wave, lane);
    SEAM(PH_A_OWN);
    if (IN(PH_A_OPROJ)) {
        DenseOrder S; S.init((const bf16_t*)(ws + WS_ATT), (const bf16_t*)(ws + WS_WO), T, D, D, gridDim.x, blockIdx.x);
        EpiRes E{a.out, a.xin, D};
        gemm_phase<EpiRes, DenseOrder>(lds, S, E);
    }
    SEAM(PH_A_OPROJ);
    MOE_PHASES(PH_M1_ROUTE, 1)
#undef IN
#undef SEAM
}
}

static int g_grid = 0;
static void fast_launch(void* const* d_in, const float* xin, float* d_out, void* d_ws, hipStream_t stream, int lo, int hi, bool per_phase) {
    if (g_grid == 0) {
        int dev = 0, cus = 0;
        if (hipGetDevice(&dev) != hipSuccess || hipDeviceGetAttribute(&cus, hipDeviceAttributeMultiprocessorCount, dev) != hipSuccess) { fprintf(stderr, "kernel_launch: device query failed\n"); g_grid = -1; return; }
        if (hipFuncSetAttribute((const void*)fk::fwd, hipFuncAttributeMaxDynamicSharedMemorySize, fk::LDS_BYTES) != hipSuccess) { fprintf(stderr, "kernel_launch: hipFuncSetAttribute failed\n"); g_grid = -1; return; }
        int per_cu = 0;
        if (hipOccupancyMaxActiveBlocksPerMultiprocessor(&per_cu, (const void*)fk::fwd, 512, fk::LDS_BYTES) != hipSuccess || per_cu < 1) fprintf(stderr, "kernel_launch: occupancy query says %d\n", per_cu);
        (void)hipGetLastError();
        g_grid = cus;
    }
    if (g_grid < 0) return;
    fk::Args a{};
    for (int i = 0; i < 20; ++i) a.in[i] = (const float*)d_in[i];
    a.out = d_out; a.xin = xin; a.ws = (unsigned char*)d_ws;
    (void)hipMemsetAsync((char*)d_ws + fk::WS_CTL, 0, fk::CTL_ZERO_BYTES, stream);
    if (per_phase) {
        for (int p = lo; p < hi; ++p) { a.ph_lo = p; a.ph_hi = p + 1; hipLaunchKernelGGL(fk::fwd, dim3(g_grid), dim3(512), fk::LDS_BYTES, stream, a); }
    } else {
        a.ph_lo = lo; a.ph_hi = hi;
        hipLaunchKernelGGL(fk::fwd, dim3(g_grid), dim3(512), fk::LDS_BYTES, stream, a);
    }
    const hipError_t le = hipPeekAtLastError();
    if (le != hipSuccess) fprintf(stderr, "kernel_launch: launch failed: %s\n", hipGetErrorName(le));
}


extern "C" void kernel_launch(void* const* d_in, const int* in_sizes, int n_in, void* d_out, int out_size, void* d_ws, size_t ws_size, hipStream_t stream) {
    if (n_in != 20 || out_size != fk::T * fk::D || ws_size < fk::WS_END) { fprintf(stderr, "kernel_launch: unexpected shapes n_in %d out %d ws %zu\n", n_in, out_size, ws_size); return; }
    float* X = (float*)d_out; unsigned char* ws = (unsigned char*)d_ws;
    const size_t N = (size_t)fk::T * fk::D;
#if DBG_STAGE == 0
    fast_launch(d_in, X, X, d_ws, stream, fk::PH_PROLOGUE, fk::PH_END_S4, HYB_PER_PHASE);
#else
    float* TMP = (float*)(ws + 800 * fk::MiB); unsigned short* FB = (unsigned short*)(ws + 928 * fk::MiB); double* ACC = (double*)(ws + 1000 * fk::MiB);
    (void)hipMemsetAsync(ACC, 0, 64, stream);
#if DBG_STAGE == 1
    fast_launch(d_in, X, TMP, d_ws, stream, fk::PH_PROLOGUE, fk::PH_END_S1, HYB_PER_PHASE);
    hipLaunchKernelGGL(dbg::k_store, dim3(4096), dim3(256), 0, stream, (const float*)TMP, (const float*)d_in[0], FB, N);
    slow::stage1(d_in, X, ws, stream);
    hipLaunchKernelGGL(dbg::k_cmp, dim3(4096), dim3(256), 0, stream, (const unsigned short*)FB, (const float*)X, (const float*)d_in[0], 0, ACC, N);
    slow::stage_moe(d_in, X, ws, stream, 0);
    slow::stage3(d_in, X, ws, stream);
    slow::stage_moe(d_in, X, ws, stream, 1);
#elif DBG_STAGE == 2
    slow::stage1(d_in, X, ws, stream);
    fast_launch(d_in, X, TMP, d_ws, stream, fk::PH_PROLOGUE, fk::PH_PROLOGUE + 1, HYB_PER_PHASE);
    fast_launch(d_in, X, TMP, d_ws, stream, fk::PH_M0_ROUTE, fk::PH_END_S2, HYB_PER_PHASE);
    hipLaunchKernelGGL(dbg::k_store, dim3(4096), dim3(256), 0, stream, (const float*)TMP, (const float*)X, FB, N);
    slow::stage_moe(d_in, X, ws, stream, 0);
    hipLaunchKernelGGL(dbg::k_cmp, dim3(4096), dim3(256), 0, stream, (const unsigned short*)FB, (const float*)(ws + 672 * fk::MiB), (const float*)nullptr, 1, ACC, N);
    slow::stage3(d_in, X, ws, stream);
    slow::stage_moe(d_in, X, ws, stream, 1);
#elif DBG_STAGE == 3
    slow::stage1(d_in, X, ws, stream);
    slow::stage_moe(d_in, X, ws, stream, 0);
    fast_launch(d_in, X, TMP, d_ws, stream, fk::PH_PROLOGUE, fk::PH_PROLOGUE + 1, HYB_PER_PHASE);
    fast_launch(d_in, X, TMP, d_ws, stream, fk::PH_A_NORM, fk::PH_END_S3, HYB_PER_PHASE);
    hipLaunchKernelGGL(dbg::k_store, dim3(4096), dim3(256), 0, stream, (const float*)TMP, (const float*)X, FB, N);
    slow::stage3(d_in, X, ws, stream, (const int*)(ws + fk::WS_SELX), (float*)(ws + 672 * fk::MiB));
    hipLaunchKernelGGL(dbg::k_cmp, dim3(4096), dim3(256), 0, stream, (const unsigned short*)FB, (const float*)(ws + 672 * fk::MiB), (const float*)nullptr, 2, ACC, N);
    slow::stage_moe(d_in, X, ws, stream, 1);
#endif
    hipLaunchKernelGGL(dbg::k_scale, dim3(4096), dim3(256), 0, stream, X, (const double*)ACC, N);
#endif
}
```

```cpp
#include <hip/hip_runtime.h>
#include <cstdio>
#include <cstdint>
#include <cmath>
#ifndef HYB_PER_PHASE
#define HYB_PER_PHASE false
#endif
#ifndef DBG_STAGE
#define DBG_STAGE 0
#endif
namespace slow {
constexpr int B = 4, L = 8192, D = 1024, T = B * L, NH = 8, HD = 128, NEXP = 32, FF = 512, NBLK = 32, BLK = 256;
constexpr int CAP = T * 2 + NEXP * 256;
constexpr float EPS = 1e-6f;

__device__ __forceinline__ float wsum(float v) {
#pragma unroll
    for (int o = 1; o < 64; o <<= 1) v += __shfl_xor(v, o);
    return v;
}
__device__ __forceinline__ float wmax(float v) {
#pragma unroll
    for (int o = 1; o < 64; o <<= 1) v = fmaxf(v, __shfl_xor(v, o));
    return v;
}
__device__ __forceinline__ int t5_bucket(int n) {
    if (n < 16) return n;
    const float lr = logf((float)n / 16.0f) / 4.1588830833596715f;
    int large = 16 + (int)(lr * 16.0f);
    return large < 31 ? large : 31;
}
__global__ void k_prep(const float* __restrict__ hg_lb, const float* __restrict__ rel_bias, float* lb, float* bias_tab) {
    const int i = blockIdx.x * blockDim.x + threadIdx.x;
    if (i < 1024) { const float a = hg_lb[i], b = hg_lb[1024 + i], m = fmaxf(a, b), ea = expf(a - m), eb = expf(b - m); lb[i] = ea / (ea + eb); }
    if (i < 8 * 1024) { const int h = i >> 10, d = i & 1023; bias_tab[i] = rel_bias[t5_bucket(d) * 8 + h]; }
}
template <int N> __global__ void k_rmsnorm(const float* __restrict__ x, const float* __restrict__ w, float* __restrict__ y, int rows) {
    const int row = blockIdx.x * (blockDim.x >> 6) + (threadIdx.x >> 6), lane = threadIdx.x & 63;
    if (row >= rows) return;
    const float* xr = x + (size_t)row * N; float* yr = y + (size_t)row * N;
    float s = 0.f;
    for (int i = lane; i < N; i += 64) { const float v = xr[i]; s += v * v; }
    s = wsum(s);
    const float r = rsqrtf(s * (1.0f / N) + EPS);
    for (int i = lane; i < N; i += 64) yr[i] = xr[i] * r * w[i];
}
__global__ void k_headnorm(const float* __restrict__ x, int ld, int col0, const float* __restrict__ w, float* __restrict__ y, int ldy) {
    const int gw = blockIdx.x * (blockDim.x >> 6) + (threadIdx.x >> 6), lane = threadIdx.x & 63;
    if (gw >= T * NH) return;
    const int t = gw >> 3, h = gw & 7;
    const float* xr = x + (size_t)t * ld + col0 + h * HD;
    const float a = xr[lane], b = xr[lane + 64];
    const float s = wsum(a * a + b * b);
    const float r = rsqrtf(s * (1.0f / HD) + EPS);
    float* yr = y + (size_t)t * ldy + h * HD;
    yr[lane] = a * r * w[lane]; yr[lane + 64] = b * r * w[lane + 64];
}
struct GemmP {
    const float* A; int lda; const int* arow;
    const float* W; int ldw; size_t wstride; const int* tile_e;
    float* C; int ldc; const int* crow; const float* cscale; const float* R;
    int M, N, K, pad;
};
__global__ __launch_bounds__(256) void k_gemm(GemmP p) {
    __shared__ float As[16][68];
    __shared__ float Ws[16][68];
    const int tm = blockIdx.y, tn = blockIdx.x, tid = threadIdx.x;
    int e = 0;
    if (p.tile_e) { e = p.tile_e[tm]; if (e < 0) return; }
    const float* W = p.W + (size_t)e * p.wstride;
    const int ar = tid >> 2, ak = (tid & 3) * 4;
    const int wk = tid >> 4, wn = (tid & 15) * 4;
    const int m0 = tm * 64, n0 = tn * 64;
    int arow = m0 + ar; if (p.arow) { arow = p.arow[m0 + ar]; if (arow < 0) arow = 0; }
    const float* Ap = p.A + (size_t)arow * p.lda + ak;
    const float* Wp = W + (size_t)wk * p.ldw + n0 + wn;
    const int ty = tid >> 4, tx = tid & 15;
    float acc[4][4];
#pragma unroll
    for (int i = 0; i < 4; ++i)
#pragma unroll
        for (int j = 0; j < 4; ++j) acc[i][j] = 0.f;
    for (int k0 = 0; k0 < p.K; k0 += 16) {
        const float4 av = *(const float4*)(Ap + k0);
        const float4 wv = *(const float4*)(Wp + (size_t)k0 * p.ldw);
        __syncthreads();
        As[ak + 0][ar] = av.x; As[ak + 1][ar] = av.y; As[ak + 2][ar] = av.z; As[ak + 3][ar] = av.w;
        *(float4*)&Ws[wk][wn] = wv;
        __syncthreads();
#pragma unroll
        for (int kk = 0; kk < 16; ++kk) {
            const float4 a = *(const float4*)&As[kk][ty * 4];
            const float4 b = *(const float4*)&Ws[kk][tx * 4];
            const float aa[4] = {a.x, a.y, a.z, a.w}, bb[4] = {b.x, b.y, b.z, b.w};
#pragma unroll
            for (int i = 0; i < 4; ++i)
#pragma unroll
                for (int j = 0; j < 4; ++j) acc[i][j] += aa[i] * bb[j];
        }
    }
#pragma unroll
    for (int i = 0; i < 4; ++i) {
        const int m = m0 + ty * 4 + i;
        int cr = m; float sc = 1.f;
        if (p.crow) { cr = p.crow[m]; if (cr < 0) continue; }
        if (p.cscale) sc = p.cscale[cr];
        float* Cp = p.C + (size_t)cr * p.ldc + n0 + tx * 4;
        float4 o = make_float4(acc[i][0] * sc, acc[i][1] * sc, acc[i][2] * sc, acc[i][3] * sc);
        if (p.R) { const float4 r = *(const float4*)(p.R + (size_t)cr * p.ldc + n0 + tx * 4); o.x += r.x; o.y += r.y; o.z += r.z; o.w += r.w; }
        *(float4*)Cp = o;
    }
}
__global__ void k_hg_gates(float* proj, const float* __restrict__ lb) {
    const size_t i = (size_t)blockIdx.x * blockDim.x + threadIdx.x;
    if (i >= (size_t)T * 1024) return;
    const size_t t = i >> 10; const int c = (int)(i & 1023);
    float* row = proj + t * 4096;
    row[c] *= 0.08838834764831845f;
    const float l = lb[c], z = row[1024 + c];
    row[1024 + c] = l + (1.f - l) * (1.f / (1.f + expf(-z)));
}
__global__ __launch_bounds__(128) void k_gla(const float* __restrict__ proj, float* __restrict__ o) {
    const int bh = blockIdx.x, b = bh >> 3, h = bh & 7, dv = threadIdx.x;
    float S[128];
#pragma unroll
    for (int d = 0; d < 128; ++d) S[d] = 0.f;
    const float* base = proj + (size_t)b * L * 4096 + h * 128;
    for (int t = 0; t < L; ++t) {
        const float* row = base + (size_t)t * 4096;
        const float v = row[2048 + dv];
        float acc = 0.f;
#pragma unroll
        for (int d = 0; d < 128; ++d) { const float f = row[1024 + d], q = row[d]; S[d] = f * S[d] + (1.f - f) * v; acc += q * S[d]; }
        o[((size_t)b * L + t) * 1024 + h * 128 + dv] = acc;
    }
}
__global__ void k_onorm_gate(const float* __restrict__ o, const float* __restrict__ proj, const float* __restrict__ w, float* __restrict__ og) {
    const int gw = blockIdx.x * (blockDim.x >> 6) + (threadIdx.x >> 6), lane = threadIdx.x & 63;
    if (gw >= T * NH) return;
    const int t = gw >> 3, h = gw & 7;
    const float* xr = o + (size_t)t * 1024 + h * HD;
    const float a = xr[lane], b = xr[lane + 64];
    const float r = rsqrtf(wsum(a * a + b * b) * (1.0f / HD) + EPS);
    const float* g = proj + (size_t)t * 4096 + 3072 + h * HD;
    const float g0 = g[lane], g1 = g[lane + 64];
    float* yr = og + (size_t)t * 1024 + h * HD;
    yr[lane] = a * r * w[lane] * (g0 / (1.f + expf(-g0)));
    yr[lane + 64] = b * r * w[lane + 64] * (g1 / (1.f + expf(-g1)));
}
__global__ void k_route(const float* __restrict__ h2, const float* __restrict__ wg, const float* __restrict__ bg, const float* __restrict__ we, const float* __restrict__ be,
                        int* cnt, int* list, float* wgt) {
    const int t = blockIdx.x * (blockDim.x >> 6) + (threadIdx.x >> 6), lane = threadIdx.x & 63;
    if (t >= T) return;
    const float* xr = h2 + (size_t)t * D;
    float acc = 0.f;
    const bool isg = lane < 4, ise = lane >= 32;
    for (int k = 0; k < D; ++k) {
        const float xv = xr[k];
        float w = 0.f;
        if (isg) w = wg[k * 4 + lane]; else if (ise) w = we[k * 32 + (lane - 32)];
        acc += xv * w;
    }
    if (isg) acc += bg[lane]; else if (ise) acc += be[lane - 32];
    float gl[4];
#pragma unroll
    for (int i = 0; i < 4; ++i) gl[i] = __shfl(acc, i);
    int gi = 0; float gm = gl[0];
#pragma unroll
    for (int i = 1; i < 4; ++i) if (gl[i] > gm) { gm = gl[i]; gi = i; }
    float gs = 0.f;
#pragma unroll
    for (int i = 0; i < 4; ++i) gs += expf(gl[i] - gm);
    const float gw_ = 1.0f / gs;
    float el[8];
#pragma unroll
    for (int i = 0; i < 8; ++i) el[i] = __shfl(acc, 32 + gi * 8 + i);
    int i0 = 0; float m0 = el[0];
#pragma unroll
    for (int i = 1; i < 8; ++i) if (el[i] > m0) { m0 = el[i]; i0 = i; }
    int i1 = -1; float m1 = -INFINITY;
#pragma unroll
    for (int i = 0; i < 8; ++i) if (i != i0 && el[i] > m1) { m1 = el[i]; i1 = i; }
    const float p1 = expf(m1 - m0);
    const float w0 = gw_ / (1.f + p1), w1 = gw_ * p1 / (1.f + p1);
    if (lane == 0) {
        const int e0 = gi * 8 + i0, e1 = gi * 8 + i1;
        const int r0 = atomicAdd(&cnt[e0], 1); list[(size_t)e0 * (2 * T) + r0] = t * 2;     wgt[t * 2] = w0;
        const int r1 = atomicAdd(&cnt[e1], 1); list[(size_t)e1 * (2 * T) + r1] = t * 2 + 1; wgt[t * 2 + 1] = w1;
    }
}
__global__ void k_moe_rows(const int* __restrict__ cnt, const int* __restrict__ list, int* row_src, int* row_dst, int* tile_e) {
    const int r = blockIdx.x * blockDim.x + threadIdx.x;
    if (r >= CAP) return;
    int start = 0, e = -1, rank = 0;
    for (int i = 0; i < NEXP; ++i) { const int c = cnt[i], pc = (c + 255) & ~255; if (r >= start && r < start + pc) { e = i; rank = r - start; } start += pc; }
    int src = -1, dst = -1;
    if (e >= 0 && rank < cnt[e]) { dst = list[(size_t)e * (2 * T) + rank]; src = dst >> 1; }
    row_src[r] = src; row_dst[r] = dst;
    if ((r & 63) == 0) tile_e[r >> 6] = e;
}
__global__ void k_silu_mul(const float* __restrict__ hu, float* __restrict__ act) {
    const size_t i = (size_t)blockIdx.x * blockDim.x + threadIdx.x;
    if (i >= (size_t)CAP * FF) return;
    const size_t r = i / FF; const int c = (int)(i % FF);
    const float a = hu[r * 1024 + c], b = hu[r * 1024 + 512 + c];
    act[i] = a / (1.f + expf(-a)) * b;
}
__global__ void k_combine(float* x, const float* __restrict__ ybuf) {
    const size_t i = (size_t)blockIdx.x * blockDim.x + threadIdx.x;
    if (i >= (size_t)T * D) return;
    const size_t t = i >> 10; const int c = (int)(i & 1023);
    x[i] += ybuf[(t * 2) * D + c] + ybuf[(t * 2 + 1) * D + c];
}
__global__ void k_kv_split(const float* __restrict__ kv, const float* __restrict__ knw, float* __restrict__ K, float* __restrict__ V) {
    const int gw = blockIdx.x * (blockDim.x >> 6) + (threadIdx.x >> 6), lane = threadIdx.x & 63;
    if (gw >= T * NH) return;
    const int t = gw >> 3, h = gw & 7, b = t / L, pos = t % L;
    const float* kr = kv + (size_t)t * 2048 + h * HD;
    const float a = kr[lane], c = kr[lane + 64];
    const float r = rsqrtf(wsum(a * a + c * c) * (1.0f / HD) + EPS);
    const size_t o = (((size_t)b * NH + h) * L + pos) * HD;
    K[o + lane] = a * r * knw[lane]; K[o + lane + 64] = c * r * knw[lane + 64];
    V[o + lane] = kr[1024 + lane]; V[o + lane + 64] = kr[1024 + lane + 64];
}
__global__ void k_kmean(const float* __restrict__ K, float* __restrict__ km) {
    const int bhn = blockIdx.x, d = threadIdx.x;
    const float* p = K + (size_t)bhn * BLK * HD + d;
    float s = 0.f;
    for (int j = 0; j < BLK; ++j) s += p[(size_t)j * HD];
    km[(size_t)bhn * HD + d] = s * (1.0f / BLK);
}
__global__ __launch_bounds__(256) void k_moba(const float* __restrict__ q, const float* __restrict__ K, const float* __restrict__ V, const float* __restrict__ km,
                                              const float* __restrict__ bias_tab, float* __restrict__ att, int* __restrict__ sel_out, const int* __restrict__ sel_in) {
    __shared__ float qs[128];
    __shared__ float gate[32];
    __shared__ int selb[4];
    __shared__ float lg[4][256];
    __shared__ float red[8];
    __shared__ float osum[128];
    const int bid = blockIdx.x, t = bid >> 3, h = bid & 7, b = t / L, pos = t % L, blk = pos >> 8, tid = threadIdx.x, lane = tid & 63, wv = tid >> 6;
    if (tid < 128) qs[tid] = q[(size_t)t * 1024 + h * HD + tid];
    __syncthreads();
    const size_t bh = (size_t)b * NH + h;
    if (tid < 32) {
        float g = -INFINITY;
        if (tid < blk) { const float* kp = km + (bh * NBLK + tid) * HD; float s = 0.f; for (int d = 0; d < HD; ++d) s += qs[d] * kp[d]; g = s; }
        gate[tid] = g;
    }
    __syncthreads();
    const int nsel = blk < 3 ? blk : 3;
    if (tid == 0 && sel_in) { selb[0] = sel_in[(size_t)bid * 3 + 0]; selb[1] = sel_in[(size_t)bid * 3 + 1]; selb[2] = sel_in[(size_t)bid * 3 + 2]; selb[3] = blk; }
    if (tid == 0 && !sel_in) {
        int u0 = -1, u1 = -1;
        for (int s = 0; s < 3; ++s) {
            int bi = -1; float bv = -INFINITY;
            for (int n = 0; n < blk; ++n) { if (n == u0 || n == u1) continue; if (bi < 0 || gate[n] > bv) { bv = gate[n]; bi = n; } }
            selb[s] = bi; if (s == 0) u0 = bi; else if (s == 1) u1 = bi;
        }
        selb[3] = blk;
        if (sel_out) { sel_out[(size_t)bid * 3 + 0] = selb[0]; sel_out[(size_t)bid * 3 + 1] = selb[1]; sel_out[(size_t)bid * 3 + 2] = selb[2]; }
    }
    __syncthreads();
    const float scale = 0.08838834764831845f;
    float mx = -INFINITY;
    for (int s = 0; s < 4; ++s) {
        float l = -INFINITY;
        const bool on = (s == 3) || (s < nsel);
        if (on) {
            const int kb = selb[s], kpos = kb * BLK + tid, dist = pos - kpos;
            if (dist >= 0) {
                const float* kp = K + (bh * L + kpos) * HD; float a = 0.f;
                for (int d = 0; d < HD; ++d) a += qs[d] * kp[d];
                l = a * scale + bias_tab[h * 1024 + (dist < 1023 ? dist : 1023)];
            }
        }
        lg[s][tid] = l; mx = fmaxf(mx, l);
    }
    mx = wmax(mx); if (lane == 0) red[wv] = mx; __syncthreads();
    mx = fmaxf(fmaxf(red[0], red[1]), fmaxf(red[2], red[3])); __syncthreads();
    float sm = 0.f;
    for (int s = 0; s < 4; ++s) { const float l = lg[s][tid]; const float p = (l == -INFINITY) ? 0.f : expf(l - mx); lg[s][tid] = p; sm += p; }
    sm = wsum(sm); if (lane == 0) red[4 + wv] = sm; __syncthreads();
    sm = red[4] + red[5] + red[6] + red[7];
    const int d = tid & 127, half = tid >> 7;
    float o = 0.f;
    for (int s = 0; s < 4; ++s) {
        const bool on = (s == 3) || (s < nsel);
        if (!on) continue;
        const float* vp = V + (bh * L + (size_t)selb[s] * BLK + half * 128) * HD + d;
        for (int j = 0; j < 128; ++j) o += lg[s][half * 128 + j] * vp[(size_t)j * HD];
    }
    if (half == 1) osum[d] = o;
    __syncthreads();
    if (half == 0) att[(size_t)t * 1024 + h * HD + d] = (o + osum[d]) / sm;
}

struct Bufs {
    float *lb, *bias_tab, *wgt, *km; int *cnt, *list, *row_src, *row_dst, *tile_e, *sel;
    float *HN, *BIG, *O;
};
constexpr size_t MiB = 1u << 20;
static void launch_gemm(hipStream_t s, GemmP p) { dim3 g(p.N / 64, p.M / 64); hipLaunchKernelGGL(k_gemm, g, dim3(256), 0, s, p); }

static void moe_layer(hipStream_t s, const Bufs& bf, float* X, int layer, void* const* d_in) {
    const float* ffn_norm = (const float*)d_in[2] + layer * D;
    const float* wg = (const float*)d_in[14] + (size_t)layer * D * 4;  const float* bg = (const float*)d_in[15] + layer * 4;
    const float* we = (const float*)d_in[16] + (size_t)layer * D * 32; const float* be = (const float*)d_in[17] + layer * 32;
    const float* win = (const float*)d_in[18] + (size_t)layer * NEXP * D * 1024;
    const float* wout = (const float*)d_in[19] + (size_t)layer * NEXP * FF * D;
    float* HU = bf.BIG;
    float* ACT = bf.BIG + (size_t)CAP * 1024;
    float* YB = bf.O;
    hipLaunchKernelGGL(k_rmsnorm<1024>, dim3(T / 4), dim3(256), 0, s, X, ffn_norm, bf.HN, T);
    (void)hipMemsetAsync(bf.cnt, 0, 32 * sizeof(int), s);
    hipLaunchKernelGGL(k_route, dim3(T / 4), dim3(256), 0, s, bf.HN, wg, bg, we, be, bf.cnt, bf.list, bf.wgt);
    hipLaunchKernelGGL(k_moe_rows, dim3((CAP + 255) / 256), dim3(256), 0, s, bf.cnt, bf.list, bf.row_src, bf.row_dst, bf.tile_e);
    GemmP p1{}; p1.A = bf.HN; p1.lda = D; p1.arow = bf.row_src; p1.W = win; p1.ldw = 1024; p1.wstride = (size_t)D * 1024; p1.tile_e = bf.tile_e;
    p1.C = HU; p1.ldc = 1024; p1.M = CAP; p1.N = 1024; p1.K = D; launch_gemm(s, p1);
    hipLaunchKernelGGL(k_silu_mul, dim3((unsigned)(((size_t)CAP * FF + 255) / 256)), dim3(256), 0, s, HU, ACT);
    GemmP p2{}; p2.A = ACT; p2.lda = FF; p2.W = wout; p2.ldw = D; p2.wstride = (size_t)FF * D; p2.tile_e = bf.tile_e;
    p2.C = YB; p2.ldc = D; p2.crow = bf.row_dst; p2.cscale = bf.wgt; p2.M = CAP; p2.N = D; p2.K = FF; launch_gemm(s, p2);
    hipLaunchKernelGGL(k_combine, dim3((unsigned)(((size_t)T * D + 255) / 256)), dim3(256), 0, s, X, YB);
}

static Bufs make_bufs(unsigned char* ws) {
    Bufs bf;
    bf.cnt = (int*)(ws + 0); bf.lb = (float*)(ws + 4096); bf.bias_tab = (float*)(ws + 8192);
    bf.wgt = (float*)(ws + 1 * MiB); bf.km = (float*)(ws + 2 * MiB);
    bf.row_src = (int*)(ws + 3 * MiB); bf.row_dst = (int*)(ws + 4 * MiB); bf.tile_e = (int*)(ws + 5 * MiB);
    bf.sel = (int*)(ws + 6 * MiB);
    bf.list = (int*)(ws + 16 * MiB);
    bf.HN = (float*)(ws + 32 * MiB);
    bf.BIG = (float*)(ws + 160 * MiB);
    bf.O = (float*)(ws + 672 * MiB);
    return bf;
}
static void stage1(void* const* d_in, float* X, unsigned char* ws, hipStream_t s) {
    Bufs bf = make_bufs(ws);
    const float* x = (const float*)d_in[0]; const float* mix_norm = (const float*)d_in[1];
    const float* hg_w_in = (const float*)d_in[3]; const float* hg_lb = (const float*)d_in[4]; const float* hg_o_norm = (const float*)d_in[5]; const float* hg_w_out = (const float*)d_in[6];
    hipLaunchKernelGGL(k_prep, dim3(32), dim3(256), 0, s, hg_lb, (const float*)d_in[13], bf.lb, bf.bias_tab);
    hipLaunchKernelGGL(k_rmsnorm<1024>, dim3(T / 4), dim3(256), 0, s, x, mix_norm, bf.HN, T);
    float* PROJ = bf.BIG;
    { GemmP p{}; p.A = bf.HN; p.lda = D; p.W = hg_w_in; p.ldw = 4096; p.C = PROJ; p.ldc = 4096; p.M = T; p.N = 4096; p.K = D; launch_gemm(s, p); }
    hipLaunchKernelGGL(k_hg_gates, dim3((unsigned)(((size_t)T * 1024 + 255) / 256)), dim3(256), 0, s, PROJ, bf.lb);
    hipLaunchKernelGGL(k_gla, dim3(B * NH), dim3(128), 0, s, PROJ, bf.O);
    hipLaunchKernelGGL(k_onorm_gate, dim3(T * NH / 4), dim3(256), 0, s, bf.O, PROJ, hg_o_norm, bf.HN);
    { GemmP p{}; p.A = bf.HN; p.lda = D; p.W = hg_w_out; p.ldw = D; p.C = X; p.ldc = D; p.R = x; p.M = T; p.N = D; p.K = D; launch_gemm(s, p); }
}
static void stage_moe(void* const* d_in, float* X, unsigned char* ws, hipStream_t s, int layer) { Bufs bf = make_bufs(ws); moe_layer(s, bf, X, layer, d_in); }
__global__ void k_add(float* x, const float* __restrict__ y, size_t n) { for (size_t i = (size_t)blockIdx.x * blockDim.x + threadIdx.x; i < n; i += (size_t)gridDim.x * blockDim.x) x[i] += y[i]; }
static void stage3(void* const* d_in, float* X, unsigned char* ws, hipStream_t s, const int* sel_in = nullptr, float* branch_out = nullptr) {
    Bufs bf = make_bufs(ws);
    const float* mix_norm = (const float*)d_in[1];
    const float* kv_norm = (const float*)d_in[7]; const float* w_kv = (const float*)d_in[8]; const float* k_norm = (const float*)d_in[9];
    const float* att_w_q = (const float*)d_in[10]; const float* q_norm = (const float*)d_in[11]; const float* att_w_o = (const float*)d_in[12]; const float* rel_bias = (const float*)d_in[13];
    hipLaunchKernelGGL(k_prep, dim3(32), dim3(256), 0, s, (const float*)d_in[4], rel_bias, bf.lb, bf.bias_tab);
    hipLaunchKernelGGL(k_rmsnorm<1024>, dim3(T / 4), dim3(256), 0, s, X, kv_norm, bf.HN, T);
    float* KV = bf.BIG; float* Kb = bf.BIG + (size_t)T * 2048; float* Vb = Kb + (size_t)T * 1024;
    { GemmP p{}; p.A = bf.HN; p.lda = D; p.W = w_kv; p.ldw = 2048; p.C = KV; p.ldc = 2048; p.M = T; p.N = 2048; p.K = D; launch_gemm(s, p); }
    hipLaunchKernelGGL(k_kv_split, dim3(T * NH / 4), dim3(256), 0, s, KV, k_norm, Kb, Vb);
    hipLaunchKernelGGL(k_kmean, dim3(B * NH * NBLK), dim3(128), 0, s, Kb, bf.km);
    hipLaunchKernelGGL(k_rmsnorm<1024>, dim3(T / 4), dim3(256), 0, s, X, mix_norm + D, bf.HN, T);
    float* Q = bf.BIG; float* ATT = bf.BIG + (size_t)T * 1024;
    { GemmP p{}; p.A = bf.HN; p.lda = D; p.W = att_w_q; p.ldw = D; p.C = Q; p.ldc = D; p.M = T; p.N = D; p.K = D; launch_gemm(s, p); }
    hipLaunchKernelGGL(k_headnorm, dim3(T * NH / 4), dim3(256), 0, s, Q, D, 0, q_norm, Q, D);
    hipLaunchKernelGGL(k_moba, dim3(T * NH), dim3(256), 0, s, Q, Kb, Vb, bf.km, bf.bias_tab, ATT, bf.sel, sel_in);
    if (branch_out) { GemmP p{}; p.A = ATT; p.lda = D; p.W = att_w_o; p.ldw = D; p.C = branch_out; p.ldc = D; p.M = T; p.N = D; p.K = D; launch_gemm(s, p);
        hipLaunchKernelGGL(k_add, dim3(4096), dim3(256), 0, s, X, (const float*)branch_out, (size_t)T * D); }
    else { GemmP p{}; p.A = ATT; p.lda = D; p.W = att_w_o; p.ldw = D; p.C = X; p.ldc = D; p.R = X; p.M = T; p.N = D; p.K = D; launch_gemm(s, p); }
}
}
namespace dbg {
__device__ __forceinline__ unsigned f2bf(float f) { unsigned u = __builtin_bit_cast(unsigned, f); return (u + 0x7fffu + ((u >> 16) & 1u)) >> 16; }
__global__ void k_store(const float* __restrict__ a, const float* __restrict__ b, unsigned short* __restrict__ out, size_t n) {
    for (size_t i = (size_t)blockIdx.x * blockDim.x + threadIdx.x; i < n; i += (size_t)gridDim.x * blockDim.x) out[i] = (unsigned short)f2bf(a[i] - b[i]);
}
__global__ void k_cmp(const unsigned short* __restrict__ fb, const float* __restrict__ s1, const float* __restrict__ s2, int mode, double* acc, size_t n) {
    double num = 0.0, den = 0.0;
    for (size_t i = (size_t)blockIdx.x * blockDim.x + threadIdx.x; i < n; i += (size_t)gridDim.x * blockDim.x) {
        float sl;
        if (mode == 0) sl = s1[i] - s2[i];
        else if (mode == 1) { const size_t t = i >> 10, c = i & 1023; sl = s1[(2 * t) * 1024 + c] + s1[(2 * t + 1) * 1024 + c]; }
        else sl = s1[i];
        const float f = __builtin_bit_cast(float, (unsigned)fb[i] << 16);
        const double d = (double)f - (double)sl; num += d * d; den += (double)sl * (double)sl;
    }
    for (int o = 32; o >= 1; o >>= 1) { num += __shfl_xor(num, o); den += __shfl_xor(den, o); }
    if ((threadIdx.x & 63) == 0) { atomicAdd(acc, num); atomicAdd(acc + 1, den); }
}
__global__ void k_scale(float* out, const double* acc, size_t n) {
    const float f = 1.0f + (float)sqrt(acc[0] / acc[1]);
    for (size_t i = (size_t)blockIdx.x * blockDim.x + threadIdx.x; i < n; i += (size_t)gridDim.x * blockDim.x) out[i] *= f;
}
}
namespace fk {
constexpr int B = 4, L = 8192, D = 1024, T = B * L, NH = 8, HD = 128, NEXP = 32, FF = 512, NBLK = 32, BLK = 256;
constexpr float EPS = 1e-6f;
#define LAS __attribute__((address_space(3)))
#define GAS __attribute__((address_space(1)))
typedef unsigned short bf16_t;
typedef short bf16x8 __attribute__((ext_vector_type(8)));
typedef short bf16x4 __attribute__((ext_vector_type(4)));
typedef float f32x4 __attribute__((ext_vector_type(4)));
typedef float f32x2 __attribute__((ext_vector_type(2)));
typedef unsigned u32x4 __attribute__((ext_vector_type(4)));
typedef unsigned u32x2 __attribute__((ext_vector_type(2)));
#define LDS_WAIT() asm volatile("s_waitcnt lgkmcnt(0)" ::: "memory")
#define VM_WAIT() asm volatile("s_waitcnt vmcnt(0)" ::: "memory")
__device__ __forceinline__ unsigned f2bf(float f) { unsigned u = __builtin_bit_cast(unsigned, f); return (u + 0x7fffu + ((u >> 16) & 1u)) >> 16; }
__device__ __forceinline__ unsigned pk2(float lo, float hi) { return f2bf(lo) | (f2bf(hi) << 16); }
__device__ __forceinline__ float as_f(unsigned u) { return __builtin_bit_cast(float, u); }
__device__ __forceinline__ unsigned as_u(float f) { return __builtin_bit_cast(unsigned, f); }
__device__ __forceinline__ float bf_lo(unsigned u) { return __builtin_bit_cast(float, u << 16); }
__device__ __forceinline__ float bf_hi(unsigned u) { return __builtin_bit_cast(float, u & 0xffff0000u); }
__device__ __forceinline__ float wave_sum(float v) {
#pragma unroll
    for (int o = 1; o < 64; o <<= 1) v += __shfl_xor(v, o);
    return v;
}
__device__ __forceinline__ float sigmoidf_(float z) { return 1.0f / (1.0f + __expf(-z)); }

#define XB_TMO      128
#define XB_XCNT(j)  (256  + 64 * (j))
#define XB_XSUB(j)  (1280 + 64 * (j))
#define XB_XGEN(j)  (2304 + 64 * (j))
#define XB_TOP      3328
#define XB_TOPGEN   3392
#define XCD_BAR_WORDS 3456
#define XB_SPIN_CAP (1u << 18)
__device__ __forceinline__ unsigned xb_ld(unsigned* p)              { return __hip_atomic_load(p, __ATOMIC_RELAXED, __HIP_MEMORY_SCOPE_AGENT); }
__device__ __forceinline__ unsigned xb_add(unsigned* p, unsigned v) { return __hip_atomic_fetch_add(p, v, __ATOMIC_RELAXED, __HIP_MEMORY_SCOPE_AGENT); }
__device__ __forceinline__ unsigned xb_xcc_id() { return (unsigned)__builtin_amdgcn_s_getreg((3 << 11) | 20) & 0xFu; }
#define XB_SPIN(cond, bar) do { unsigned _sp = 0; while (cond) { __builtin_amdgcn_s_sleep(1); \
    if ((++_sp & 255u) == 0u) { if (xb_ld(&(bar)[XB_TMO])) break; if (_sp > XB_SPIN_CAP) { atomicAdd(&(bar)[XB_TMO], 1u); break; } } } } while (0)
struct XcdBarrier { unsigned* bar; unsigned x; volatile LAS unsigned* st; };
__device__ __forceinline__ XcdBarrier xcd_barrier_post(unsigned* bar, volatile LAS unsigned* st) {
    XcdBarrier b; b.bar = bar; b.x = xb_xcc_id(); b.st = st;
    if (threadIdx.x == 0) (void)xb_add(&bar[XB_XCNT(b.x)], 1u);
    return b;
}
__device__ __forceinline__ void xcd_barrier_complete(unsigned* bar, unsigned x, unsigned& nloc, unsigned& nx) {
    const unsigned G = gridDim.x * gridDim.y * gridDim.z;
    unsigned sum, cnt, mine, sp = 0u;
    for (;;) {
        sum = 0u; cnt = 0u; mine = 0u;
#pragma unroll
        for (unsigned j = 0; j < 16; ++j) { const unsigned c = xb_ld(&bar[XB_XCNT(j)]); sum += c; cnt += (c > 0u) ? 1u : 0u; mine = (j == x) ? c : mine; }
        if (sum == G) break;
        __builtin_amdgcn_s_sleep(1);
        if ((++sp & 255u) == 0u) { if (xb_ld(&bar[XB_TMO])) break; if (sp > XB_SPIN_CAP) { atomicAdd(&bar[XB_TMO], 1u); break; } }
    }
    nloc = mine > 0u ? mine : 1u; nx = cnt > 0u ? cnt : 1u;
}
__device__ __forceinline__ void xcd_barrier(const XcdBarrier& b) {
    asm volatile("s_waitcnt vmcnt(0)" ::: "memory");
    __syncthreads();
    if (threadIdx.x == 0) {
        unsigned* bar = b.bar;
        __builtin_amdgcn_s_waitcnt(0);
        unsigned nloc = b.st[0], nx = b.st[1];
        if (nloc == 0u) { xcd_barrier_complete(bar, b.x, nloc, nx); b.st[0] = nloc; b.st[1] = nx; }
        const unsigned old = xb_add(&bar[XB_XSUB(b.x)], 1u);
        const unsigned gen = old / nloc;
        if (old + 1u == (gen + 1u) * nloc) {
            __builtin_amdgcn_fence(__ATOMIC_RELEASE, "agent");
            asm volatile("s_waitcnt vmcnt(0)" ::: "memory");
            const unsigned og = xb_add(&bar[XB_TOP], 1u);
            const unsigned tg = og / nx;
            if (og + 1u == (tg + 1u) * nx) xb_add(&bar[XB_TOPGEN], 1u);
            else XB_SPIN(xb_ld(&bar[XB_TOPGEN]) == tg, bar);
            __builtin_amdgcn_fence(__ATOMIC_ACQUIRE, "agent");
            xb_add(&bar[XB_XGEN(b.x)], 1u);
            asm volatile("s_waitcnt vmcnt(0)" ::: "memory");
        } else {
            XB_SPIN(xb_ld(&bar[XB_XGEN(b.x)]) == gen, bar);
            __builtin_amdgcn_fence(__ATOMIC_ACQUIRE, "agent");
            asm volatile("s_waitcnt vmcnt(0)" ::: "memory");
        }
    }
    __syncthreads();
}

constexpr int BM = 256, BK = 64, HALF = 128, HTB = HALF * BK * 2, STAGE_BYTES = 8 * HTB, NXCD = 8, WGM = 8;
__host__ __device__ __forceinline__ int lds_byte(int r, int c) { const int st = (r >> 4) * 2 + (c >> 5), rr = r & 15, cc = c & 31, ob = rr * 64 + cc * 2; return st * 1024 + (ob ^ (((ob >> 9) & 1) << 5)); }
__host__ __device__ __forceinline__ void stage_rc(int b, int& R, int& C) { const int st = b / 1024, sb = b % 1024, swz = sb ^ (((sb >> 9) & 1) << 5); R = (st >> 1) * 16 + swz / 64; C = (st & 1) * 32 + (swz % 64) / 2; }
__host__ __device__ __forceinline__ int perm32(int rho) { const int n = rho >> 4, i = rho & 15; return 8 * (i >> 2) + 4 * n + (i & 3); }
struct Unit { int pm, pn, e, aux; };
__device__ __forceinline__ unsigned cvt_pk_bf16(float lo, float hi) { unsigned r; asm volatile("v_cvt_pk_bf16_f32 %0, %1, %2" : "=v"(r) : "v"(lo), "v"(hi)); return r; }

struct DenseOrder {
    static constexpr bool GATHER = false;
    const bf16_t* A; const bf16_t* Bt; int K;
    int nM, nN, nwg, G, c;
    __device__ void init(const bf16_t* A_, const bf16_t* Bt_, int M, int N, int K_, int G_, int c_) { A = A_; Bt = Bt_; K = K_; nM = M / BM; nN = N / BM; nwg = nM * nN; G = G_; c = c_; }
    __device__ bool next(int i, Unit& u) const {
        const long Lx = (long)i * G + c; if (Lx >= nwg) return false;
        int wgid = (int)Lx; { const int q = nwg / NXCD, r = nwg % NXCD, xcd = wgid % NXCD, off = wgid / NXCD; wgid = (xcd < r ? xcd * (q + 1) : r * (q + 1) + (xcd - r) * q) + off; }
        const int nig = WGM * nN, gid = wgid / nig, fm = gid * WGM, gsz = (nM - fm) < WGM ? (nM - fm) : WGM;
        u.pm = fm + ((wgid % nig) % gsz); u.pn = (wgid % nig) / gsz; u.e = 0; u.aux = 0; return true;
    }
    __device__ __forceinline__ const char* a_base(const Unit& u) const { return (const char*)A + (size_t)u.pm * 256 * K * 2; }
    __device__ __forceinline__ const char* b_base(const Unit& u) const { return (const char*)Bt + (size_t)u.pn * 256 * K * 2; }
    __device__ __forceinline__ void a_offs(const Unit&, const int (&)[2], const int (&)[2], unsigned (&)[2][2]) const {}
};

template <class Epi, class Sched>
__device__ __forceinline__ void gemm_phase(LAS unsigned char* lds, const Sched& S, const Epi& E) {
    const int tid = threadIdx.x, wid = __builtin_amdgcn_readfirstlane(tid >> 6), lane = tid & 63, wr = wid >> 2, wc = wid & 3, fr = lane & 15, fq = lane >> 4;
    const int K = S.K, nt = K / BK;
    unsigned voffA[2], voffB[2]; int RR[2], CC[2];
#pragma unroll
    for (int i = 0; i < 2; ++i) { int R, C; stage_rc(tid * 16 + i * 8192, R, C); const int Rb = Epi::PERM ? ((R & ~31) + perm32(R & 31)) : R; RR[i] = R; CC[i] = C;
        voffA[i] = (unsigned)(R * K + C) * 2u; voffB[i] = (unsigned)(Rb * K + C) * 2u; }
    const size_t kstep = (size_t)(BK * 2);
    const size_t hstep = (size_t)HALF * K * 2;
    const unsigned ldsw = (unsigned)wid * 1024u;
    const int aoff = lds_byte(wr * 64 + fr, fq * 8), boff = lds_byte(wc * 32 + fr, fq * 8);
#define PG8_SA(b, h) (((b) * 2 + (h)) * HTB)
#define PG8_SB(b, h) ((4 + (b) * 2 + (h)) * HTB)
#define PG8_STAGE(bufoff, gbase, voff) do { _Pragma("unroll") for (int _i = 0; _i < 2; ++_i) \
        __builtin_amdgcn_global_load_lds((const unsigned*)((const char*)(gbase) + (voff)[_i]), (LAS unsigned*)(lds + (bufoff) + ldsw + _i * 8192), 16, 0, 0); } while (0)
#define PG8_STAGE_A(bufoff, ap, h, go) do { if constexpr (Sched::GATHER) { PG8_STAGE(bufoff, ap, (go)[h]); } else { PG8_STAGE(bufoff, (ap) + (h) * hstep, voffA); } } while (0)
#define PG8_LDA(dst, b, h) do { _Pragma("unroll") for (int m = 0; m < 4; ++m) _Pragma("unroll") for (int k = 0; k < 2; ++k) dst[m][k] = *(const LAS bf16x8*)(lds + PG8_SA(b, h) + aoff + m * 2048 + k * 1024); } while (0)
#define PG8_LDB(dst, b, h) do { _Pragma("unroll") for (int n = 0; n < 2; ++n) _Pragma("unroll") for (int k = 0; k < 2; ++k) dst[n][k] = *(const LAS bf16x8*)(lds + PG8_SB(b, h) + boff + n * 2048 + k * 1024); } while (0)
#define PG8_MMA(ai, bj, At, Bt) do { __builtin_amdgcn_s_setprio(1); _Pragma("unroll") for (int m = 0; m < 4; ++m) _Pragma("unroll") for (int n = 0; n < 2; ++n) _Pragma("unroll") for (int k = 0; k < 2; ++k) \
        acc[ai][bj][m][n] = __builtin_amdgcn_mfma_f32_16x16x32_bf16(Bt[n][k], At[m][k], acc[ai][bj][m][n], 0, 0, 0); __builtin_amdgcn_s_setprio(0); } while (0)
#define PG8_WAIT_V(n) asm volatile("s_waitcnt vmcnt(" #n ")" ::: "memory")
#define PG8_WAIT_L(n) asm volatile("s_waitcnt lgkmcnt(" #n ")" ::: "memory")
#define PG8_BAR __builtin_amdgcn_s_barrier()
#define PG8_SCHED __builtin_amdgcn_sched_barrier(0)
    Unit cur, nxt; int ui = 0;
    if (!S.next(0, cur)) return;
    f32x4 acc[2][2][4][2];
#pragma unroll
    for (int a = 0; a < 2; ++a)
#pragma unroll
        for (int b = 0; b < 2; ++b)
#pragma unroll
            for (int m = 0; m < 4; ++m)
#pragma unroll
                for (int n = 0; n < 2; ++n) acc[a][b][m][n] = (f32x4){0.f, 0.f, 0.f, 0.f};
    bf16x8 At[4][2], B0[2][2], B1[2][2];
    const char* cA = S.a_base(cur); const char* cB = S.b_base(cur);
    unsigned ca[2][2] = {{0u, 0u}, {0u, 0u}}, na[2][2] = {{0u, 0u}, {0u, 0u}};
    if constexpr (Sched::GATHER) S.a_offs(cur, RR, CC, ca);
    PG8_STAGE(PG8_SB(0, 0), cB, voffB); PG8_STAGE(PG8_SB(0, 1), cB + hstep, voffB); PG8_STAGE_A(PG8_SA(0, 0), cA, 0, ca); PG8_STAGE_A(PG8_SA(0, 1), cA, 1, ca);
    if (wr == 1) PG8_BAR;
    PG8_WAIT_V(2); PG8_BAR;
    PG8_STAGE(PG8_SB(1, 0), cB + kstep, voffB); PG8_STAGE_A(PG8_SA(1, 0), cA + kstep, 0, ca); PG8_STAGE(PG8_SB(1, 1), cB + hstep + kstep, voffB);
    PG8_WAIT_V(6); PG8_BAR;
    for (;;) {
        const bool has_next = S.next(ui + 1, nxt);
        const char* nA = has_next ? S.a_base(nxt) : cA; const char* nB = has_next ? S.b_base(nxt) : cB;
        if constexpr (Sched::GATHER) { if (has_next) S.a_offs(nxt, RR, CC, na); else {
#pragma unroll
            for (int h = 0; h < 2; ++h)
#pragma unroll
                for (int i = 0; i < 2; ++i) na[h][i] = ca[h][i]; } }
        for (int t = 0; t < nt; t += 2) {
            const bool last = (t == nt - 2);
            const char* a1 = cA + (size_t)(t + 1) * kstep;
            const char* a2 = last ? nA : cA + (size_t)(t + 2) * kstep; const char* b2 = last ? nB : cB + (size_t)(t + 2) * kstep;
            const char* a3 = a2 + kstep; const char* b3 = b2 + kstep;
            unsigned o2[2][2];
#pragma unroll
            for (int h = 0; h < 2; ++h)
#pragma unroll
                for (int i = 0; i < 2; ++i) o2[h][i] = last ? na[h][i] : ca[h][i];
            PG8_LDB(B0, 0, 0); PG8_LDB(B1, 0, 1); PG8_SCHED; PG8_LDA(At, 0, 0); PG8_STAGE_A(PG8_SA(1, 1), a1, 1, ca);
            PG8_WAIT_V(8); PG8_WAIT_L(0); PG8_BAR; PG8_MMA(0, 0, At, B0); PG8_MMA(0, 1, At, B1); PG8_BAR; PG8_SCHED;
            PG8_LDA(At, 0, 1); PG8_STAGE(PG8_SB(0, 0), b2, voffB); PG8_STAGE(PG8_SB(0, 1), b2 + hstep, voffB); PG8_STAGE_A(PG8_SA(0, 0), a2, 0, o2);
            PG8_WAIT_V(8); PG8_WAIT_L(0); PG8_BAR; PG8_MMA(1, 0, At, B0); PG8_MMA(1, 1, At, B1); PG8_BAR; PG8_SCHED;
            PG8_LDB(B0, 1, 0); PG8_LDB(B1, 1, 1); PG8_SCHED; PG8_LDA(At, 1, 0); PG8_STAGE_A(PG8_SA(0, 1), a2, 1, o2);
            PG8_WAIT_V(8); PG8_WAIT_L(0); PG8_BAR; PG8_MMA(0, 0, At, B0); PG8_MMA(0, 1, At, B1); PG8_BAR; PG8_SCHED;
            PG8_LDA(At, 1, 1); PG8_STAGE(PG8_SB(1, 0), b3, voffB); PG8_STAGE(PG8_SB(1, 1), b3 + hstep, voffB); PG8_STAGE_A(PG8_SA(1, 0), a3, 0, o2);
            PG8_WAIT_V(8); PG8_WAIT_L(0); PG8_BAR; PG8_MMA(1, 0, At, B0); PG8_MMA(1, 1, At, B1); PG8_BAR; PG8_SCHED;
        }
        if (wr == 0) PG8_BAR;
        E(acc, cur, wr, wc, fr, fq);
        if (!has_next) break;
#pragma unroll
        for (int a = 0; a < 2; ++a)
#pragma unroll
            for (int b = 0; b < 2; ++b)
#pragma unroll
                for (int m = 0; m < 4; ++m)
#pragma unroll
                    for (int n = 0; n < 2; ++n) acc[a][b][m][n] = (f32x4){0.f, 0.f, 0.f, 0.f};
        cur = nxt; cA = nA; cB = nB; ++ui;
#pragma unroll
        for (int h = 0; h < 2; ++h)
#pragma unroll
            for (int i = 0; i < 2; ++i) ca[h][i] = na[h][i];
        if (wr == 1) PG8_BAR;
    }
    PG8_WAIT_V(0);
    PG8_BAR;
#undef PG8_SA
#undef PG8_SB
#undef PG8_STAGE
#undef PG8_STAGE_A
#undef PG8_LDA
#undef PG8_LDB
#undef PG8_MMA
#undef PG8_WAIT_V
#undef PG8_WAIT_L
#undef PG8_BAR
#undef PG8_SCHED
}
constexpr size_t MiB = 1u << 20;
constexpr size_t WS_CTL = 0, CTL_ZERO_BYTES = 256 * 1024;
constexpr size_t WS_SMALL = 1 * MiB;
constexpr size_t WS_DEC = 2 * MiB;
constexpr size_t WS_KM = 3 * MiB;
constexpr size_t WS_LIST = 520 * MiB;
constexpr size_t WS_WGT = 12 * MiB;
constexpr size_t WS_SELCNT = 13 * MiB;
constexpr size_t WS_SEL = 16 * MiB;
constexpr size_t WS_WIN = 40 * MiB, WS_WOUT = 48 * MiB, WS_WKVQ = 50 * MiB, WS_WO = 56 * MiB;
constexpr size_t WS_MWIN = 64 * MiB, WS_MWOUT = 192 * MiB;
constexpr size_t WS_XN = 256 * MiB;
constexpr size_t WS_Q = 320 * MiB, WS_LF = 384 * MiB, WS_V = 448 * MiB, WS_G = 512 * MiB;
constexpr size_t WS_STATE = 576 * MiB;
constexpr size_t WS_OG = 640 * MiB;
constexpr size_t WS_ACT = 320 * MiB;
constexpr size_t WS_YB = 392 * MiB;
constexpr size_t WS_DUMMY = 800 * MiB;
constexpr size_t WS_END = 1024 * MiB;
constexpr int CW_BAR = 1024;
constexpr int CW_CNT = 8192;
constexpr int LDS_BYTES = 163840;
constexpr int LDS_MISC = LDS_BYTES - 64;

struct Args {
    const float* in[20]; const float* xin; float* out; unsigned char* ws; int ph_lo, ph_hi, rep2, pad;
};

__device__ __forceinline__ void p0_item(const float* W, int K, int N, bf16_t* WT, int dst_row0, const float* kscale, LAS float* scr, int k0, int n0, int lane) {
    float wv[32];
#pragma unroll
    for (int i = 0; i < 32; ++i) { const int kk = 2 * i + (lane >> 5); wv[i] = W[(size_t)(k0 + kk) * N + n0 + (lane & 31)]; }
    if (kscale) {
#pragma unroll
        for (int i = 0; i < 32; ++i) wv[i] *= kscale[k0 + 2 * i + (lane >> 5)]; }
#pragma unroll
    for (int i = 0; i < 32; ++i) scr[(2 * i + (lane >> 5)) * 33 + (lane & 31)] = wv[i];
    LDS_WAIT(); asm volatile("" ::: "memory");
    const int c = lane & 7;
#pragma unroll
    for (int j = 0; j < 4; ++j) { const int n = (lane >> 3) + 8 * j; const LAS float* s = scr + (8 * c) * 33 + n;
        u32x4 o; o.x = pk2(s[0 * 33], s[1 * 33]); o.y = pk2(s[2 * 33], s[3 * 33]); o.z = pk2(s[4 * 33], s[5 * 33]); o.w = pk2(s[6 * 33], s[7 * 33]);
        *(GAS u32x4*)(WT + (size_t)(dst_row0 + n) * K + k0 + 8 * c) = o; }
    LDS_WAIT(); asm volatile("" ::: "memory");
}
__device__ __forceinline__ int t5_bucket(int n) {
    if (n < 16) return n;
    const float lr = logf((float)n / 16.0f) / 4.1588830833596715f;
    int large = 16 + (int)(lr * 16.0f);
    return large < 31 ? large : 31;
}
__device__ __forceinline__ void norm_row_bf16(const float* xrow, const float* w, bf16_t* orow, int lane) {
    const GAS f32x4* xr = (const GAS f32x4*)xrow + lane;
    f32x4 v[4]; float s = 0.f;
#pragma unroll
    for (int j = 0; j < 4; ++j) { v[j] = xr[64 * j]; s += (v[j].x * v[j].x + v[j].y * v[j].y) + (v[j].z * v[j].z + v[j].w * v[j].w); }
    const float r = rsqrtf(wave_sum(s) * (1.f / D) + EPS);
    GAS u32x2* o8 = (GAS u32x2*)orow + lane;
#pragma unroll
    for (int j = 0; j < 4; ++j) { f32x4 ww = (f32x4){1.f, 1.f, 1.f, 1.f}; if (w) ww = ((const GAS f32x4*)w)[lane + 64 * j];
        u32x2 o; o.x = pk2(v[j].x * r * ww.x, v[j].y * r * ww.y); o.y = pk2(v[j].z * r * ww.z, v[j].w * r * ww.w); o8[64 * j] = o; }
}
__device__ __forceinline__ void p0_prologue(const Args& a, LAS unsigned char* lds, int wave, int lane) {
    LAS float* scr = (LAS float*)(lds + wave * 16384);
    const int gw = blockIdx.x * 8 + wave, NGW = gridDim.x * 8;
    unsigned char* ws = a.ws;
    constexpr int J0 = 2048, J1 = J0 + 512, J2 = J1 + 1024, J3 = J2 + 512, J4 = J3 + 512, J5 = J4 + 64 * 512, J6 = J5 + 64 * 256;
    for (int it = gw; it < J6; it += NGW) {
        if (it < J0) { const int r = it, nblk = 4096 / 32, kb = r / nblk, nb = r % nblk; p0_item(a.in[3], 1024, 4096, (bf16_t*)(ws + WS_WIN), 32 * nb, nullptr, scr, 64 * kb, 32 * nb, lane); }
        else if (it < J1) { const int r = it - J0, kb = r / 32, nb = r % 32; p0_item(a.in[6], 1024, 1024, (bf16_t*)(ws + WS_WOUT), 32 * nb, nullptr, scr, 64 * kb, 32 * nb, lane); }
        else if (it < J2) { const int r = it - J1, kb = r / 64, nb = r % 64; p0_item(a.in[8], 1024, 2048, (bf16_t*)(ws + WS_WKVQ), 32 * nb, a.in[7], scr, 64 * kb, 32 * nb, lane); }
        else if (it < J3) { const int r = it - J2, kb = r / 32, nb = r % 32; p0_item(a.in[10], 1024, 1024, (bf16_t*)(ws + WS_WKVQ), 2048 + 32 * nb, a.in[1] + D, scr, 64 * kb, 32 * nb, lane); }
        else if (it < J4) { const int r = it - J3, kb = r / 32, nb = r % 32; p0_item(a.in[12], 1024, 1024, (bf16_t*)(ws + WS_WO), 32 * nb, nullptr, scr, 64 * kb, 32 * nb, lane); }
        else if (it < J5) { const int r = it - J4, mat = r / 512, q = r % 512, kb = q / 32, nb = q % 32; const int n0 = 32 * nb;
            const int dst = (n0 < 512) ? ((n0 >> 7) * 256 + (n0 & 127)) : ((((n0 - 512) >> 7) * 256) + 128 + ((n0 - 512) & 127));
            p0_item(a.in[18] + (size_t)mat * 1024 * 1024, 1024, 1024, (bf16_t*)(ws + WS_MWIN) + (size_t)mat * 1024 * 1024, dst, a.in[2] + (mat >> 5) * D, scr, 64 * kb, n0, lane); }
        else { const int r = it - J5, mat = r / 256, q = r % 256, kb = q / 32, nb = q % 32;
            p0_item(a.in[19] + (size_t)mat * 512 * 1024, 512, 1024, (bf16_t*)(ws + WS_MWOUT) + (size_t)mat * 1024 * 512, 32 * nb, nullptr, scr, 64 * kb, 32 * nb, lane); }
    }
    for (int m = gw; m < T; m += NGW) norm_row_bf16(a.in[0] + (size_t)m * D, a.in[1], (bf16_t*)(ws + WS_XN) + (size_t)m * D, lane);
    if (blockIdx.x == 0) {
        float* lb = (float*)(ws + WS_SMALL); float* bt = lb + 2048;
        for (int i = threadIdx.x; i < 1024; i += 512) { const float x0 = a.in[4][i], x1 = a.in[4][1024 + i], m = fmaxf(x0, x1), e0 = expf(x0 - m), e1 = expf(x1 - m); lb[i] = e0 / (e0 + e1); }
        for (int i = threadIdx.x; i < 8192; i += 512) { const int h = i >> 10, d = i & 1023; bt[i] = a.in[13][t5_bucket(d) * 8 + h]; }
    }
}

struct EpiHG {
    static constexpr bool PERM = true;
    bf16_t* Qo; const float* lb;
    __device__ __forceinline__ void operator()(const f32x4 (&acc)[2][2][4][2], const Unit& u, int wr, int wc, int fr, int fq) const {
        const int quarter = u.pn >> 2, colq = (u.pn & 3) * 256 + wc * 32 + 8 * fq;
        bf16_t* base = Qo + (size_t)quarter * (64 * MiB / 2);
        const int row0 = u.pm * BM + wr * 64 + fr;
        f32x4 l0[2], l1[2];
#pragma unroll
        for (int bj = 0; bj < 2; ++bj) { l0[bj] = *(const f32x4*)(lb + colq + bj * HALF); l1[bj] = *(const f32x4*)(lb + colq + bj * HALF + 4); }
#pragma unroll
        for (int ai = 0; ai < 2; ++ai)
#pragma unroll
            for (int m = 0; m < 4; ++m) { bf16_t* rowp = base + (size_t)(row0 + ai * HALF + m * 16) * 1024 + colq;
#pragma unroll
                for (int bj = 0; bj < 2; ++bj) { f32x4 v0 = acc[ai][bj][m][0], v1 = acc[ai][bj][m][1];
                    if (quarter == 0) { v0 = v0 * 0.08838834764831845f; v1 = v1 * 0.08838834764831845f; }
                    else if (quarter == 1) {
#pragma unroll
                        for (int j = 0; j < 4; ++j) { v0[j] = __logf(l0[bj][j] + (1.f - l0[bj][j]) * sigmoidf_(v0[j])); v1[j] = __logf(l1[bj][j] + (1.f - l1[bj][j]) * sigmoidf_(v1[j])); } }
                    else if (quarter == 3) {
#pragma unroll
                        for (int j = 0; j < 4; ++j) { v0[j] = v0[j] * sigmoidf_(v0[j]); v1[j] = v1[j] * sigmoidf_(v1[j]); } }
                    u32x4 w; w.x = cvt_pk_bf16(v0[0], v0[1]); w.y = cvt_pk_bf16(v0[2], v0[3]); w.z = cvt_pk_bf16(v1[0], v1[1]); w.w = cvt_pk_bf16(v1[2], v1[3]);
                    *(u32x4*)(rowp + bj * HALF) = w; } }
    }
};
struct EpiRes {
    static constexpr bool PERM = false;
    float* C; const float* R; int ldc;
    __device__ __forceinline__ void operator()(const f32x4 (&acc)[2][2][4][2], const Unit& u, int wr, int wc, int fr, int fq) const {
        const int row0 = u.pm * BM + wr * 64 + fr, col0 = u.pn * BM + wc * 32 + 4 * fq;
#pragma unroll
        for (int ai = 0; ai < 2; ++ai)
#pragma unroll
            for (int m = 0; m < 4; ++m) { const size_t off = (size_t)(row0 + ai * HALF + m * 16) * ldc + col0;
#pragma unroll
                for (int bj = 0; bj < 2; ++bj)
#pragma unroll
                    for (int n = 0; n < 2; ++n) { const f32x4 r = *(const f32x4*)(R + off + bj * HALF + n * 16); *(f32x4*)(C + off + bj * HALF + n * 16) = r + acc[ai][bj][m][n]; }
                asm volatile("" ::: "memory"); }
    }
};

__device__ __forceinline__ unsigned off_b(unsigned row, unsigned ch) { return 256u * row + 16u * (ch ^ (((row & 3) << 2) | ((row >> 2) & 3))); }
__device__ __forceinline__ unsigned row_rd16(unsigned lane, unsigned rb, unsigned s) { return off_b((lane & 15) + 16 * rb, 4 * s + (lane >> 4)); }
__device__ __forceinline__ unsigned tr_rd16(unsigned lane, unsigned c, unsigned ks, unsigned t) { const unsigned g = lane >> 4, q = (lane & 15) >> 2, p = lane & 3; return off_b(32 * ks + 8 * g + 4 * t + q, 2 * c + (p >> 1)) + 8 * (p & 1); }
__device__ __forceinline__ unsigned elem_off(unsigned row, unsigned col) { return off_b(row, col >> 3) + (col & 7) * 2; }
__device__ __forceinline__ bf16x8 tr_frag(unsigned a0, unsigned a1) {
    bf16x4 lo, hi;
    asm volatile("ds_read_b64_tr_b16 %0, %2\n\tds_read_b64_tr_b16 %1, %3\n\ts_waitcnt lgkmcnt(0)" : "=&v"(lo), "=&v"(hi) : "v"(a0), "v"(a1) : "memory");
    bf16x8 r; r[0] = lo[0]; r[1] = lo[1]; r[2] = lo[2]; r[3] = lo[3]; r[4] = hi[0]; r[5] = hi[1]; r[6] = hi[2]; r[7] = hi[3]; return r;
}
constexpr int GI_Q = 0, GI_K = 16384, GI_KH = 32768, GI_V = 49152, GI_A = 65536, GI_ST = 81920, GI_O = 114688, GI_GTOT = 148480, GI_EBT = 152576;
constexpr int O_PITCH = 132;

template <bool WITH_Q>
__device__ __forceinline__ void gla_prep(LAS unsigned char* lds, const unsigned (&lfw)[8], const unsigned (&qw)[8], const unsigned (&vw)[8], int g, int lane, float& totsum0, float& totsum1) {
    float b0[8], b1[8]; float s0 = 0.f, s1 = 0.f;
#pragma unroll
    for (int i = 0; i < 8; ++i) { s0 += bf_lo(lfw[i]); s1 += bf_hi(lfw[i]); b0[i] = s0; b1[i] = s1; }
    LAS float* gtot = (LAS float*)(lds + GI_GTOT);
    *(LAS f32x2*)(gtot + g * 128 + 2 * lane) = (f32x2){s0, s1};
    __syncthreads();
    float pre0 = 0.f, pre1 = 0.f, tot0 = 0.f, tot1 = 0.f;
#pragma unroll
    for (int gg = 0; gg < 8; ++gg) { const f32x2 v = *(LAS f32x2*)(gtot + gg * 128 + 2 * lane); tot0 += v.x; tot1 += v.y; if (gg < g) { pre0 += v.x; pre1 += v.y; } }
    totsum0 += tot0; totsum1 += tot1;
    if (g == 0) *(LAS f32x2*)((LAS float*)(lds + GI_EBT) + 2 * lane) = (f32x2){__expf(tot0), __expf(tot1)};
    const unsigned d = 2 * lane;
#pragma unroll
    for (int i = 0; i < 8; ++i) {
        const unsigned t = 8 * g + i, eo = elem_off(t, d);
        const float B0 = b0[i] + pre0, B1 = b1[i] + pre1;
        const float k0 = 1.f - __expf(bf_lo(lfw[i])), k1 = 1.f - __expf(bf_hi(lfw[i]));
        *(LAS unsigned*)(lds + GI_KH + eo) = pk2(k0 * __expf(tot0 - B0), k1 * __expf(tot1 - B1));
        *(LAS unsigned*)(lds + GI_V + eo) = vw[i];
        if (WITH_Q) {
            *(LAS unsigned*)(lds + GI_Q + eo) = pk2(bf_lo(qw[i]) * __expf(B0), bf_hi(qw[i]) * __expf(B1));
            *(LAS unsigned*)(lds + GI_K + eo) = pk2(k0 * __expf(fminf(-B0, 80.f)), k1 * __expf(fminf(-B1, 80.f)));
        }
    }
}
__device__ __forceinline__ void gla_state_update(LAS unsigned char* lds, unsigned lds0, f32x4 (&S)[8], const bf16x8 (&vf)[2], int w, int lane) {
    const int fr = lane & 15, fq = lane >> 4;
#pragma unroll
    for (int mb = 0; mb < 8; ++mb) {
        const f32x4 e4 = *(LAS f32x4*)((LAS float*)(lds + GI_EBT) + 16 * mb + 4 * fq);
        f32x4 s = S[mb] * e4;
#pragma unroll
        for (int ks = 0; ks < 2; ++ks) { const bf16x8 kh = tr_frag(lds0 + GI_KH + tr_rd16(lane, mb, ks, 0), lds0 + GI_KH + tr_rd16(lane, mb, ks, 1)); s = __builtin_amdgcn_mfma_f32_16x16x32_bf16(kh, vf[ks], s, 0, 0, 0); }
        S[mb] = s;
        u32x2 o; o.x = pk2(s[0], s[1]); o.y = pk2(s[2], s[3]);
        *(LAS u32x2*)(lds + GI_ST + elem_off(16 * w + fr, 16 * mb + 4 * fq)) = o;
    }
}
template <int PASS>
__device__ __forceinline__ void gla_phase(const Args& a, LAS unsigned char* lds, int wave, int lane) {
    unsigned char* ws = a.ws;
    const unsigned lds0 = (unsigned)(size_t)lds;
    const bf16_t* Qg = (const bf16_t*)(ws + WS_Q); const bf16_t* LFg = (const bf16_t*)(ws + WS_LF); const bf16_t* Vg = (const bf16_t*)(ws + WS_V); const bf16_t* Gg = (const bf16_t*)(ws + WS_G);
    float* STATE = (float*)(ws + WS_STATE); float* DEC = (float*)(ws + WS_DEC); bf16_t* OG = (bf16_t*)(ws + WS_OG);
    const float* onw = a.in[5];
    const int g = wave, w = wave, fr = lane & 15, fq = lane >> 4;
    for (int item = blockIdx.x; item < 1024; item += gridDim.x) {
        const int bh = item >> 5, sc = item & 31, b = bh >> 3, h = bh & 7;
        const size_t tok0 = (size_t)b * L + (size_t)sc * 256;
        const size_t colb = (size_t)h * 128 + 2 * lane;
        f32x4 S[8];
        if (PASS == 1) {
            const float* sp = STATE + (size_t)item * 16384 + (size_t)(16 * w + fr) * 128 + 4 * fq;
#pragma unroll
            for (int mb = 0; mb < 8; ++mb) { S[mb] = *(const f32x4*)(sp + 16 * mb);
                u32x2 o; o.x = pk2(S[mb][0], S[mb][1]); o.y = pk2(S[mb][2], S[mb][3]);
                *(LAS u32x2*)(lds + GI_ST + elem_off(16 * w + fr, 16 * mb + 4 * fq)) = o; }
        } else {
#pragma unroll
            for (int mb = 0; mb < 8; ++mb) S[mb] = (f32x4){0.f, 0.f, 0.f, 0.f};
        }
        float ts0 = 0.f, ts1 = 0.f;
        for (int c = 0; c < 4; ++c) {
            unsigned lfw[8], qw[8], vw[8];
#pragma unroll
            for (int i = 0; i < 8; ++i) { const size_t o = (tok0 + c * 64 + 8 * g + i) * 1024 + colb;
                lfw[i] = *(const unsigned*)(LFg + o); vw[i] = *(const unsigned*)(Vg + o); qw[i] = (PASS == 1) ? *(const unsigned*)(Qg + o) : 0u; }
            gla_prep<PASS == 1>(lds, lfw, qw, vw, g, lane, ts0, ts1);
            __syncthreads();
            bf16x8 vf[2];
#pragma unroll
            for (int ks = 0; ks < 2; ++ks) vf[ks] = tr_frag(lds0 + GI_V + tr_rd16(lane, w, ks, 0), lds0 + GI_V + tr_rd16(lane, w, ks, 1));
            if (PASS == 1) {
                const int tb = w >> 1;
#pragma unroll
                for (int x = 0; x < 2; ++x) { const int sb = 2 * (w & 1) + x;
                    f32x4 acc = (f32x4){0.f, 0.f, 0.f, 0.f};
#pragma unroll
                    for (int ks = 0; ks < 4; ++ks) { const bf16x8 ka = *(const LAS bf16x8*)(lds + GI_K + row_rd16(lane, sb, ks)); const bf16x8 qb = *(const LAS bf16x8*)(lds + GI_Q + row_rd16(lane, tb, ks));
                        acc = __builtin_amdgcn_mfma_f32_16x16x32_bf16(ka, qb, acc, 0, 0, 0); }
                    const int t = tb * 16 + fr, s0 = sb * 16 + 4 * fq;
#pragma unroll
                    for (int r = 0; r < 4; ++r) if (s0 + r > t) acc[r] = 0.f;
                    u32x2 o; o.x = pk2(acc[0], acc[1]); o.y = pk2(acc[2], acc[3]);
                    *(LAS u32x2*)(lds + GI_A + elem_off(t, s0)) = o; }
                bf16x8 stf[4];
#pragma unroll
                for (int ks = 0; ks < 4; ++ks) stf[ks] = *(const LAS bf16x8*)(lds + GI_ST + row_rd16(lane, w, ks));
                __syncthreads();
#pragma unroll
                for (int tb2 = 0; tb2 < 4; ++tb2) {
                    f32x4 acc = (f32x4){0.f, 0.f, 0.f, 0.f};
#pragma unroll
                    for (int ks = 0; ks < 2; ++ks) { const bf16x8 ab = *(const LAS bf16x8*)(lds + GI_A + row_rd16(lane, tb2, ks)); acc = __builtin_amdgcn_mfma_f32_16x16x32_bf16(vf[ks], ab, acc, 0, 0, 0); }
#pragma unroll
                    for (int ks = 0; ks < 4; ++ks) { const bf16x8 qb = *(const LAS bf16x8*)(lds + GI_Q + row_rd16(lane, tb2, ks)); acc = __builtin_amdgcn_mfma_f32_16x16x32_bf16(stf[ks], qb, acc, 0, 0, 0); }
                    *(LAS f32x4*)((LAS float*)(lds + GI_O) + (16 * tb2 + fr) * O_PITCH + 16 * w + 4 * fq) = acc;
                }
            }
            if (PASS == 0 || c < 3) gla_state_update(lds, lds0, S, vf, w, lane);
            __syncthreads();
            if (PASS == 1) {
#pragma unroll
                for (int i = 0; i < 8; ++i) { const int t = 8 * g + i;
                    const f32x2 o = *(LAS f32x2*)((LAS float*)(lds + GI_O) + t * O_PITCH + 2 * lane);
                    const float r = rsqrtf(wave_sum(o.x * o.x + o.y * o.y) * (1.f / 128.f) + EPS);
                    const size_t go = (tok0 + c * 64 + t) * 1024 + colb;
                    const unsigned gw = *(const unsigned*)(Gg + go);
                    const f32x2 nw = *(const f32x2*)(onw + 2 * lane);
                    *(unsigned*)(OG + go) = pk2(o.x * r * nw.x * bf_lo(gw), o.y * r * nw.y * bf_hi(gw)); }
            }
        }
        if (PASS == 0) {
            float* sp = STATE + (size_t)item * 16384 + (size_t)(16 * w + fr) * 128 + 4 * fq;
#pragma unroll
            for (int mb = 0; mb < 8; ++mb) *(f32x4*)(sp + 16 * mb) = S[mb];
            if (g == 0) *(f32x2*)(DEC + (size_t)item * 128 + 2 * lane) = (f32x2){__expf(ts0), __expf(ts1)};
        }
        __syncthreads();
    }
}
__device__ __forceinline__ void gla_scan(const Args& a) {
    float* STATE = (float*)(a.ws + WS_STATE); const float* DEC = (const float*)(a.ws + WS_DEC);
    for (int e = blockIdx.x * 512 + threadIdx.x; e < 32 * 4096; e += gridDim.x * 512) {
        const int bh = e >> 12, q = e & 4095, dk0 = (q & 31) * 4;
        f32x4 carry = (f32x4){0.f, 0.f, 0.f, 0.f};
        float* p = STATE + (size_t)bh * 32 * 16384 + (size_t)q * 4;
        const float* dp = DEC + (size_t)bh * 32 * 128 + dk0;
#pragma unroll 4
        for (int sc = 0; sc < 32; ++sc) { const f32x4 loc = *(const f32x4*)(p + (size_t)sc * 16384); const f32x4 dec = *(const f32x4*)(dp + sc * 128);
            *(f32x4*)(p + (size_t)sc * 16384) = carry; carry = dec * carry + loc; }
    }
}
constexpr int MOE_CAPROWS = T * 2 + NEXP * 256;
constexpr int LDS_MOE_TAB = 131072;

constexpr int RL_BH = 0, RL_BL = 36864, RL_LG = 73728, RL_RS = RL_LG + 8 * 2304, RL_REC = RL_RS + 8 * 64, RL_CNT = RL_REC + 5 * 2048;
__device__ __forceinline__ unsigned rt_off(int c, int k) { return (unsigned)c * 1024u + ((((unsigned)k >> 3) ^ ((unsigned)c & 15u)) << 4) + ((unsigned)k & 7u) * 2u; }
__device__ __forceinline__ void moe_route_phase(const Args& a, LAS unsigned char* lds, int layer, int cslot, const float* xin, int wave, int lane) {
    unsigned char* ws = a.ws;
    const float* wg = a.in[14] + (size_t)layer * D * 4; const float* bg = a.in[15] + layer * 4;
    const float* we = a.in[16] + (size_t)layer * D * 32; const float* be = a.in[17] + layer * 32;
    const float* nw = a.in[2] + (size_t)layer * D;
    unsigned* cnt = (unsigned*)(ws + WS_CTL) + CW_CNT + 64 * cslot;
    u32x4* list = (u32x4*)(ws + WS_LIST); bf16_t* H2 = (bf16_t*)(ws + WS_XN);
    const int tid = threadIdx.x, fr = lane & 15, fq = lane >> 4;
    const int NGW = gridDim.x * 8, ngroups = T / 16, rounds = (ngroups + NGW - 1) / NGW;
    LAS float* lgw = (LAS float*)(lds + RL_LG + wave * 2304);
    LAS float* rsw = (LAS float*)(lds + RL_RS + wave * 64);
    LAS int* re0 = (LAS int*)(lds + RL_REC); LAS int* re1 = re0 + 512; LAS float* rw0 = (LAS float*)(re1 + 512); LAS float* rw1 = rw0 + 512; LAS float* rrs = rw1 + 512;
    LAS int* lcnt = (LAS int*)(lds + RL_CNT); LAS int* lbase = lcnt + 32;
    for (int rd = 0; rd < rounds; ++rd) {
        const int grp = (int)blockIdx.x * 8 + wave + rd * NGW;
        const bool live = grp < ngroups;
        const int t = (live ? grp : 0) * 16 + fr;
        f32x4 acc[3];
#pragma unroll
        for (int n = 0; n < 3; ++n) acc[n] = (f32x4){0.f, 0.f, 0.f, 0.f};
        float ss = 0.f;
#pragma unroll 1
        for (int half = 0; half < 2; ++half) {
            __syncthreads();
            for (int i = tid; i < 36 * 512; i += 512) {
                int c, kk; float w;
                if (i < 4 * 512) { kk = i >> 2; c = i & 3; w = wg[(size_t)(half * 512 + kk) * 4 + c]; }
                else { const int q = i - 4 * 512; kk = q >> 5; c = 4 + (q & 31); w = we[(size_t)(half * 512 + kk) * 32 + (q & 31)]; }
                w *= nw[half * 512 + kk];
                const unsigned hi = f2bf(w); const float lo = w - __builtin_bit_cast(float, hi << 16);
                const unsigned o = rt_off(c, kk);
                *(LAS unsigned short*)(lds + RL_BH + o) = (unsigned short)hi; *(LAS unsigned short*)(lds + RL_BL + o) = (unsigned short)f2bf(lo);
            }
            __syncthreads();
            const float* xr = xin + (size_t)t * D + half * 512 + 8 * fq;
            bf16_t* hr = H2 + (size_t)t * D + half * 512 + 8 * fq;
#pragma unroll
            for (int ks = 0; ks < 16; ++ks) {
                const f32x4 xa = *(const GAS f32x4*)(xr + 32 * ks), xb = *(const GAS f32x4*)(xr + 32 * ks + 4);
                ss += (xa.x * xa.x + xa.y * xa.y) + (xa.z * xa.z + xa.w * xa.w) + (xb.x * xb.x + xb.y * xb.y) + (xb.z * xb.z + xb.w * xb.w);
                u32x4 hi; hi.x = pk2(xa.x, xa.y); hi.y = pk2(xa.z, xa.w); hi.z = pk2(xb.x, xb.y); hi.w = pk2(xb.z, xb.w);
                u32x4 lo; lo.x = pk2(xa.x - bf_lo(hi.x), xa.y - bf_hi(hi.x)); lo.y = pk2(xa.z - bf_lo(hi.y), xa.w - bf_hi(hi.y));
                          lo.z = pk2(xb.x - bf_lo(hi.z), xb.y - bf_hi(hi.z)); lo.w = pk2(xb.z - bf_lo(hi.w), xb.w - bf_hi(hi.w));
                if (live) *(GAS u32x4*)(hr + 32 * ks) = hi;
                const bf16x8 ahi = __builtin_bit_cast(bf16x8, hi), alo = __builtin_bit_cast(bf16x8, lo);
#pragma unroll
                for (int n = 0; n < 3; ++n) { const int c = (n == 2 ? 20 : 16 * n) + fr; const unsigned o = (unsigned)c * 1024u + ((((unsigned)(4 * ks + fq)) ^ ((unsigned)c & 15u)) << 4);
                    const bf16x8 bh = *(const LAS bf16x8*)(lds + RL_BH + o), bl = *(const LAS bf16x8*)(lds + RL_BL + o);
                    acc[n] = __builtin_amdgcn_mfma_f32_16x16x32_bf16(ahi, bh, acc[n], 0, 0, 0);
                    acc[n] = __builtin_amdgcn_mfma_f32_16x16x32_bf16(ahi, bl, acc[n], 0, 0, 0);
                    acc[n] = __builtin_amdgcn_mfma_f32_16x16x32_bf16(alo, bh, acc[n], 0, 0, 0); }
            }
        }
        ss += __shfl_xor(ss, 16); ss += __shfl_xor(ss, 32);
        const float rstd = rsqrtf(ss * (1.f / D) + EPS);
        if (fq == 0) rsw[fr] = rstd;
#pragma unroll
        for (int r = 0; r < 4; ++r) { const float rs = rsw[4 * fq + r];
            lgw[(4 * fq + r) * 36 + fr] = acc[0][r] * rs + (fr < 4 ? bg[fr] : be[fr - 4]);
            lgw[(4 * fq + r) * 36 + 16 + fr] = acc[1][r] * rs + be[12 + fr];
            if (fr >= 12) lgw[(4 * fq + r) * 36 + 20 + fr] = acc[2][r] * rs + be[16 + fr]; }
        if (lane < 16) {
            float lg[36];
#pragma unroll
            for (int c = 0; c < 36; ++c) lg[c] = lgw[lane * 36 + c];
            int gi = 0; float gm = lg[0];
#pragma unroll
            for (int i = 1; i < 4; ++i) if (lg[i] > gm) { gm = lg[i]; gi = i; }
            float gs = 0.f;
#pragma unroll
            for (int i = 0; i < 4; ++i) gs += expf(lg[i] - gm);
            const float gw_ = 1.0f / gs;
            float el[8];
#pragma unroll
            for (int i = 0; i < 8; ++i) el[i] = gi == 0 ? lg[4 + i] : gi == 1 ? lg[12 + i] : gi == 2 ? lg[20 + i] : lg[28 + i];
            int i0 = 0; float m0 = el[0];
#pragma unroll
            for (int i = 1; i < 8; ++i) if (el[i] > m0) { m0 = el[i]; i0 = i; }
            int i1 = -1; float m1 = -INFINITY;
#pragma unroll
            for (int i = 0; i < 8; ++i) if (i != i0 && el[i] > m1) { m1 = el[i]; i1 = i; }
            const float p1 = expf(m1 - m0);
            const int li = wave * 16 + lane;
            re0[li] = live ? gi * 8 + i0 : -1; re1[li] = gi * 8 + i1; rw0[li] = gw_ / (1.f + p1); rw1[li] = gw_ * p1 / (1.f + p1); rrs[li] = rsw[lane];
        }
        if (tid < 32) lcnt[tid] = 0;
        __syncthreads();
        int myrank0 = 0, myrank1 = 0, e0 = -1, e1 = 0; float w0 = 0.f, w1 = 0.f, rs = 0.f;
        if (tid < 128) { e0 = re0[tid]; e1 = re1[tid]; w0 = rw0[tid]; w1 = rw1[tid]; rs = rrs[tid]; }
        if (e0 >= 0) { myrank0 = __hip_atomic_fetch_add(&lcnt[e0], 1, __ATOMIC_RELAXED, __HIP_MEMORY_SCOPE_WORKGROUP); myrank1 = __hip_atomic_fetch_add(&lcnt[e1], 1, __ATOMIC_RELAXED, __HIP_MEMORY_SCOPE_WORKGROUP); }
        __syncthreads();
        if (tid < 32) { const int c = lcnt[tid]; lbase[tid] = c ? (int)__hip_atomic_fetch_add(cnt + tid, (unsigned)c, __ATOMIC_RELAXED, __HIP_MEMORY_SCOPE_AGENT) : 0; }
        __syncthreads();
        if (e0 >= 0) { const int tk = (((int)blockIdx.x * 8 + (tid >> 4) + rd * NGW) * 16) + (tid & 15);
            list[(size_t)e0 * (2 * T) + lbase[e0] + myrank0] = (u32x4){(unsigned)(tk * 2), as_u(rs), as_u(w0), 0u};
            list[(size_t)e1 * (2 * T) + lbase[e1] + myrank1] = (u32x4){(unsigned)(tk * 2 + 1), as_u(rs), as_u(w1), 0u}; }
    }
}
__device__ __forceinline__ void moe_tables(const Args& a, LAS unsigned char* lds, int layer) {
    LAS int* tst = (LAS int*)(lds + LDS_MOE_TAB); LAS int* cn = tst + 64;
    const unsigned* cnt = (const unsigned*)(a.ws + WS_CTL) + CW_CNT + 64 * layer;
    if (threadIdx.x == 0) { int acc = 0; for (int e = 0; e < NEXP; ++e) { const int c = (int)__hip_atomic_load(cnt + e, __ATOMIC_RELAXED, __HIP_MEMORY_SCOPE_AGENT); tst[e] = acc; cn[e] = c; acc += (c + 255) >> 8; } tst[NEXP] = acc; }
    __syncthreads();
}
struct MoeOrder {
    const LAS int* tst; const LAS int* cn; const u32x4* list;
    const bf16_t* A; const bf16_t* Bt; int K; size_t bstride;
    int G, c, ntot;
    __device__ bool next(int i, Unit& u) const {
        const int Lx = i * G + c; if (Lx >= ntot * 4) return false;
        u.pm = Lx >> 2; u.pn = Lx & 3; int e = 0;
#pragma unroll 1
        for (int k = 1; k < NEXP; ++k) if (tst[k] <= u.pm) e = k;
        u.e = e; u.aux = u.pm - tst[e]; return true;
    }
    __device__ __forceinline__ const char* b_base(const Unit& u) const { return (const char*)Bt + (size_t)u.e * bstride + (size_t)u.pn * 256 * K * 2; }
};
struct MoeOrder1 : MoeOrder {
    static constexpr bool GATHER = true;
    __device__ __forceinline__ const char* a_base(const Unit&) const { return (const char*)A; }
    __device__ __forceinline__ void a_offs(const Unit& u, const int (&RR)[2], const int (&CC)[2], unsigned (&o)[2][2]) const {
        const int cnte = cn[u.e]; const u32x4* le = list + (size_t)u.e * (2 * T);
#pragma unroll
        for (int h = 0; h < 2; ++h)
#pragma unroll
            for (int i = 0; i < 2; ++i) { const int rank = u.aux * 256 + h * 128 + RR[i]; const int tok = rank < cnte ? (int)(((const unsigned*)(le + rank))[0] >> 1) : 0; o[h][i] = (unsigned)(tok * K + CC[i]) * 2u; }
    }
};
struct MoeOrder2 : MoeOrder {
    static constexpr bool GATHER = false;
    __device__ __forceinline__ const char* a_base(const Unit& u) const { return (const char*)A + (size_t)u.pm * 256 * K * 2; }
    __device__ __forceinline__ void a_offs(const Unit&, const int (&)[2], const int (&)[2], unsigned (&)[2][2]) const {}
};
struct EpiAct {
    static constexpr bool PERM = true;
    bf16_t* ACT; const u32x4* list; const LAS int* cn;
    __device__ __forceinline__ void operator()(const f32x4 (&acc)[2][2][4][2], const Unit& u, int wr, int wc, int fr, int fq) const {
        const int row0 = u.pm * BM + wr * 64 + fr, col0 = u.pn * 128 + wc * 32 + 8 * fq;
        const int cnte = cn[u.e]; const u32x4* le = list + (size_t)u.e * (2 * T);
        float rs[2][4];
#pragma unroll
        for (int ai = 0; ai < 2; ++ai)
#pragma unroll
            for (int m = 0; m < 4; ++m) { const int rank = u.aux * 256 + ai * HALF + wr * 64 + m * 16 + fr; rs[ai][m] = rank < cnte ? as_f(((const unsigned*)(le + rank))[1]) : 0.f; }
#pragma unroll
        for (int ai = 0; ai < 2; ++ai)
#pragma unroll
            for (int m = 0; m < 4; ++m) { bf16_t* rowp = ACT + (size_t)(row0 + ai * HALF + m * 16) * FF + col0; const float r = rs[ai][m];
                f32x4 g0 = acc[ai][0][m][0] * r, g1 = acc[ai][0][m][1] * r; const f32x4 u0 = acc[ai][1][m][0] * r, u1 = acc[ai][1][m][1] * r;
#pragma unroll
                for (int j = 0; j < 4; ++j) { g0[j] = g0[j] * sigmoidf_(g0[j]) * u0[j]; g1[j] = g1[j] * sigmoidf_(g1[j]) * u1[j]; }
                u32x4 w; w.x = cvt_pk_bf16(g0[0], g0[1]); w.y = cvt_pk_bf16(g0[2], g0[3]); w.z = cvt_pk_bf16(g1[0], g1[1]); w.w = cvt_pk_bf16(g1[2], g1[3]);
                *(u32x4*)rowp = w; }
    }
};
struct EpiY {
    static constexpr bool PERM = true;
    bf16_t* YB; const u32x4* list; const LAS int* cn;
    __device__ __forceinline__ void operator()(const f32x4 (&acc)[2][2][4][2], const Unit& u, int wr, int wc, int fr, int fq) const {
        const int cnte = cn[u.e]; const u32x4* le = list + (size_t)u.e * (2 * T);
        const int col0 = u.pn * BM + wc * 32 + 8 * fq;
        u32x4 en[2][4];
#pragma unroll
        for (int ai = 0; ai < 2; ++ai)
#pragma unroll
            for (int m = 0; m < 4; ++m) { const int rank = u.aux * 256 + ai * HALF + wr * 64 + m * 16 + fr; en[ai][m] = le[rank < cnte ? rank : 0]; }
#pragma unroll
        for (int ai = 0; ai < 2; ++ai)
#pragma unroll
            for (int m = 0; m < 4; ++m) { const int rank = u.aux * 256 + ai * HALF + wr * 64 + m * 16 + fr;
                if (rank < cnte) { const unsigned wz = en[ai][m].z; const float w = as_f(wz);   bf16_t* rowp = YB + (size_t)en[ai][m].x * D + col0;
#pragma unroll
                    for (int bj = 0; bj < 2; ++bj) { const f32x4 v0 = acc[ai][bj][m][0] * w, v1 = acc[ai][bj][m][1] * w;
                        u32x4 o; o.x = cvt_pk_bf16(v0[0], v0[1]); o.y = cvt_pk_bf16(v0[2], v0[3]); o.z = cvt_pk_bf16(v1[0], v1[1]); o.w = cvt_pk_bf16(v1[2], v1[3]);
                        *(u32x4*)(rowp + bj * HALF) = o; } } }
    }
};
template <bool NORM>
__device__ __forceinline__ void moe_combine_phase(const Args& a, const float* xin, float* xout, int wave, int lane) {
    const bf16_t* YB = (const bf16_t*)(a.ws + WS_YB); bf16_t* XN = (bf16_t*)(a.ws + WS_XN);
    const int gw = blockIdx.x * 8 + wave, NGW = gridDim.x * 8;
    for (int t = gw; t < T; t += NGW) {
        const GAS f32x4* xr = (const GAS f32x4*)(xin + (size_t)t * D) + lane; GAS f32x4* xo = (GAS f32x4*)(xout + (size_t)t * D) + lane;
        const GAS u32x2* y0 = (const GAS u32x2*)(YB + (size_t)(2 * t) * D) + lane; const GAS u32x2* y1 = (const GAS u32x2*)(YB + (size_t)(2 * t + 1) * D) + lane;
        f32x4 v[4]; float s = 0.f;
#pragma unroll
        for (int j = 0; j < 4; ++j) { v[j] = xr[64 * j]; const u32x2 p = y0[64 * j], q = y1[64 * j];
            v[j].x += bf_lo(p.x) + bf_lo(q.x); v[j].y += bf_hi(p.x) + bf_hi(q.x); v[j].z += bf_lo(p.y) + bf_lo(q.y); v[j].w += bf_hi(p.y) + bf_hi(q.y); xo[64 * j] = v[j];
            s += (v[j].x * v[j].x + v[j].y * v[j].y) + (v[j].z * v[j].z + v[j].w * v[j].w); }
        if (NORM) { const float r = rsqrtf(wave_sum(s) * (1.f / D) + EPS); GAS u32x2* o8 = (GAS u32x2*)(XN + (size_t)t * D) + lane;
#pragma unroll
            for (int j = 0; j < 4; ++j) { u32x2 o; o.x = pk2(v[j].x * r, v[j].y * r); o.y = pk2(v[j].z * r, v[j].w * r); o8[64 * j] = o; } }
    }
}
constexpr size_t WS_K2 = 320 * MiB, WS_V2 = 384 * MiB, WS_Q2 = 448 * MiB;
constexpr size_t WS_OP = 512 * MiB;
constexpr size_t WS_LP = 704 * MiB;
constexpr size_t WS_ATT = 708 * MiB;
constexpr size_t WS_SELX = 1001 * MiB;
constexpr int CW_TOT = 16384;
constexpr float ATT_C1 = 0.08838834764831845f * 1.4426950408889634f;

__device__ __forceinline__ void att_norm_phase(const Args& a, int wave, int lane) {
    const int gw = blockIdx.x * 8 + wave, NGW = gridDim.x * 8;
    for (int m = gw; m < T; m += NGW) norm_row_bf16(a.xin + (size_t)m * D, nullptr, (bf16_t*)(a.ws + WS_XN) + (size_t)m * D, lane);
}
struct EpiKVQ {
    static constexpr bool PERM = true;
    bf16_t* Ko;
    __device__ __forceinline__ void operator()(const f32x4 (&acc)[2][2][4][2], const Unit& u, int wr, int wc, int fr, int fq) const {
        const int sec = u.pn >> 2, hp = (u.pn & 3) * 2, d0 = wc * 32 + 8 * fq;
        bf16_t* base = Ko + (size_t)sec * (64 * MiB / 2);
#pragma unroll
        for (int ai = 0; ai < 2; ++ai)
#pragma unroll
            for (int m = 0; m < 4; ++m) { const int r = u.pm * BM + ai * HALF + wr * 64 + m * 16 + fr, b = r >> 13, pos = r & 8191;
#pragma unroll
                for (int bj = 0; bj < 2; ++bj) { const f32x4 v0 = acc[ai][bj][m][0], v1 = acc[ai][bj][m][1];
                    u32x4 w; w.x = cvt_pk_bf16(v0[0], v0[1]); w.y = cvt_pk_bf16(v0[2], v0[3]); w.z = cvt_pk_bf16(v1[0], v1[1]); w.w = cvt_pk_bf16(v1[2], v1[3]);
                    *(u32x4*)(base + (((size_t)(b * NH + hp + bj) * L + pos) * HD + d0)) = w; } }
    }
};
__device__ __forceinline__ void att_post_phase(const Args& a, LAS unsigned char* lds, int rep, int wave, int lane) {
    bf16_t* Kb = (bf16_t*)(a.ws + WS_K2); bf16_t* Qb = (bf16_t*)(a.ws + WS_Q2); float* KM = (float*)(a.ws + (rep ? WS_DUMMY + 96 * MiB : WS_KM));
    const size_t wofs = rep ? (WS_DUMMY - WS_K2) / 2 : 0;
    const f32x2 kw = *(const f32x2*)(a.in[9] + 2 * lane), qw = *(const f32x2*)(a.in[11] + 2 * lane);
    LAS float* cs = (LAS float*)lds;
    for (int item = blockIdx.x; item < B * NH * NBLK; item += gridDim.x) {
        const size_t row0 = (size_t)(item >> 5) * L + (size_t)(item & 31) * 256 + 32 * wave;
        float c0 = 0.f, c1 = 0.f;
#pragma unroll 4
        for (int i = 0; i < 32; ++i) {
            unsigned* kp = (unsigned*)(Kb + (row0 + i) * HD) + lane; unsigned* qp = (unsigned*)(Qb + (row0 + i) * HD) + lane;
            const unsigned ku = *kp, qu = *qp;
            float k0 = bf_lo(ku), k1 = bf_hi(ku), q0 = bf_lo(qu), q1 = bf_hi(qu);
            const float rk = rsqrtf(wave_sum(k0 * k0 + k1 * k1) * (1.f / HD) + EPS), rq = rsqrtf(wave_sum(q0 * q0 + q1 * q1) * (1.f / HD) + EPS);
            k0 *= rk * kw.x; k1 *= rk * kw.y; q0 *= rq * qw.x; q1 *= rq * qw.y;
            c0 += k0; c1 += k1;
            kp[wofs / 2] = pk2(k0, k1); qp[(rep ? (WS_DUMMY + 64 * MiB - WS_Q2) / 4 : 0)] = pk2(q0, q1);
        }
        *(LAS f32x2*)(cs + wave * 128 + 2 * lane) = (f32x2){c0, c1};
        __syncthreads();
        if (threadIdx.x < 128) { float s = 0.f;
#pragma unroll
            for (int w8 = 0; w8 < 8; ++w8) s += cs[w8 * 128 + threadIdx.x];
            KM[(size_t)item * HD + threadIdx.x] = s * (1.f / 256.f); }
        __syncthreads();
    }
}
__device__ __forceinline__ void att_sel_phase(const Args& a, LAS unsigned char* lds, int rep, int wave, int lane) {
    const bf16_t* Qb = (const bf16_t*)(a.ws + WS_Q2); const float* KM = (const float*)(a.ws + WS_KM);
    unsigned short* LISTS = (unsigned short*)(a.ws + WS_SEL); int* CNTS = (int*)(a.ws + WS_SELCNT); unsigned* TOT = (unsigned*)(a.ws + WS_CTL) + CW_TOT + 1024 * rep; int* SELX = (int*)(a.ws + WS_SELX);
    LAS float* kms = (LAS float*)lds;
    LAS int* cnts = (LAS int*)(lds + 16384);
    const int tid = threadIdx.x;
    for (int item = blockIdx.x; item < B * NH * NBLK; item += gridDim.x) {
        const int bh = item >> 5, qb = item & 31, b = bh >> 3, h = bh & 7;
        for (int i = tid; i < qb * 128; i += 512) kms[i] = KM[(size_t)bh * NBLK * HD + i];
        if (tid < 32) cnts[tid] = 0;
        __syncthreads();
        if (tid < 256) {
            const size_t qrow = (size_t)bh * L + (size_t)qb * 256 + tid;
            u32x4 qv[16];
#pragma unroll
            for (int i = 0; i < 16; ++i) qv[i] = ((const GAS u32x4*)(Qb + qrow * HD))[i];
            float v0 = -INFINITY, v1 = -INFINITY, v2 = -INFINITY; int i0 = -1, i1 = -1, i2 = -1;
#pragma unroll 1
            for (int n = 0; n < qb; ++n) {
                const LAS f32x4* kp = (const LAS f32x4*)(kms + n * 128);
                float g = 0.f;
#pragma unroll
                for (int i = 0; i < 16; ++i) { const f32x4 ka = kp[2 * i], kb2 = kp[2 * i + 1];
                    g += bf_lo(qv[i].x) * ka.x + bf_hi(qv[i].x) * ka.y + bf_lo(qv[i].y) * ka.z + bf_hi(qv[i].y) * ka.w
                       + bf_lo(qv[i].z) * kb2.x + bf_hi(qv[i].z) * kb2.y + bf_lo(qv[i].w) * kb2.z + bf_hi(qv[i].w) * kb2.w; }
                if (g > v0) { v2 = v1; i2 = i1; v1 = v0; i1 = i0; v0 = g; i0 = n; }
                else if (g > v1) { v2 = v1; i2 = i1; v1 = g; i1 = n; }
                else if (g > v2) { v2 = g; i2 = n; }
            }
            const int sel[3] = {i0, i1, i2};
#pragma unroll
            for (int s = 0; s < 3; ++s) {
                const int j = sel[s];
                if (j >= 0) { const int p = __hip_atomic_fetch_add(&cnts[j], 1, __ATOMIC_RELAXED, __HIP_MEMORY_SCOPE_WORKGROUP); LISTS[((size_t)(bh * NBLK + j) * NBLK + qb) * 256 + p] = (unsigned short)(tid | (s << 8)); }
                SELX[((size_t)(b * L + qb * 256 + tid) * NH + h) * 3 + s] = j;
            }
        }
        __syncthreads();
        if (tid < qb) { const int c = cnts[tid]; CNTS[(size_t)(bh * NBLK + tid) * NBLK + qb] = c; if (c) __hip_atomic_fetch_add(TOT + bh * NBLK + tid, (unsigned)c, __ATOMIC_RELAXED, __HIP_MEMORY_SCOPE_AGENT); }
        __syncthreads();
    }
}

constexpr int AL_K = 0, AL_V = 32768, AL_P = 65536, AL_BT = 131072, AL_TAB = 135168;
struct QRow { int qpos; int valid; };
__device__ __forceinline__ void att_stage(LAS unsigned char* lds, const bf16_t* Kg, const bf16_t* Vg, int c, int buf, int wave) {
    const int tid = threadIdx.x;
#pragma unroll
    for (int i = 0; i < 2; ++i) { const int e = tid + 512 * i, row = e >> 4, p = e & 15, ch = p ^ (((row & 3) << 2) | ((row >> 2) & 3));
        const size_t o = (size_t)c * 64 * HD + (size_t)row * HD + ch * 8;
        __builtin_amdgcn_global_load_lds((const unsigned*)(Kg + o), (LAS unsigned*)(lds + AL_K + buf * 16384 + wave * 1024 + i * 8192), 16, 0, 0);
        __builtin_amdgcn_global_load_lds((const unsigned*)(Vg + o), (LAS unsigned*)(lds + AL_V + buf * 16384 + wave * 1024 + i * 8192), 16, 0, 0); }
}
template <bool OWN>
__device__ __forceinline__ void att_tile(LAS unsigned char* lds, const bf16_t* Kg, const bf16_t* Vg, const bf16_t* const (&qptr)[2], const QRow (&qr)[2], const int (&xblk)[2], int kbase,
                                         f32x4 (&O)[8][2], float (&lsum)[2], int wave, int lane) {
    const int fr = lane & 15, fq = lane >> 4;
    const unsigned lds0 = (unsigned)(size_t)lds;
    LAS unsigned char* Pw = lds + AL_P + wave * 8192;
    const LAS float* bt = (const LAS float*)(lds + AL_BT);
    bf16x8 qf[2][4];
#pragma unroll
    for (int x = 0; x < 2; ++x)
#pragma unroll
        for (int ks = 0; ks < 4; ++ks) qf[x][ks] = *(const GAS bf16x8*)(qptr[x] + 32 * ks + 8 * fq);
#pragma unroll
    for (int db = 0; db < 8; ++db)
#pragma unroll
        for (int x = 0; x < 2; ++x) O[db][x] = (f32x4){0.f, 0.f, 0.f, 0.f};
    lsum[0] = 0.f; lsum[1] = 0.f;
    __syncthreads();
    att_stage(lds, Kg, Vg, 0, 0, wave);
    asm volatile("s_waitcnt vmcnt(0)" ::: "memory");
    __syncthreads();
    for (int c = 0; c < 4; ++c) {
        const int buf = c & 1;
        if (c < 3) att_stage(lds, Kg, Vg, c + 1, buf ^ 1, wave);
        bool act[2];
#pragma unroll
        for (int x = 0; x < 2; ++x) act[x] = OWN ? (64 * c <= 16 * xblk[x] + 15) : true;
        if (act[0] || act[1]) {
#pragma unroll
            for (int kb = 0; kb < 4; ++kb) {
                bf16x8 ka[4];
#pragma unroll
                for (int ks = 0; ks < 4; ++ks) ka[ks] = *(const LAS bf16x8*)(lds + AL_K + buf * 16384 + row_rd16(lane, kb, ks));
#pragma unroll
                for (int x = 0; x < 2; ++x) {
                    if (!act[x]) continue;
                    f32x4 s = (f32x4){0.f, 0.f, 0.f, 0.f};
#pragma unroll
                    for (int ks = 0; ks < 4; ++ks) s = __builtin_amdgcn_mfma_f32_16x16x32_bf16(ka[ks], qf[x][ks], s, 0, 0, 0);
                    const int key0 = kbase + 64 * c + 16 * kb + 4 * fq;
                    float p[4];
#pragma unroll
                    for (int r = 0; r < 4; ++r) { const int dist = qr[x].qpos - (key0 + r); const int idx = dist < 0 ? 0 : (dist > 1023 ? 1023 : dist);
                        const float e = __builtin_amdgcn_exp2f(s[r] * ATT_C1 + bt[idx]);
                        p[r] = (qr[x].valid && dist >= 0) ? e : 0.f; lsum[x] += p[r]; }
                    u32x2 o; o.x = pk2(p[0], p[1]); o.y = pk2(p[2], p[3]);
                    *(LAS u32x2*)(Pw + elem_off(16 * x + fr, 16 * kb + 4 * fq)) = o;
                }
            }
#pragma unroll
            for (int db = 0; db < 8; ++db) {
                bf16x8 vf[2];
#pragma unroll
                for (int ks = 0; ks < 2; ++ks) vf[ks] = tr_frag(lds0 + AL_V + buf * 16384 + tr_rd16(lane, db, ks, 0), lds0 + AL_V + buf * 16384 + tr_rd16(lane, db, ks, 1));
#pragma unroll
                for (int x = 0; x < 2; ++x) {
                    if (!act[x]) continue;
#pragma unroll
                    for (int ks = 0; ks < 2; ++ks) { const bf16x8 pb = *(const LAS bf16x8*)(Pw + row_rd16(lane, x, ks)); O[db][x] = __builtin_amdgcn_mfma_f32_16x16x32_bf16(vf[ks], pb, O[db][x], 0, 0, 0); }
                }
            }
        }
        asm volatile("s_waitcnt vmcnt(0)" ::: "memory");
        __syncthreads();
    }
#pragma unroll
    for (int x = 0; x < 2; ++x) { lsum[x] += __shfl_xor(lsum[x], 16); lsum[x] += __shfl_xor(lsum[x], 32); }
}
__device__ __forceinline__ void att_load_bias(const Args& a, LAS unsigned char* lds, int h) {
    LAS float* bt = (LAS float*)(lds + AL_BT); LAS float* red = (LAS float*)(lds + AL_TAB + 8192);
    const int tid = threadIdx.x;
    float m = 0.f;
    if (tid < 128) m = fabsf(a.in[11][tid]);
    else if (tid < 256) m = fabsf(a.in[9][tid - 128]);
    else m = fabsf(a.in[13][tid - 256]);
#pragma unroll
    for (int o = 1; o < 64; o <<= 1) m = fmaxf(m, __shfl_xor(m, o));
    if ((tid & 63) == 0) red[tid >> 6] = m;
    __syncthreads();
    const float mq = fmaxf(red[0], red[1]), mk = fmaxf(red[2], red[3]), mb = fmaxf(fmaxf(red[4], red[5]), fmaxf(red[6], red[7]));
    const float M = 128.f * 0.08838834764831845f * mq * mk * 1.02f + mb;
    const float* bias_tab = (const float*)(a.ws + WS_SMALL) + 2048 + h * 1024;
    for (int i = tid; i < 1024; i += 512) bt[i] = (bias_tab[i] - M) * 1.4426950408889634f;
    __syncthreads();
}
__device__ __forceinline__ void att_selatt_phase(const Args& a, LAS unsigned char* lds, int wave, int lane) {
    const bf16_t* Kb = (const bf16_t*)(a.ws + WS_K2); const bf16_t* Vb = (const bf16_t*)(a.ws + WS_V2); const bf16_t* Qb = (const bf16_t*)(a.ws + WS_Q2);
    const unsigned short* LISTS = (const unsigned short*)(a.ws + WS_SEL); const int* CNTS = (const int*)(a.ws + WS_SELCNT); const unsigned* TOT = (const unsigned*)(a.ws + WS_CTL) + CW_TOT;
    bf16_t* OP = (bf16_t*)(a.ws + WS_OP); float* LP = (float*)(a.ws + WS_LP);
    LAS int* pfx = (LAS int*)(lds + AL_TAB);
    LAS int* seg = (LAS int*)(lds + AL_TAB + 4352);
    const int tid = threadIdx.x, fr = lane & 15, fq = lane >> 4;
    if (wave == 0) {
        int loc[16]; int s = 0;
#pragma unroll
        for (int i = 0; i < 16; ++i) { const unsigned t = __hip_atomic_load(TOT + lane * 16 + i, __ATOMIC_RELAXED, __HIP_MEMORY_SCOPE_AGENT); loc[i] = s; s += (int)((t + 255u) >> 8); }
        int inc = s;
#pragma unroll
        for (int o = 1; o < 64; o <<= 1) { const int v = __shfl_up(inc, o); if (lane >= o) inc += v; }
        const int excl = inc - s;
#pragma unroll
        for (int i = 0; i < 16; ++i) pfx[lane * 16 + i] = excl + loc[i];
        if (lane == 63) pfx[1024] = inc;
    }
    __syncthreads();
    const int ntiles = pfx[1024];
    int cur_h = -1;
    for (int g = blockIdx.x; g < ntiles; g += gridDim.x) {
        int lo = 0, hi = 1024;
        while (hi - lo > 1) { const int mid = (lo + hi) >> 1; if (pfx[mid] <= g) lo = mid; else hi = mid; }
        const int lid = lo, ti = g - pfx[lid], bh = lid >> 5, j = lid & 31, h = bh & 7;
        __syncthreads();
        if (h != cur_h) { att_load_bias(a, lds, h); cur_h = h; }
        if (wave == 0) {
            int cq = 0; if (lane < NBLK) { const int v = CNTS[(size_t)lid * NBLK + lane]; cq = lane > j ? v : 0; }
            int inc = cq;
#pragma unroll
            for (int o = 1; o < 32; o <<= 1) { const int v = __shfl_up(inc, o); if (lane >= o) inc += v; }
            if (lane < NBLK) seg[lane] = inc - cq;
            if (lane == NBLK - 1) seg[NBLK] = inc;
        }
        __syncthreads();
        const int total = seg[NBLK];
        const bf16_t* qptr[2]; QRow qr[2]; int slot[2]; int xblk[2] = {0, 0};
#pragma unroll
        for (int x = 0; x < 2; ++x) {
            const int R = ti * 256 + 32 * wave + 16 * x + fr;
            qr[x].valid = R < total; qr[x].qpos = 0; slot[x] = 0;
            if (qr[x].valid) { int qb = j + 1;
#pragma unroll 1
                for (int k = j + 2; k < NBLK; ++k) if (seg[k] <= R) qb = k;
                const unsigned e = LISTS[((size_t)lid * NBLK + qb) * 256 + (R - seg[qb])];
                qr[x].qpos = qb * 256 + (int)(e & 255u); slot[x] = (int)(e >> 8); }
            qptr[x] = Qb + ((size_t)bh * L + qr[x].qpos) * HD;
        }
        f32x4 O[8][2]; float lsum[2];
        att_tile<false>(lds, Kb + ((size_t)bh * L + j * 256) * HD, Vb + ((size_t)bh * L + j * 256) * HD, qptr, qr, xblk, j * 256, O, lsum, wave, lane);
#pragma unroll
        for (int x = 0; x < 2; ++x) if (qr[x].valid) {
            const size_t ro = ((size_t)bh * L + qr[x].qpos) * 3 + slot[x];
#pragma unroll
            for (int db = 0; db < 8; ++db) { u32x2 o; o.x = pk2(O[db][x][0], O[db][x][1]); o.y = pk2(O[db][x][2], O[db][x][3]); *(u32x2*)(OP + ro * HD + 16 * db + 4 * fq) = o; }
            if (fq == 0) LP[ro] = lsum[x];
        }
    }
}
__device__ __forceinline__ void att_own_phase(const Args& a, LAS unsigned char* lds, int wave, int lane) {
    const bf16_t* Kb = (const bf16_t*)(a.ws + WS_K2); const bf16_t* Vb = (const bf16_t*)(a.ws + WS_V2); const bf16_t* Qb = (const bf16_t*)(a.ws + WS_Q2);
    const bf16_t* OP = (const bf16_t*)(a.ws + WS_OP); const float* LP = (const float*)(a.ws + WS_LP); bf16_t* ATT = (bf16_t*)(a.ws + WS_ATT);
    const int fr = lane & 15, fq = lane >> 4;
    int cur_h = -1;
    for (int item = blockIdx.x; item < B * NH * NBLK; item += gridDim.x) {
        const int bh = item >> 5, qb = item & 31, b = bh >> 3, h = bh & 7;
        __syncthreads();
        if (h != cur_h) { att_load_bias(a, lds, h); cur_h = h; }
        const bf16_t* qptr[2]; QRow qr[2]; int xblk[2] = {wave, 15 - wave};
#pragma unroll
        for (int x = 0; x < 2; ++x) { qr[x].valid = 1; qr[x].qpos = qb * 256 + 16 * xblk[x] + fr; qptr[x] = Qb + ((size_t)bh * L + qr[x].qpos) * HD; }
        f32x4 O[8][2]; float lsum[2];
        att_tile<true>(lds, Kb + ((size_t)bh * L + qb * 256) * HD, Vb + ((size_t)bh * L + qb * 256) * HD, qptr, qr, xblk, qb * 256, O, lsum, wave, lane);
        const int nsel = qb < 3 ? qb : 3;
#pragma unroll
        for (int x = 0; x < 2; ++x) {
            const size_t ro = ((size_t)bh * L + qr[x].qpos) * 3;
            float l = lsum[x];
            for (int s = 0; s < nsel; ++s) { l += LP[ro + s];
#pragma unroll
                for (int db = 0; db < 8; ++db) { const u32x2 p = *(const u32x2*)(OP + (ro + s) * HD + 16 * db + 4 * fq);
                    O[db][x][0] += bf_lo(p.x); O[db][x][1] += bf_hi(p.x); O[db][x][2] += bf_lo(p.y); O[db][x][3] += bf_hi(p.y); } }
            const float inv = 1.0f / l;
            bf16_t* orow = ATT + ((size_t)b * L + qr[x].qpos) * D + h * HD;
#pragma unroll
            for (int db = 0; db < 8; ++db) { u32x2 o; o.x = pk2(O[db][x][0] * inv, O[db][x][1] * inv); o.y = pk2(O[db][x][2] * inv, O[db][x][3] * inv); *(u32x2*)(orow + 16 * db + 4 * fq) = o; }
        }
    }
}
enum Phase { PH_PROLOGUE = 0, PH_INPROJ, PH_GLA_A, PH_GLA_SCAN, PH_GLA_C, PH_OUTPROJ, PH_END_S1,
             PH_M0_ROUTE = PH_END_S1, PH_M0_G1, PH_M0_G2, PH_M0_COMB, PH_END_S2,
             PH_A_NORM = PH_END_S2, PH_A_KVQ, PH_A_POST, PH_A_SEL, PH_A_SELATT, PH_A_OWN, PH_A_OPROJ, PH_END_S3,
             PH_M1_ROUTE = PH_END_S3, PH_M1_G1, PH_M1_G2, PH_M1_COMB, PH_END_S4,
             PH_COUNT = PH_END_S4 };
#ifndef DUP_MASK
#define DUP_MASK 0ull
#endif
#define REPS(k) ((((DUP_MASK) >> (k)) & 1ull) ? a.rep2 : 1)
#define PHASE(k) if (IN(k)) for (int rep = 0; rep < REPS(k); ++rep)
#ifndef ROUTE_FN
#define ROUTE_FN moe_route_phase
#endif
#define REPBAR() do { if (rep) xcd_barrier(bar); } while (0)
#define MOE_PHASES(base, layer) \
    PHASE(base) { REPBAR(); ROUTE_FN(a, lds, layer, (layer) + 2 * rep, a.xin, wave, lane); } \
    SEAM(base); \
    PHASE((base) + 1) { REPBAR(); moe_tables(a, lds, layer); MoeOrder1 S; S.tst = (const LAS int*)(lds + LDS_MOE_TAB); S.cn = S.tst + 64; S.list = (const u32x4*)(ws + WS_LIST); \
        S.A = (const bf16_t*)(ws + WS_XN); S.Bt = (const bf16_t*)(ws + WS_MWIN) + (size_t)(layer) * NEXP * 1024 * 1024; S.K = D; S.bstride = (size_t)1024 * 1024 * 2; S.G = gridDim.x; S.c = blockIdx.x; S.ntot = S.tst[NEXP]; \
        EpiAct E{(bf16_t*)(ws + WS_ACT), (const u32x4*)(ws + WS_LIST), S.cn}; gemm_phase<EpiAct, MoeOrder1>(lds, S, E); } \
    SEAM((base) + 1); \
    PHASE((base) + 2) { REPBAR(); moe_tables(a, lds, layer); MoeOrder2 S; S.tst = (const LAS int*)(lds + LDS_MOE_TAB); S.cn = S.tst + 64; S.list = (const u32x4*)(ws + WS_LIST); \
        S.A = (const bf16_t*)(ws + WS_ACT); S.Bt = (const bf16_t*)(ws + WS_MWOUT) + (size_t)(layer) * NEXP * 1024 * 512; S.K = FF; S.bstride = (size_t)1024 * 512 * 2; S.G = gridDim.x; S.c = blockIdx.x; S.ntot = S.tst[NEXP]; \
        EpiY E{(bf16_t*)(ws + WS_YB), (const u32x4*)(ws + WS_LIST), S.cn}; gemm_phase<EpiY, MoeOrder2>(lds, S, E); } \
    SEAM((base) + 2); \
    PHASE((base) + 3) { REPBAR(); moe_combine_phase<(layer) == 0>(a, a.xin, rep ? (float*)(ws + WS_DUMMY) : a.out, wave, lane); }

__global__ void __launch_bounds__(512, 2) fwd(Args a) {
    extern __shared__ __attribute__((aligned(16))) unsigned char smem[];
    LAS unsigned char* lds = (LAS unsigned char*)smem;
    const int tid = threadIdx.x, lane = tid & 63, wave = __builtin_amdgcn_readfirstlane(tid >> 6);
    volatile LAS unsigned* MISC = (volatile LAS unsigned*)(lds + LDS_MISC);
    if (tid < 4) MISC[tid] = 0u;
    __syncthreads();
    unsigned* ctl = (unsigned*)(a.ws + WS_CTL);
    XcdBarrier bar = xcd_barrier_post(ctl + CW_BAR, MISC);
    const int lo = a.ph_lo, hi = a.ph_hi;
    unsigned char* ws = a.ws;
#define IN(k) (lo <= (k) && (k) < hi)
#define SEAM(k) do { if (IN(k) && IN((k) + 1)) xcd_barrier(bar); } while (0)
    PHASE(PH_PROLOGUE) { REPBAR(); p0_prologue(a, lds, wave, lane); }
    SEAM(PH_PROLOGUE);
    PHASE(PH_INPROJ) { REPBAR();
        DenseOrder S; S.init((const bf16_t*)(ws + WS_XN), (const bf16_t*)(ws + WS_WIN), T, 4096, D, gridDim.x, blockIdx.x);
        EpiHG E{(bf16_t*)(ws + WS_Q), (const float*)(ws + WS_SMALL)};
        gemm_phase<EpiHG, DenseOrder>(lds, S, E);
    }
    SEAM(PH_INPROJ);
    PHASE(PH_GLA_A) { REPBAR(); gla_phase<0>(a, lds, wave, lane); }
    SEAM(PH_GLA_A);
    if (IN(PH_GLA_SCAN)) gla_scan(a);
    SEAM(PH_GLA_SCAN);
    PHASE(PH_GLA_C) { REPBAR(); gla_phase<1>(a, lds, wave, lane); }
    SEAM(PH_GLA_C);
    PHASE(PH_OUTPROJ) { REPBAR();
        DenseOrder S; S.init((const bf16_t*)(ws + WS_OG), (const bf16_t*)(ws + WS_WOUT), T, D, D, gridDim.x, blockIdx.x);
        EpiRes E{a.out, a.in[0], D};
        gemm_phase<EpiRes, DenseOrder>(lds, S, E);
    }
    SEAM(PH_OUTPROJ);
    MOE_PHASES(PH_M0_ROUTE, 0)
    SEAM(PH_M0_COMB);
    if (IN(PH_A_NORM) && !IN(PH_M0_COMB)) att_norm_phase(a, wave, lane);
    if (IN(PH_A_NORM) && !IN(PH_M0_COMB)) SEAM(PH_A_NORM);
    PHASE(PH_A_KVQ) { REPBAR();
        DenseOrder S; S.init((const bf16_t*)(ws + WS_XN), (const bf16_t*)(ws + WS_WKVQ), T, 3072, D, gridDim.x, blockIdx.x);
        EpiKVQ E{(bf16_t*)(ws + WS_K2)};
        gemm_phase<EpiKVQ, DenseOrder>(lds, S, E);
    }
    SEAM(PH_A_KVQ);
    PHASE(PH_A_POST) { REPBAR(); att_post_phase(a, lds, rep, wave, lane); }
    SEAM(PH_A_POST);
    PHASE(PH_A_SEL) { REPBAR(); att_sel_phase(a, lds, rep, wave, lane); }
    SEAM(PH_A_SEL);
    PHASE(PH_A_SELATT) { REPBAR(); att_selatt_phase(a, lds, wave, lane); }
    SEAM(PH_A_SELATT);
    PHASE(PH_A_OWN) { REPBAR(); att_own_phase(a, lds, wave, lane); }
    SEAM(PH_A_OWN);
    PHASE(PH_A_OPROJ) { REPBAR();
        DenseOrder S; S.init((const bf16_t*)(ws + WS_ATT), (const bf16_t*)(ws + WS_WO), T, D, D, gridDim.x, blockIdx.x);
        EpiRes E{rep ? (float*)(ws + WS_DUMMY) : a.out, a.xin, D};
        gemm_phase<EpiRes, DenseOrder>(lds, S, E);
    }
    SEAM(PH_A_OPROJ);
    MOE_PHASES(PH_M1_ROUTE, 1)
#undef IN
#undef SEAM
}
}

static int g_grid = 0;
static void fast_launch(void* const* d_in, const float* xin, float* d_out, void* d_ws, hipStream_t stream, int lo, int hi, bool per_phase) {
    if (g_grid == 0) {
        int dev = 0, cus = 0;
        if (hipGetDevice(&dev) != hipSuccess || hipDeviceGetAttribute(&cus, hipDeviceAttributeMultiprocessorCount, dev) != hipSuccess) { fprintf(stderr, "kernel_launch: device query failed\n"); g_grid = -1; return; }
        if (hipFuncSetAttribute((const void*)fk::fwd, hipFuncAttributeMaxDynamicSharedMemorySize, fk::LDS_BYTES) != hipSuccess) { fprintf(stderr, "kernel_launch: hipFuncSetAttribute failed\n"); g_grid = -1; return; }
        int per_cu = 0;
        if (hipOccupancyMaxActiveBlocksPerMultiprocessor(&per_cu, (const void*)fk::fwd, 512, fk::LDS_BYTES) != hipSuccess || per_cu < 1) fprintf(stderr, "kernel_launch: occupancy query says %d\n", per_cu);
        (void)hipGetLastError();
        g_grid = cus;
    }
    if (g_grid < 0) return;
    fk::Args a{};
    for (int i = 0; i < 20; ++i) a.in[i] = (const float*)d_in[i];
    a.out = d_out; a.xin = xin; a.ws = (unsigned char*)d_ws; a.rep2 = 2;
    (void)hipMemsetAsync((char*)d_ws + fk::WS_CTL, 0, fk::CTL_ZERO_BYTES, stream);
    if (per_phase) {
        for (int p = lo; p < hi; ++p) { a.ph_lo = p; a.ph_hi = p + 1; hipLaunchKernelGGL(fk::fwd, dim3(g_grid), dim3(512), fk::LDS_BYTES, stream, a); }
    } else {
        a.ph_lo = lo; a.ph_hi = hi;
        hipLaunchKernelGGL(fk::fwd, dim3(g_grid), dim3(512), fk::LDS_BYTES, stream, a);
    }
    const hipError_t le = hipPeekAtLastError();
    if (le != hipSuccess) fprintf(stderr, "kernel_launch: launch failed: %s\n", hipGetErrorName(le));
}


extern "C" void kernel_launch(void* const* d_in, const int* in_sizes, int n_in, void* d_out, int out_size, void* d_ws, size_t ws_size, hipStream_t stream) {
    if (n_in != 20 || out_size != fk::T * fk::D || ws_size < fk::WS_END) { fprintf(stderr, "kernel_launch: unexpected shapes n_in %d out %d ws %zu\n", n_in, out_size, ws_size); return; }
    float* X = (float*)d_out; unsigned char* ws = (unsigned char*)d_ws;
    const size_t N = (size_t)fk::T * fk::D;
#if DBG_STAGE == 0
    fast_launch(d_in, X, X, d_ws, stream, fk::PH_PROLOGUE, fk::PH_END_S4, HYB_PER_PHASE);
#else
    float* TMP = (float*)(ws + 800 * fk::MiB); unsigned short* FB = (unsigned short*)(ws + 928 * fk::MiB); double* ACC = (double*)(ws + 1000 * fk::MiB);
    (void)hipMemsetAsync(ACC, 0, 64, stream);
#if DBG_STAGE == 1
    fast_launch(d_in, X, TMP, d_ws, stream, fk::PH_PROLOGUE, fk::PH_END_S1, HYB_PER_PHASE);
    hipLaunchKernelGGL(dbg::k_store, dim3(4096), dim3(256), 0, stream, (const float*)TMP, (const float*)d_in[0], FB, N);
    slow::stage1(d_in, X, ws, stream);
    hipLaunchKernelGGL(dbg::k_cmp, dim3(4096), dim3(256), 0, stream, (const unsigned short*)FB, (const float*)X, (const float*)d_in[0], 0, ACC, N);
    slow::stage_moe(d_in, X, ws, stream, 0);
    slow::stage3(d_in, X, ws, stream);
    slow::stage_moe(d_in, X, ws, stream, 1);
#elif DBG_STAGE == 2
    slow::stage1(d_in, X, ws, stream);
    fast_launch(d_in, X, TMP, d_ws, stream, fk::PH_PROLOGUE, fk::PH_PROLOGUE + 1, HYB_PER_PHASE);
    fast_launch(d_in, X, TMP, d_ws, stream, fk::PH_M0_ROUTE, fk::PH_END_S2, HYB_PER_PHASE);
    hipLaunchKernelGGL(dbg::k_store, dim3(4096), dim3(256), 0, stream, (const float*)TMP, (const float*)X, FB, N);
    slow::stage_moe(d_in, X, ws, stream, 0);
    hipLaunchKernelGGL(dbg::k_cmp, dim3(4096), dim3(256), 0, stream, (const unsigned short*)FB, (const float*)(ws + 672 * fk::MiB), (const float*)nullptr, 1, ACC, N);
    slow::stage3(d_in, X, ws, stream);
    slow::stage_moe(d_in, X, ws, stream, 1);
#elif DBG_STAGE == 3
    slow::stage1(d_in, X, ws, stream);
    slow::stage_moe(d_in, X, ws, stream, 0);
    fast_launch(d_in, X, TMP, d_ws, stream, fk::PH_PROLOGUE, fk::PH_PROLOGUE + 1, HYB_PER_PHASE);
    fast_launch(d_in, X, TMP, d_ws, stream, fk::PH_A_NORM, fk::PH_END_S3, HYB_PER_PHASE);
    hipLaunchKernelGGL(dbg::k_store, dim3(4096), dim3(256), 0, stream, (const float*)TMP, (const float*)X, FB, N);
    slow::stage3(d_in, X, ws, stream, (const int*)(ws + fk::WS_SELX), (float*)(ws + 672 * fk::MiB));
    hipLaunchKernelGGL(dbg::k_cmp, dim3(4096), dim3(256), 0, stream, (const unsigned short*)FB, (const float*)(ws + 672 * fk::MiB), (const float*)nullptr, 2, ACC, N);
    slow::stage_moe(d_in, X, ws, stream, 1);
#endif
    hipLaunchKernelGGL(dbg::k_scale, dim3(4096), dim3(256), 0, stream, X, (const double*)ACC, N);
#endif
}
```

```cpp
#include <hip/hip_runtime.h>
#include <cstdio>
#include <cstdint>
#include <cmath>
#ifndef HYB_PER_PHASE
#define HYB_PER_PHASE false
#endif
#ifndef DBG_STAGE
#define DBG_STAGE 0
#endif
namespace slow {
constexpr int B = 4, L = 8192, D = 1024, T = B * L, NH = 8, HD = 128, NEXP = 32, FF = 512, NBLK = 32, BLK = 256;
constexpr int CAP = T * 2 + NEXP * 256;
constexpr float EPS = 1e-6f;

__device__ __forceinline__ float wsum(float v) {
#pragma unroll
    for (int o = 1; o < 64; o <<= 1) v += __shfl_xor(v, o);
    return v;
}
__device__ __forceinline__ float wmax(float v) {
#pragma unroll
    for (int o = 1; o < 64; o <<= 1) v = fmaxf(v, __shfl_xor(v, o));
    return v;
}
__device__ __forceinline__ int t5_bucket(int n) {
    if (n < 16) return n;
    const float lr = logf((float)n / 16.0f) / 4.1588830833596715f;
    int large = 16 + (int)(lr * 16.0f);
    return large < 31 ? large : 31;
}
__global__ void k_prep(const float* __restrict__ hg_lb, const float* __restrict__ rel_bias, float* lb, float* bias_tab) {
    const int i = blockIdx.x * blockDim.x + threadIdx.x;
    if (i < 1024) { const float a = hg_lb[i], b = hg_lb[1024 + i], m = fmaxf(a, b), ea = expf(a - m), eb = expf(b - m); lb[i] = ea / (ea + eb); }
    if (i < 8 * 1024) { const int h = i >> 10, d = i & 1023; bias_tab[i] = rel_bias[t5_bucket(d) * 8 + h]; }
}
template <int N> __global__ void k_rmsnorm(const float* __restrict__ x, const float* __restrict__ w, float* __restrict__ y, int rows) {
    const int row = blockIdx.x * (blockDim.x >> 6) + (threadIdx.x >> 6), lane = threadIdx.x & 63;
    if (row >= rows) return;
    const float* xr = x + (size_t)row * N; float* yr = y + (size_t)row * N;
    float s = 0.f;
    for (int i = lane; i < N; i += 64) { const float v = xr[i]; s += v * v; }
    s = wsum(s);
    const float r = rsqrtf(s * (1.0f / N) + EPS);
    for (int i = lane; i < N; i += 64) yr[i] = xr[i] * r * w[i];
}
__global__ void k_headnorm(const float* __restrict__ x, int ld, int col0, const float* __restrict__ w, float* __restrict__ y, int ldy) {
    const int gw = blockIdx.x * (blockDim.x >> 6) + (threadIdx.x >> 6), lane = threadIdx.x & 63;
    if (gw >= T * NH) return;
    const int t = gw >> 3, h = gw & 7;
    const float* xr = x + (size_t)t * ld + col0 + h * HD;
    const float a = xr[lane], b = xr[lane + 64];
    const float s = wsum(a * a + b * b);
    const float r = rsqrtf(s * (1.0f / HD) + EPS);
    float* yr = y + (size_t)t * ldy + h * HD;
    yr[lane] = a * r * w[lane]; yr[lane + 64] = b * r * w[lane + 64];
}
struct GemmP {
    const float* A; int lda; const int* arow;
    const float* W; int ldw; size_t wstride; const int* tile_e;
    float* C; int ldc; const int* crow; const float* cscale; const float* R;
    int M, N, K, pad;
};
__global__ __launch_bounds__(256) void k_gemm(GemmP p) {
    __shared__ float As[16][68];
    __shared__ float Ws[16][68];
    const int tm = blockIdx.y, tn = blockIdx.x, tid = threadIdx.x;
    int e = 0;
    if (p.tile_e) { e = p.tile_e[tm]; if (e < 0) return; }
    const float* W = p.W + (size_t)e * p.wstride;
    const int ar = tid >> 2, ak = (tid & 3) * 4;
    const int wk = tid >> 4, wn = (tid & 15) * 4;
    const int m0 = tm * 64, n0 = tn * 64;
    int arow = m0 + ar; if (p.arow) { arow = p.arow[m0 + ar]; if (arow < 0) arow = 0; }
    const float* Ap = p.A + (size_t)arow * p.lda + ak;
    const float* Wp = W + (size_t)wk * p.ldw + n0 + wn;
    const int ty = tid >> 4, tx = tid & 15;
    float acc[4][4];
#pragma unroll
    for (int i = 0; i < 4; ++i)
#pragma unroll
        for (int j = 0; j < 4; ++j) acc[i][j] = 0.f;
    for (int k0 = 0; k0 < p.K; k0 += 16) {
        const float4 av = *(const float4*)(Ap + k0);
        const float4 wv = *(const float4*)(Wp + (size_t)k0 * p.ldw);
        __syncthreads();
        As[ak + 0][ar] = av.x; As[ak + 1][ar] = av.y; As[ak + 2][ar] = av.z; As[ak + 3][ar] = av.w;
        *(float4*)&Ws[wk][wn] = wv;
        __syncthreads();
#pragma unroll
        for (int kk = 0; kk < 16; ++kk) {
            const float4 a = *(const float4*)&As[kk][ty * 4];
            const float4 b = *(const float4*)&Ws[kk][tx * 4];
            const float aa[4] = {a.x, a.y, a.z, a.w}, bb[4] = {b.x, b.y, b.z, b.w};
#pragma unroll
            for (int i = 0; i < 4; ++i)
#pragma unroll
                for (int j = 0; j < 4; ++j) acc[i][j] += aa[i] * bb[j];
        }
    }
#pragma unroll
    for (int i = 0; i < 4; ++i) {
        const int m = m0 + ty * 4 + i;
        int cr = m; float sc = 1.f;
        if (p.crow) { cr = p.crow[m]; if (cr < 0) continue; }
        if (p.cscale) sc = p.cscale[cr];
        float* Cp = p.C + (size_t)cr * p.ldc + n0 + tx * 4;
        float4 o = make_float4(acc[i][0] * sc, acc[i][1] * sc, acc[i][2] * sc, acc[i][3] * sc);
        if (p.R) { const float4 r = *(const float4*)(p.R + (size_t)cr * p.ldc + n0 + tx * 4); o.x += r.x; o.y += r.y; o.z += r.z; o.w += r.w; }
        *(float4*)Cp = o;
    }
}
__global__ void k_hg_gates(float* proj, const float* __restrict__ lb) {
    const size_t i = (size_t)blockIdx.x * blockDim.x + threadIdx.x;
    if (i >= (size_t)T * 1024) return;
    const size_t t = i >> 10; const int c = (int)(i & 1023);
    float* row = proj + t * 4096;
    row[c] *= 0.08838834764831845f;
    const float l = lb[c], z = row[1024 + c];
    row[1024 + c] = l + (1.f - l) * (1.f / (1.f + expf(-z)));
}
__global__ __launch_bounds__(128) void k_gla(const float* __restrict__ proj, float* __restrict__ o) {
    const int bh = blockIdx.x, b = bh >> 3, h = bh & 7, dv = threadIdx.x;
    float S[128];
#pragma unroll
    for (int d = 0; d < 128; ++d) S[d] = 0.f;
    const float* base = proj + (size_t)b * L * 4096 + h * 128;
    for (int t = 0; t < L; ++t) {
        const float* row = base + (size_t)t * 4096;
        const float v = row[2048 + dv];
        float acc = 0.f;
#pragma unroll
        for (int d = 0; d < 128; ++d) { const float f = row[1024 + d], q = row[d]; S[d] = f * S[d] + (1.f - f) * v; acc += q * S[d]; }
        o[((size_t)b * L + t) * 1024 + h * 128 + dv] = acc;
    }
}
__global__ void k_onorm_gate(const float* __restrict__ o, const float* __restrict__ proj, const float* __restrict__ w, float* __restrict__ og) {
    const int gw = blockIdx.x * (blockDim.x >> 6) + (threadIdx.x >> 6), lane = threadIdx.x & 63;
    if (gw >= T * NH) return;
    const int t = gw >> 3, h = gw & 7;
    const float* xr = o + (size_t)t * 1024 + h * HD;
    const float a = xr[lane], b = xr[lane + 64];
    const float r = rsqrtf(wsum(a * a + b * b) * (1.0f / HD) + EPS);
    const float* g = proj + (size_t)t * 4096 + 3072 + h * HD;
    const float g0 = g[lane], g1 = g[lane + 64];
    float* yr = og + (size_t)t * 1024 + h * HD;
    yr[lane] = a * r * w[lane] * (g0 / (1.f + expf(-g0)));
    yr[lane + 64] = b * r * w[lane + 64] * (g1 / (1.f + expf(-g1)));
}
__global__ void k_route(const float* __restrict__ h2, const float* __restrict__ wg, const float* __restrict__ bg, const float* __restrict__ we, const float* __restrict__ be,
                        int* cnt, int* list, float* wgt) {
    const int t = blockIdx.x * (blockDim.x >> 6) + (threadIdx.x >> 6), lane = threadIdx.x & 63;
    if (t >= T) return;
    const float* xr = h2 + (size_t)t * D;
    float acc = 0.f;
    const bool isg = lane < 4, ise = lane >= 32;
    for (int k = 0; k < D; ++k) {
        const float xv = xr[k];
        float w = 0.f;
        if (isg) w = wg[k * 4 + lane]; else if (ise) w = we[k * 32 + (lane - 32)];
        acc += xv * w;
    }
    if (isg) acc += bg[lane]; else if (ise) acc += be[lane - 32];
    float gl[4];
#pragma unroll
    for (int i = 0; i < 4; ++i) gl[i] = __shfl(acc, i);
    int gi = 0; float gm = gl[0];
#pragma unroll
    for (int i = 1; i < 4; ++i) if (gl[i] > gm) { gm = gl[i]; gi = i; }
    float gs = 0.f;
#pragma unroll
    for (int i = 0; i < 4; ++i) gs += expf(gl[i] - gm);
    const float gw_ = 1.0f / gs;
    float el[8];
#pragma unroll
    for (int i = 0; i < 8; ++i) el[i] = __shfl(acc, 32 + gi * 8 + i);
    int i0 = 0; float m0 = el[0];
#pragma unroll
    for (int i = 1; i < 8; ++i) if (el[i] > m0) { m0 = el[i]; i0 = i; }
    int i1 = -1; float m1 = -INFINITY;
#pragma unroll
    for (int i = 0; i < 8; ++i) if (i != i0 && el[i] > m1) { m1 = el[i]; i1 = i; }
    const float p1 = expf(m1 - m0);
    const float w0 = gw_ / (1.f + p1), w1 = gw_ * p1 / (1.f + p1);
    if (lane == 0) {
        const int e0 = gi * 8 + i0, e1 = gi * 8 + i1;
        const int r0 = atomicAdd(&cnt[e0], 1); list[(size_t)e0 * (2 * T) + r0] = t * 2;     wgt[t * 2] = w0;
        const int r1 = atomicAdd(&cnt[e1], 1); list[(size_t)e1 * (2 * T) + r1] = t * 2 + 1; wgt[t * 2 + 1] = w1;
    }
}
__global__ void k_moe_rows(const int* __restrict__ cnt, const int* __restrict__ list, int* row_src, int* row_dst, int* tile_e) {
    const int r = blockIdx.x * blockDim.x + threadIdx.x;
    if (r >= CAP) return;
    int start = 0, e = -1, rank = 0;
    for (int i = 0; i < NEXP; ++i) { const int c = cnt[i], pc = (c + 255) & ~255; if (r >= start && r < start + pc) { e = i; rank = r - start; } start += pc; }
    int src = -1, dst = -1;
    if (e >= 0 && rank < cnt[e]) { dst = list[(size_t)e * (2 * T) + rank]; src = dst >> 1; }
    row_src[r] = src; row_dst[r] = dst;
    if ((r & 63) == 0) tile_e[r >> 6] = e;
}
__global__ void k_silu_mul(const float* __restrict__ hu, float* __restrict__ act) {
    const size_t i = (size_t)blockIdx.x * blockDim.x + threadIdx.x;
    if (i >= (size_t)CAP * FF) return;
    const size_t r = i / FF; const int c = (int)(i % FF);
    const float a = hu[r * 1024 + c], b = hu[r * 1024 + 512 + c];
    act[i] = a / (1.f + expf(-a)) * b;
}
__global__ void k_combine(float* x, const float* __restrict__ ybuf) {
    const size_t i = (size_t)blockIdx.x * blockDim.x + threadIdx.x;
    if (i >= (size_t)T * D) return;
    const size_t t = i >> 10; const int c = (int)(i & 1023);
    x[i] += ybuf[(t * 2) * D + c] + ybuf[(t * 2 + 1) * D + c];
}
__global__ void k_kv_split(const float* __restrict__ kv, const float* __restrict__ knw, float* __restrict__ K, float* __restrict__ V) {
    const int gw = blockIdx.x * (blockDim.x >> 6) + (threadIdx.x >> 6), lane = threadIdx.x & 63;
    if (gw >= T * NH) return;
    const int t = gw >> 3, h = gw & 7, b = t / L, pos = t % L;
    const float* kr = kv + (size_t)t * 2048 + h * HD;
    const float a = kr[lane], c = kr[lane + 64];
    const float r = rsqrtf(wsum(a * a + c * c) * (1.0f / HD) + EPS);
    const size_t o = (((size_t)b * NH + h) * L + pos) * HD;
    K[o + lane] = a * r * knw[lane]; K[o + lane + 64] = c * r * knw[lane + 64];
    V[o + lane] = kr[1024 + lane]; V[o + lane + 64] = kr[1024 + lane + 64];
}
__global__ void k_kmean(const float* __restrict__ K, float* __restrict__ km) {
    const int bhn = blockIdx.x, d = threadIdx.x;
    const float* p = K + (size_t)bhn * BLK * HD + d;
    float s = 0.f;
    for (int j = 0; j < BLK; ++j) s += p[(size_t)j * HD];
    km[(size_t)bhn * HD + d] = s * (1.0f / BLK);
}
__global__ __launch_bounds__(256) void k_moba(const float* __restrict__ q, const float* __restrict__ K, const float* __restrict__ V, const float* __restrict__ km,
                                              const float* __restrict__ bias_tab, float* __restrict__ att, int* __restrict__ sel_out, const int* __restrict__ sel_in) {
    __shared__ float qs[128];
    __shared__ float gate[32];
    __shared__ int selb[4];
    __shared__ float lg[4][256];
    __shared__ float red[8];
    __shared__ float osum[128];
    const int bid = blockIdx.x, t = bid >> 3, h = bid & 7, b = t / L, pos = t % L, blk = pos >> 8, tid = threadIdx.x, lane = tid & 63, wv = tid >> 6;
    if (tid < 128) qs[tid] = q[(size_t)t * 1024 + h * HD + tid];
    __syncthreads();
    const size_t bh = (size_t)b * NH + h;
    if (tid < 32) {
        float g = -INFINITY;
        if (tid < blk) { const float* kp = km + (bh * NBLK + tid) * HD; float s = 0.f; for (int d = 0; d < HD; ++d) s += qs[d] * kp[d]; g = s; }
        gate[tid] = g;
    }
    __syncthreads();
    const int nsel = blk < 3 ? blk : 3;
    if (tid == 0 && sel_in) { selb[0] = sel_in[(size_t)bid * 3 + 0]; selb[1] = sel_in[(size_t)bid * 3 + 1]; selb[2] = sel_in[(size_t)bid * 3 + 2]; selb[3] = blk; }
    if (tid == 0 && !sel_in) {
        int u0 = -1, u1 = -1;
        for (int s = 0; s < 3; ++s) {
            int bi = -1; float bv = -INFINITY;
            for (int n = 0; n < blk; ++n) { if (n == u0 || n == u1) continue; if (bi < 0 || gate[n] > bv) { bv = gate[n]; bi = n; } }
            selb[s] = bi; if (s == 0) u0 = bi; else if (s == 1) u1 = bi;
        }
        selb[3] = blk;
        if (sel_out) { sel_out[(size_t)bid * 3 + 0] = selb[0]; sel_out[(size_t)bid * 3 + 1] = selb[1]; sel_out[(size_t)bid * 3 + 2] = selb[2]; }
    }
    __syncthreads();
    const float scale = 0.08838834764831845f;
    float mx = -INFINITY;
    for (int s = 0; s < 4; ++s) {
        float l = -INFINITY;
        const bool on = (s == 3) || (s < nsel);
        if (on) {
            const int kb = selb[s], kpos = kb * BLK + tid, dist = pos - kpos;
            if (dist >= 0) {
                const float* kp = K + (bh * L + kpos) * HD; float a = 0.f;
                for (int d = 0; d < HD; ++d) a += qs[d] * kp[d];
                l = a * scale + bias_tab[h * 1024 + (dist < 1023 ? dist : 1023)];
            }
        }
        lg[s][tid] = l; mx = fmaxf(mx, l);
    }
    mx = wmax(mx); if (lane == 0) red[wv] = mx; __syncthreads();
    mx = fmaxf(fmaxf(red[0], red[1]), fmaxf(red[2], red[3])); __syncthreads();
    float sm = 0.f;
    for (int s = 0; s < 4; ++s) { const float l = lg[s][tid]; const float p = (l == -INFINITY) ? 0.f : expf(l - mx); lg[s][tid] = p; sm += p; }
    sm = wsum(sm); if (lane == 0) red[4 + wv] = sm; __syncthreads();
    sm = red[4] + red[5] + red[6] + red[7];
    const int d = tid & 127, half = tid >> 7;
    float o = 0.f;
    for (int s = 0; s < 4; ++s) {
        const bool on = (s == 3) || (s < nsel);
        if (!on) continue;
        const float* vp = V + (bh * L + (size_t)selb[s] * BLK + half * 128) * HD + d;
        for (int j = 0; j < 128; ++j) o += lg[s][half * 128 + j] * vp[(size_t)j * HD];
    }
    if (half == 1) osum[d] = o;
    __syncthreads();
    if (half == 0) att[(size_t)t * 1024 + h * HD + d] = (o + osum[d]) / sm;
}

struct Bufs {
    float *lb, *bias_tab, *wgt, *km; int *cnt, *list, *row_src, *row_dst, *tile_e, *sel;
    float *HN, *BIG, *O;
};
constexpr size_t MiB = 1u << 20;
static void launch_gemm(hipStream_t s, GemmP p) { dim3 g(p.N / 64, p.M / 64); hipLaunchKernelGGL(k_gemm, g, dim3(256), 0, s, p); }

static void moe_layer(hipStream_t s, const Bufs& bf, float* X, int layer, void* const* d_in) {
    const float* ffn_norm = (const float*)d_in[2] + layer * D;
    const float* wg = (const float*)d_in[14] + (size_t)layer * D * 4;  const float* bg = (const float*)d_in[15] + layer * 4;
    const float* we = (const float*)d_in[16] + (size_t)layer * D * 32; const float* be = (const float*)d_in[17] + layer * 32;
    const float* win = (const float*)d_in[18] + (size_t)layer * NEXP * D * 1024;
    const float* wout = (const float*)d_in[19] + (size_t)layer * NEXP * FF * D;
    float* HU = bf.BIG;
    float* ACT = bf.BIG + (size_t)CAP * 1024;
    float* YB = bf.O;
    hipLaunchKernelGGL(k_rmsnorm<1024>, dim3(T / 4), dim3(256), 0, s, X, ffn_norm, bf.HN, T);
    (void)hipMemsetAsync(bf.cnt, 0, 32 * sizeof(int), s);
    hipLaunchKernelGGL(k_route, dim3(T / 4), dim3(256), 0, s, bf.HN, wg, bg, we, be, bf.cnt, bf.list, bf.wgt);
    hipLaunchKernelGGL(k_moe_rows, dim3((CAP + 255) / 256), dim3(256), 0, s, bf.cnt, bf.list, bf.row_src, bf.row_dst, bf.tile_e);
    GemmP p1{}; p1.A = bf.HN; p1.lda = D; p1.arow = bf.row_src; p1.W = win; p1.ldw = 1024; p1.wstride = (size_t)D * 1024; p1.tile_e = bf.tile_e;
    p1.C = HU; p1.ldc = 1024; p1.M = CAP; p1.N = 1024; p1.K = D; launch_gemm(s, p1);
    hipLaunchKernelGGL(k_silu_mul, dim3((unsigned)(((size_t)CAP * FF + 255) / 256)), dim3(256), 0, s, HU, ACT);
    GemmP p2{}; p2.A = ACT; p2.lda = FF; p2.W = wout; p2.ldw = D; p2.wstride = (size_t)FF * D; p2.tile_e = bf.tile_e;
    p2.C = YB; p2.ldc = D; p2.crow = bf.row_dst; p2.cscale = bf.wgt; p2.M = CAP; p2.N = D; p2.K = FF; launch_gemm(s, p2);
    hipLaunchKernelGGL(k_combine, dim3((unsigned)(((size_t)T * D + 255) / 256)), dim3(256), 0, s, X, YB);
}

static Bufs make_bufs(unsigned char* ws) {
    Bufs bf;
    bf.cnt = (int*)(ws + 0); bf.lb = (float*)(ws + 4096); bf.bias_tab = (float*)(ws + 8192);
    bf.wgt = (float*)(ws + 1 * MiB); bf.km = (float*)(ws + 2 * MiB);
    bf.row_src = (int*)(ws + 3 * MiB); bf.row_dst = (int*)(ws + 4 * MiB); bf.tile_e = (int*)(ws + 5 * MiB);
    bf.sel = (int*)(ws + 6 * MiB);
    bf.list = (int*)(ws + 16 * MiB);
    bf.HN = (float*)(ws + 32 * MiB);
    bf.BIG = (float*)(ws + 160 * MiB);
    bf.O = (float*)(ws + 672 * MiB);
    return bf;
}
static void stage1(void* const* d_in, float* X, unsigned char* ws, hipStream_t s) {
    Bufs bf = make_bufs(ws);
    const float* x = (const float*)d_in[0]; const float* mix_norm = (const float*)d_in[1];
    const float* hg_w_in = (const float*)d_in[3]; const float* hg_lb = (const float*)d_in[4]; const float* hg_o_norm = (const float*)d_in[5]; const float* hg_w_out = (const float*)d_in[6];
    hipLaunchKernelGGL(k_prep, dim3(32), dim3(256), 0, s, hg_lb, (const float*)d_in[13], bf.lb, bf.bias_tab);
    hipLaunchKernelGGL(k_rmsnorm<1024>, dim3(T / 4), dim3(256), 0, s, x, mix_norm, bf.HN, T);
    float* PROJ = bf.BIG;
    { GemmP p{}; p.A = bf.HN; p.lda = D; p.W = hg_w_in; p.ldw = 4096; p.C = PROJ; p.ldc = 4096; p.M = T; p.N = 4096; p.K = D; launch_gemm(s, p); }
    hipLaunchKernelGGL(k_hg_gates, dim3((unsigned)(((size_t)T * 1024 + 255) / 256)), dim3(256), 0, s, PROJ, bf.lb);
    hipLaunchKernelGGL(k_gla, dim3(B * NH), dim3(128), 0, s, PROJ, bf.O);
    hipLaunchKernelGGL(k_onorm_gate, dim3(T * NH / 4), dim3(256), 0, s, bf.O, PROJ, hg_o_norm, bf.HN);
    { GemmP p{}; p.A = bf.HN; p.lda = D; p.W = hg_w_out; p.ldw = D; p.C = X; p.ldc = D; p.R = x; p.M = T; p.N = D; p.K = D; launch_gemm(s, p); }
}
static void stage_moe(void* const* d_in, float* X, unsigned char* ws, hipStream_t s, int layer) { Bufs bf = make_bufs(ws); moe_layer(s, bf, X, layer, d_in); }
__global__ void k_add(float* x, const float* __restrict__ y, size_t n) { for (size_t i = (size_t)blockIdx.x * blockDim.x + threadIdx.x; i < n; i += (size_t)gridDim.x * blockDim.x) x[i] += y[i]; }
static void stage3(void* const* d_in, float* X, unsigned char* ws, hipStream_t s, const int* sel_in = nullptr, float* branch_out = nullptr) {
    Bufs bf = make_bufs(ws);
    const float* mix_norm = (const float*)d_in[1];
    const float* kv_norm = (const float*)d_in[7]; const float* w_kv = (const float*)d_in[8]; const float* k_norm = (const float*)d_in[9];
    const float* att_w_q = (const float*)d_in[10]; const float* q_norm = (const float*)d_in[11]; const float* att_w_o = (const float*)d_in[12]; const float* rel_bias = (const float*)d_in[13];
    hipLaunchKernelGGL(k_prep, dim3(32), dim3(256), 0, s, (const float*)d_in[4], rel_bias, bf.lb, bf.bias_tab);
    hipLaunchKernelGGL(k_rmsnorm<1024>, dim3(T / 4), dim3(256), 0, s, X, kv_norm, bf.HN, T);
    float* KV = bf.BIG; float* Kb = bf.BIG + (size_t)T * 2048; float* Vb = Kb + (size_t)T * 1024;
    { GemmP p{}; p.A = bf.HN; p.lda = D; p.W = w_kv; p.ldw = 2048; p.C = KV; p.ldc = 2048; p.M = T; p.N = 2048; p.K = D; launch_gemm(s, p); }
    hipLaunchKernelGGL(k_kv_split, dim3(T * NH / 4), dim3(256), 0, s, KV, k_norm, Kb, Vb);
    hipLaunchKernelGGL(k_kmean, dim3(B * NH * NBLK), dim3(128), 0, s, Kb, bf.km);
    hipLaunchKernelGGL(k_rmsnorm<1024>, dim3(T / 4), dim3(256), 0, s, X, mix_norm + D, bf.HN, T);
    float* Q = bf.BIG; float* ATT = bf.BIG + (size_t)T * 1024;
    { GemmP p{}; p.A = bf.HN; p.lda = D; p.W = att_w_q; p.ldw = D; p.C = Q; p.ldc = D; p.M = T; p.N = D; p.K = D; launch_gemm(s, p); }
    hipLaunchKernelGGL(k_headnorm, dim3(T * NH / 4), dim3(256), 0, s, Q, D, 0, q_norm, Q, D);
    hipLaunchKernelGGL(k_moba, dim3(T * NH), dim3(256), 0, s, Q, Kb, Vb, bf.km, bf.bias_tab, ATT, bf.sel, sel_in);
    if (branch_out) { GemmP p{}; p.A = ATT; p.lda = D; p.W = att_w_o; p.ldw = D; p.C = branch_out; p.ldc = D; p.M = T; p.N = D; p.K = D; launch_gemm(s, p);
        hipLaunchKernelGGL(k_add, dim3(4096), dim3(256), 0, s, X, (const float*)branch_out, (size_t)T * D); }
    else { GemmP p{}; p.A = ATT; p.lda = D; p.W = att_w_o; p.ldw = D; p.C = X; p.ldc = D; p.R = X; p.M = T; p.N = D; p.K = D; launch_gemm(s, p); }
}
}
namespace dbg {
__device__ __forceinline__ unsigned f2bf(float f) { unsigned u = __builtin_bit_cast(unsigned, f); return (u + 0x7fffu + ((u >> 16) & 1u)) >> 16; }
__global__ void k_store(const float* __restrict__ a, const float* __restrict__ b, unsigned short* __restrict__ out, size_t n) {
    for (size_t i = (size_t)blockIdx.x * blockDim.x + threadIdx.x; i < n; i += (size_t)gridDim.x * blockDim.x) out[i] = (unsigned short)f2bf(a[i] - b[i]);
}
__global__ void k_cmp(const unsigned short* __restrict__ fb, const float* __restrict__ s1, const float* __restrict__ s2, int mode, double* acc, size_t n) {
    double num = 0.0, den = 0.0;
    for (size_t i = (size_t)blockIdx.x * blockDim.x + threadIdx.x; i < n; i += (size_t)gridDim.x * blockDim.x) {
        float sl;
        if (mode == 0) sl = s1[i] - s2[i];
        else if (mode == 1) { const size_t t = i >> 10, c = i & 1023; sl = s1[(2 * t) * 1024 + c] + s1[(2 * t + 1) * 1024 + c]; }
        else sl = s1[i];
        const float f = __builtin_bit_cast(float, (unsigned)fb[i] << 16);
        const double d = (double)f - (double)sl; num += d * d; den += (double)sl * (double)sl;
    }
    for (int o = 32; o >= 1; o >>= 1) { num += __shfl_xor(num, o); den += __shfl_xor(den, o); }
    if ((threadIdx.x & 63) == 0) { atomicAdd(acc, num); atomicAdd(acc + 1, den); }
}
__global__ void k_scale(float* out, const double* acc, size_t n) {
    const float f = 1.0f + (float)sqrt(acc[0] / acc[1]);
    for (size_t i = (size_t)blockIdx.x * blockDim.x + threadIdx.x; i < n; i += (size_t)gridDim.x * blockDim.x) out[i] *= f;
}
}
namespace fk {
constexpr int B = 4, L = 8192, D = 1024, T = B * L, NH = 8, HD = 128, NEXP = 32, FF = 512, NBLK = 32, BLK = 256;
constexpr float EPS = 1e-6f;
#define LAS __attribute__((address_space(3)))
#define GAS __attribute__((address_space(1)))
typedef unsigned short bf16_t;
typedef short bf16x8 __attribute__((ext_vector_type(8)));
typedef short bf16x4 __attribute__((ext_vector_type(4)));
typedef float f32x4 __attribute__((ext_vector_type(4)));
typedef float f32x2 __attribute__((ext_vector_type(2)));
typedef unsigned u32x4 __attribute__((ext_vector_type(4)));
typedef unsigned u32x2 __attribute__((ext_vector_type(2)));
#define LDS_WAIT() asm volatile("s_waitcnt lgkmcnt(0)" ::: "memory")
#define VM_WAIT() asm volatile("s_waitcnt vmcnt(0)" ::: "memory")
__device__ __forceinline__ unsigned f2bf(float f) { unsigned u = __builtin_bit_cast(unsigned, f); return (u + 0x7fffu + ((u >> 16) & 1u)) >> 16; }
__device__ __forceinline__ unsigned pk2(float lo, float hi) { return f2bf(lo) | (f2bf(hi) << 16); }
__device__ __forceinline__ float as_f(unsigned u) { return __builtin_bit_cast(float, u); }
__device__ __forceinline__ unsigned as_u(float f) { return __builtin_bit_cast(unsigned, f); }
__device__ __forceinline__ float bf_lo(unsigned u) { return __builtin_bit_cast(float, u << 16); }
__device__ __forceinline__ float bf_hi(unsigned u) { return __builtin_bit_cast(float, u & 0xffff0000u); }
__device__ __forceinline__ float wave_sum(float v) {
#pragma unroll
    for (int o = 1; o < 64; o <<= 1) v += __shfl_xor(v, o);
    return v;
}
__device__ __forceinline__ float sigmoidf_(float z) { return 1.0f / (1.0f + __expf(-z)); }

#define XB_TMO      128
#define XB_XCNT(j)  (256  + 64 * (j))
#define XB_XSUB(j)  (1280 + 64 * (j))
#define XB_XGEN(j)  (2304 + 64 * (j))
#define XB_TOP      3328
#define XB_TOPGEN   3392
#define XCD_BAR_WORDS 3456
#define XB_SPIN_CAP (1u << 18)
__device__ __forceinline__ unsigned xb_ld(unsigned* p)              { return __hip_atomic_load(p, __ATOMIC_RELAXED, __HIP_MEMORY_SCOPE_AGENT); }
__device__ __forceinline__ unsigned xb_add(unsigned* p, unsigned v) { return __hip_atomic_fetch_add(p, v, __ATOMIC_RELAXED, __HIP_MEMORY_SCOPE_AGENT); }
__device__ __forceinline__ unsigned xb_xcc_id() { return (unsigned)__builtin_amdgcn_s_getreg((3 << 11) | 20) & 0xFu; }
#define XB_SPIN(cond, bar) do { unsigned _sp = 0; while (cond) { __builtin_amdgcn_s_sleep(1); \
    if ((++_sp & 255u) == 0u) { if (xb_ld(&(bar)[XB_TMO])) break; if (_sp > XB_SPIN_CAP) { atomicAdd(&(bar)[XB_TMO], 1u); break; } } } } while (0)
struct XcdBarrier { unsigned* bar; unsigned x; volatile LAS unsigned* st; };
__device__ __forceinline__ XcdBarrier xcd_barrier_post(unsigned* bar, volatile LAS unsigned* st) {
    XcdBarrier b; b.bar = bar; b.x = xb_xcc_id(); b.st = st;
    if (threadIdx.x == 0) (void)xb_add(&bar[XB_XCNT(b.x)], 1u);
    return b;
}
__device__ __forceinline__ void xcd_barrier_complete(unsigned* bar, unsigned x, unsigned& nloc, unsigned& nx) {
    const unsigned G = gridDim.x * gridDim.y * gridDim.z;
    unsigned sum, cnt, mine, sp = 0u;
    for (;;) {
        sum = 0u; cnt = 0u; mine = 0u;
#pragma unroll
        for (unsigned j = 0; j < 16; ++j) { const unsigned c = xb_ld(&bar[XB_XCNT(j)]); sum += c; cnt += (c > 0u) ? 1u : 0u; mine = (j == x) ? c : mine; }
        if (sum == G) break;
        __builtin_amdgcn_s_sleep(1);
        if ((++sp & 255u) == 0u) { if (xb_ld(&bar[XB_TMO])) break; if (sp > XB_SPIN_CAP) { atomicAdd(&bar[XB_TMO], 1u); break; } }
    }
    nloc = mine > 0u ? mine : 1u; nx = cnt > 0u ? cnt : 1u;
}
__device__ __forceinline__ void xcd_barrier(const XcdBarrier& b) {
    asm volatile("s_waitcnt vmcnt(0)" ::: "memory");
    __syncthreads();
    if (threadIdx.x == 0) {
        unsigned* bar = b.bar;
        __builtin_amdgcn_s_waitcnt(0);
        unsigned nloc = b.st[0], nx = b.st[1];
        if (nloc == 0u) { xcd_barrier_complete(bar, b.x, nloc, nx); b.st[0] = nloc; b.st[1] = nx; }
        const unsigned old = xb_add(&bar[XB_XSUB(b.x)], 1u);
        const unsigned gen = old / nloc;
        if (old + 1u == (gen + 1u) * nloc) {
            __builtin_amdgcn_fence(__ATOMIC_RELEASE, "agent");
            asm volatile("s_waitcnt vmcnt(0)" ::: "memory");
            const unsigned og = xb_add(&bar[XB_TOP], 1u);
            const unsigned tg = og / nx;
            if (og + 1u == (tg + 1u) * nx) xb_add(&bar[XB_TOPGEN], 1u);
            else XB_SPIN(xb_ld(&bar[XB_TOPGEN]) == tg, bar);
            __builtin_amdgcn_fence(__ATOMIC_ACQUIRE, "agent");
            xb_add(&bar[XB_XGEN(b.x)], 1u);
            asm volatile("s_waitcnt vmcnt(0)" ::: "memory");
        } else {
            XB_SPIN(xb_ld(&bar[XB_XGEN(b.x)]) == gen, bar);
            __builtin_amdgcn_fence(__ATOMIC_ACQUIRE, "agent");
            asm volatile("s_waitcnt vmcnt(0)" ::: "memory");
        }
    }
    __syncthreads();
}

constexpr int BM = 256, BK = 64, HALF = 128, HTB = HALF * BK * 2, STAGE_BYTES = 8 * HTB, NXCD = 8, WGM = 8;
__host__ __device__ __forceinline__ int lds_byte(int r, int c) { const int st = (r >> 4) * 2 + (c >> 5), rr = r & 15, cc = c & 31, ob = rr * 64 + cc * 2; return st * 1024 + (ob ^ (((ob >> 9) & 1) << 5)); }
__host__ __device__ __forceinline__ void stage_rc(int b, int& R, int& C) { const int st = b / 1024, sb = b % 1024, swz = sb ^ (((sb >> 9) & 1) << 5); R = (st >> 1) * 16 + swz / 64; C = (st & 1) * 32 + (swz % 64) / 2; }
__host__ __device__ __forceinline__ int perm32(int rho) { const int n = rho >> 4, i = rho & 15; return 8 * (i >> 2) + 4 * n + (i & 3); }
struct Unit { int pm, pn, e, aux; };
__device__ __forceinline__ unsigned cvt_pk_bf16(float lo, float hi) { unsigned r; asm volatile("v_cvt_pk_bf16_f32 %0, %1, %2" : "=v"(r) : "v"(lo), "v"(hi)); return r; }

struct DenseOrder {
    static constexpr bool GATHER = false;
    const bf16_t* A; const bf16_t* Bt; int K;
    int nM, nN, nwg, G, c;
    __device__ void init(const bf16_t* A_, const bf16_t* Bt_, int M, int N, int K_, int G_, int c_) { A = A_; Bt = Bt_; K = K_; nM = M / BM; nN = N / BM; nwg = nM * nN; G = G_; c = c_; }
    __device__ bool next(int i, Unit& u) const {
        const long Lx = (long)i * G + c; if (Lx >= nwg) return false;
        int wgid = (int)Lx; { const int q = nwg / NXCD, r = nwg % NXCD, xcd = wgid % NXCD, off = wgid / NXCD; wgid = (xcd < r ? xcd * (q + 1) : r * (q + 1) + (xcd - r) * q) + off; }
        const int nig = WGM * nN, gid = wgid / nig, fm = gid * WGM, gsz = (nM - fm) < WGM ? (nM - fm) : WGM;
        u.pm = fm + ((wgid % nig) % gsz); u.pn = (wgid % nig) / gsz; u.e = 0; u.aux = 0; return true;
    }
    __device__ __forceinline__ const char* a_base(const Unit& u) const { return (const char*)A + (size_t)u.pm * 256 * K * 2; }
    __device__ __forceinline__ const char* b_base(const Unit& u) const { return (const char*)Bt + (size_t)u.pn * 256 * K * 2; }
    __device__ __forceinline__ void a_offs(const Unit&, const int (&)[2], const int (&)[2], unsigned (&)[2][2]) const {}
};

template <class Epi, class Sched>
__device__ __forceinline__ void gemm_phase(LAS unsigned char* lds, const Sched& S, const Epi& E) {
    const int tid = threadIdx.x, wid = __builtin_amdgcn_readfirstlane(tid >> 6), lane = tid & 63, wr = wid >> 2, wc = wid & 3, fr = lane & 15, fq = lane >> 4;
    const int K = S.K, nt = K / BK;
    unsigned voffA[2], voffB[2]; int RR[2], CC[2];
#pragma unroll
    for (int i = 0; i < 2; ++i) { int R, C; stage_rc(tid * 16 + i * 8192, R, C); const int Rb = Epi::PERM ? ((R & ~31) + perm32(R & 31)) : R; RR[i] = R; CC[i] = C;
        voffA[i] = (unsigned)(R * K + C) * 2u; voffB[i] = (unsigned)(Rb * K + C) * 2u; }
    const size_t kstep = (size_t)(BK * 2);
    const size_t hstep = (size_t)HALF * K * 2;
    const unsigned ldsw = (unsigned)wid * 1024u;
    const int aoff = lds_byte(wr * 64 + fr, fq * 8), boff = lds_byte(wc * 32 + fr, fq * 8);
#define PG8_SA(b, h) (((b) * 2 + (h)) * HTB)
#define PG8_SB(b, h) ((4 + (b) * 2 + (h)) * HTB)
#define PG8_STAGE(bufoff, gbase, voff) do { _Pragma("unroll") for (int _i = 0; _i < 2; ++_i) \
        __builtin_amdgcn_global_load_lds((const unsigned*)((const char*)(gbase) + (voff)[_i]), (LAS unsigned*)(lds + (bufoff) + ldsw + _i * 8192), 16, 0, 0); } while (0)
#define PG8_STAGE_A(bufoff, ap, h, go) do { if constexpr (Sched::GATHER) { PG8_STAGE(bufoff, ap, (go)[h]); } else { PG8_STAGE(bufoff, (ap) + (h) * hstep, voffA); } } while (0)
#define PG8_LDA(dst, b, h) do { _Pragma("unroll") for (int m = 0; m < 4; ++m) _Pragma("unroll") for (int k = 0; k < 2; ++k) dst[m][k] = *(const LAS bf16x8*)(lds + PG8_SA(b, h) + aoff + m * 2048 + k * 1024); } while (0)
#define PG8_LDB(dst, b, h) do { _Pragma("unroll") for (int n = 0; n < 2; ++n) _Pragma("unroll") for (int k = 0; k < 2; ++k) dst[n][k] = *(const LAS bf16x8*)(lds + PG8_SB(b, h) + boff + n * 2048 + k * 1024); } while (0)
#define PG8_MMA(ai, bj, At, Bt) do { __builtin_amdgcn_s_setprio(1); _Pragma("unroll") for (int m = 0; m < 4; ++m) _Pragma("unroll") for (int n = 0; n < 2; ++n) _Pragma("unroll") for (int k = 0; k < 2; ++k) \
        acc[ai][bj][m][n] = __builtin_amdgcn_mfma_f32_16x16x32_bf16(Bt[n][k], At[m][k], acc[ai][bj][m][n], 0, 0, 0); __builtin_amdgcn_s_setprio(0); } while (0)
#define PG8_WAIT_V(n) asm volatile("s_waitcnt vmcnt(" #n ")" ::: "memory")
#define PG8_WAIT_L(n) asm volatile("s_waitcnt lgkmcnt(" #n ")" ::: "memory")
#define PG8_BAR __builtin_amdgcn_s_barrier()
#define PG8_SCHED __builtin_amdgcn_sched_barrier(0)
    Unit cur, nxt; int ui = 0;
    if (!S.next(0, cur)) return;
    f32x4 acc[2][2][4][2];
#pragma unroll
    for (int a = 0; a < 2; ++a)
#pragma unroll
        for (int b = 0; b < 2; ++b)
#pragma unroll
            for (int m = 0; m < 4; ++m)
#pragma unroll
                for (int n = 0; n < 2; ++n) acc[a][b][m][n] = (f32x4){0.f, 0.f, 0.f, 0.f};
    bf16x8 At[4][2], B0[2][2], B1[2][2];
    const char* cA = S.a_base(cur); const char* cB = S.b_base(cur);
    unsigned ca[2][2] = {{0u, 0u}, {0u, 0u}}, na[2][2] = {{0u, 0u}, {0u, 0u}};
    if constexpr (Sched::GATHER) S.a_offs(cur, RR, CC, ca);
    PG8_STAGE(PG8_SB(0, 0), cB, voffB); PG8_STAGE(PG8_SB(0, 1), cB + hstep, voffB); PG8_STAGE_A(PG8_SA(0, 0), cA, 0, ca); PG8_STAGE_A(PG8_SA(0, 1), cA, 1, ca);
    if (wr == 1) PG8_BAR;
    PG8_WAIT_V(2); PG8_BAR;
    PG8_STAGE(PG8_SB(1, 0), cB + kstep, voffB); PG8_STAGE_A(PG8_SA(1, 0), cA + kstep, 0, ca); PG8_STAGE(PG8_SB(1, 1), cB + hstep + kstep, voffB);
    PG8_WAIT_V(6); PG8_BAR;
    for (;;) {
        const bool has_next = S.next(ui + 1, nxt);
        const char* nA = has_next ? S.a_base(nxt) : cA; const char* nB = has_next ? S.b_base(nxt) : cB;
        if constexpr (Sched::GATHER) { if (has_next) S.a_offs(nxt, RR, CC, na); else {
#pragma unroll
            for (int h = 0; h < 2; ++h)
#pragma unroll
                for (int i = 0; i < 2; ++i) na[h][i] = ca[h][i]; } }
        for (int t = 0; t < nt; t += 2) {
            const bool last = (t == nt - 2);
            const char* a1 = cA + (size_t)(t + 1) * kstep;
            const char* a2 = last ? nA : cA + (size_t)(t + 2) * kstep; const char* b2 = last ? nB : cB + (size_t)(t + 2) * kstep;
            const char* a3 = a2 + kstep; const char* b3 = b2 + kstep;
            unsigned o2[2][2];
#pragma unroll
            for (int h = 0; h < 2; ++h)
#pragma unroll
                for (int i = 0; i < 2; ++i) o2[h][i] = last ? na[h][i] : ca[h][i];
            PG8_LDB(B0, 0, 0); PG8_LDB(B1, 0, 1); PG8_SCHED; PG8_LDA(At, 0, 0); PG8_STAGE_A(PG8_SA(1, 1), a1, 1, ca);
            PG8_WAIT_V(8); PG8_WAIT_L(0); PG8_BAR; PG8_MMA(0, 0, At, B0); PG8_MMA(0, 1, At, B1); PG8_BAR; PG8_SCHED;
            PG8_LDA(At, 0, 1); PG8_STAGE(PG8_SB(0, 0), b2, voffB); PG8_STAGE(PG8_SB(0, 1), b2 + hstep, voffB); PG8_STAGE_A(PG8_SA(0, 0), a2, 0, o2);
            PG8_WAIT_V(8); PG8_WAIT_L(0); PG8_BAR; PG8_MMA(1, 0, At, B0); PG8_MMA(1, 1, At, B1); PG8_BAR; PG8_SCHED;
            PG8_LDB(B0, 1, 0); PG8_LDB(B1, 1, 1); PG8_SCHED; PG8_LDA(At, 1, 0); PG8_STAGE_A(PG8_SA(0, 1), a2, 1, o2);
            PG8_WAIT_V(8); PG8_WAIT_L(0); PG8_BAR; PG8_MMA(0, 0, At, B0); PG8_MMA(0, 1, At, B1); PG8_BAR; PG8_SCHED;
            PG8_LDA(At, 1, 1); PG8_STAGE(PG8_SB(1, 0), b3, voffB); PG8_STAGE(PG8_SB(1, 1), b3 + hstep, voffB); PG8_STAGE_A(PG8_SA(1, 0), a3, 0, o2);
            PG8_WAIT_V(8); PG8_WAIT_L(0); PG8_BAR; PG8_MMA(1, 0, At, B0); PG8_MMA(1, 1, At, B1); PG8_BAR; PG8_SCHED;
        }
        if (wr == 0) PG8_BAR;
        E(acc, cur, wr, wc, fr, fq);
        if (!has_next) break;
#pragma unroll
        for (int a = 0; a < 2; ++a)
#pragma unroll
            for (int b = 0; b < 2; ++b)
#pragma unroll
                for (int m = 0; m < 4; ++m)
#pragma unroll
                    for (int n = 0; n < 2; ++n) acc[a][b][m][n] = (f32x4){0.f, 0.f, 0.f, 0.f};
        cur = nxt; cA = nA; cB = nB; ++ui;
#pragma unroll
        for (int h = 0; h < 2; ++h)
#pragma unroll
            for (int i = 0; i < 2; ++i) ca[h][i] = na[h][i];
        if (wr == 1) PG8_BAR;
    }
    PG8_WAIT_V(0);
    PG8_BAR;
#undef PG8_SA
#undef PG8_SB
#undef PG8_STAGE
#undef PG8_STAGE_A
#undef PG8_LDA
#undef PG8_LDB
#undef PG8_MMA
#undef PG8_WAIT_V
#undef PG8_WAIT_L
#undef PG8_BAR
#undef PG8_SCHED
}
constexpr size_t MiB = 1u << 20;
constexpr size_t WS_CTL = 0, CTL_ZERO_BYTES = 256 * 1024;
constexpr size_t WS_SMALL = 1 * MiB;
constexpr size_t WS_DEC = 2 * MiB;
constexpr size_t WS_KM = 3 * MiB;
constexpr size_t WS_LIST = 520 * MiB;
constexpr size_t WS_WGT = 12 * MiB;
constexpr size_t WS_SELCNT = 13 * MiB;
constexpr size_t WS_SEL = 16 * MiB;
constexpr size_t WS_WIN = 40 * MiB, WS_WOUT = 48 * MiB, WS_WKVQ = 50 * MiB, WS_WO = 56 * MiB;
constexpr size_t WS_MWIN = 64 * MiB, WS_MWOUT = 192 * MiB;
constexpr size_t WS_XN = 256 * MiB;
constexpr size_t WS_Q = 320 * MiB, WS_LF = 384 * MiB, WS_V = 448 * MiB, WS_G = 512 * MiB;
constexpr size_t WS_STATE = 576 * MiB;
constexpr size_t WS_OG = 640 * MiB;
constexpr size_t WS_ACT = 320 * MiB;
constexpr size_t WS_YB = 392 * MiB;
constexpr size_t WS_DUMMY = 800 * MiB;
constexpr size_t WS_END = 1024 * MiB;
constexpr int CW_BAR = 1024;
constexpr int CW_CNT = 8192;
constexpr int LDS_BYTES = 163840;
constexpr int LDS_MISC = LDS_BYTES - 64;

struct Args {
    const float* in[20]; const float* xin; float* out; unsigned char* ws; int ph_lo, ph_hi, rep2, pad;
};

__device__ __forceinline__ void p0_item(const float* W, int K, int N, bf16_t* WT, int dst_row0, const float* kscale, LAS float* scr, int k0, int n0, int lane) {
    float wv[32];
#pragma unroll
    for (int i = 0; i < 32; ++i) { const int kk = 2 * i + (lane >> 5); wv[i] = W[(size_t)(k0 + kk) * N + n0 + (lane & 31)]; }
    if (kscale) {
#pragma unroll
        for (int i = 0; i < 32; ++i) wv[i] *= kscale[k0 + 2 * i + (lane >> 5)]; }
#pragma unroll
    for (int i = 0; i < 32; ++i) scr[(2 * i + (lane >> 5)) * 33 + (lane & 31)] = wv[i];
    LDS_WAIT(); asm volatile("" ::: "memory");
    const int c = lane & 7;
#pragma unroll
    for (int j = 0; j < 4; ++j) { const int n = (lane >> 3) + 8 * j; const LAS float* s = scr + (8 * c) * 33 + n;
        u32x4 o; o.x = pk2(s[0 * 33], s[1 * 33]); o.y = pk2(s[2 * 33], s[3 * 33]); o.z = pk2(s[4 * 33], s[5 * 33]); o.w = pk2(s[6 * 33], s[7 * 33]);
        *(GAS u32x4*)(WT + (size_t)(dst_row0 + n) * K + k0 + 8 * c) = o; }
    LDS_WAIT(); asm volatile("" ::: "memory");
}
__device__ __forceinline__ int t5_bucket(int n) {
    if (n < 16) return n;
    const float lr = logf((float)n / 16.0f) / 4.1588830833596715f;
    int large = 16 + (int)(lr * 16.0f);
    return large < 31 ? large : 31;
}
__device__ __forceinline__ void norm_row_bf16(const float* xrow, const float* w, bf16_t* orow, int lane) {
    const GAS f32x4* xr = (const GAS f32x4*)xrow + lane;
    f32x4 v[4]; float s = 0.f;
#pragma unroll
    for (int j = 0; j < 4; ++j) { v[j] = xr[64 * j]; s += (v[j].x * v[j].x + v[j].y * v[j].y) + (v[j].z * v[j].z + v[j].w * v[j].w); }
    const float r = rsqrtf(wave_sum(s) * (1.f / D) + EPS);
    GAS u32x2* o8 = (GAS u32x2*)orow + lane;
#pragma unroll
    for (int j = 0; j < 4; ++j) { f32x4 ww = (f32x4){1.f, 1.f, 1.f, 1.f}; if (w) ww = ((const GAS f32x4*)w)[lane + 64 * j];
        u32x2 o; o.x = pk2(v[j].x * r * ww.x, v[j].y * r * ww.y); o.y = pk2(v[j].z * r * ww.z, v[j].w * r * ww.w); o8[64 * j] = o; }
}
__device__ __forceinline__ void p0_prologue(const Args& a, LAS unsigned char* lds, int wave, int lane) {
    LAS float* scr = (LAS float*)(lds + wave * 16384);
    const int gw = blockIdx.x * 8 + wave, NGW = gridDim.x * 8;
    unsigned char* ws = a.ws;
    constexpr int J0 = 2048, J1 = J0 + 512, J2 = J1 + 1024, J3 = J2 + 512, J4 = J3 + 512, J5 = J4 + 64 * 512, J6 = J5 + 64 * 256;
    for (int it = gw; it < J6; it += NGW) {
        if (it < J0) { const int r = it, nblk = 4096 / 32, kb = r / nblk, nb = r % nblk; p0_item(a.in[3], 1024, 4096, (bf16_t*)(ws + WS_WIN), 32 * nb, nullptr, scr, 64 * kb, 32 * nb, lane); }
        else if (it < J1) { const int r = it - J0, kb = r / 32, nb = r % 32; p0_item(a.in[6], 1024, 1024, (bf16_t*)(ws + WS_WOUT), 32 * nb, nullptr, scr, 64 * kb, 32 * nb, lane); }
        else if (it < J2) { const int r = it - J1, kb = r / 64, nb = r % 64; p0_item(a.in[8], 1024, 2048, (bf16_t*)(ws + WS_WKVQ), 32 * nb, a.in[7], scr, 64 * kb, 32 * nb, lane); }
        else if (it < J3) { const int r = it - J2, kb = r / 32, nb = r % 32; p0_item(a.in[10], 1024, 1024, (bf16_t*)(ws + WS_WKVQ), 2048 + 32 * nb, a.in[1] + D, scr, 64 * kb, 32 * nb, lane); }
        else if (it < J4) { const int r = it - J3, kb = r / 32, nb = r % 32; p0_item(a.in[12], 1024, 1024, (bf16_t*)(ws + WS_WO), 32 * nb, nullptr, scr, 64 * kb, 32 * nb, lane); }
        else if (it < J5) { const int r = it - J4, mat = r / 512, q = r % 512, kb = q / 32, nb = q % 32; const int n0 = 32 * nb;
            const int dst = (n0 < 512) ? ((n0 >> 7) * 256 + (n0 & 127)) : ((((n0 - 512) >> 7) * 256) + 128 + ((n0 - 512) & 127));
            p0_item(a.in[18] + (size_t)mat * 1024 * 1024, 1024, 1024, (bf16_t*)(ws + WS_MWIN) + (size_t)mat * 1024 * 1024, dst, a.in[2] + (mat >> 5) * D, scr, 64 * kb, n0, lane); }
        else { const int r = it - J5, mat = r / 256, q = r % 256, kb = q / 32, nb = q % 32;
            p0_item(a.in[19] + (size_t)mat * 512 * 1024, 512, 1024, (bf16_t*)(ws + WS_MWOUT) + (size_t)mat * 1024 * 512, 32 * nb, nullptr, scr, 64 * kb, 32 * nb, lane); }
    }
    for (int m = gw; m < T; m += NGW) norm_row_bf16(a.in[0] + (size_t)m * D, a.in[1], (bf16_t*)(ws + WS_XN) + (size_t)m * D, lane);
    if (blockIdx.x == 0) {
        float* lb = (float*)(ws + WS_SMALL); float* bt = lb + 2048;
        for (int i = threadIdx.x; i < 1024; i += 512) { const float x0 = a.in[4][i], x1 = a.in[4][1024 + i], m = fmaxf(x0, x1), e0 = expf(x0 - m), e1 = expf(x1 - m); lb[i] = e0 / (e0 + e1); }
        for (int i = threadIdx.x; i < 8192; i += 512) { const int h = i >> 10, d = i & 1023; bt[i] = a.in[13][t5_bucket(d) * 8 + h]; }
    }
}

struct EpiHG {
    static constexpr bool PERM = true;
    bf16_t* Qo; const float* lb;
    __device__ __forceinline__ void operator()(const f32x4 (&acc)[2][2][4][2], const Unit& u, int wr, int wc, int fr, int fq) const {
        const int quarter = u.pn >> 2, colq = (u.pn & 3) * 256 + wc * 32 + 8 * fq;
        bf16_t* base = Qo + (size_t)quarter * (64 * MiB / 2);
        const int row0 = u.pm * BM + wr * 64 + fr;
        f32x4 l0[2], l1[2];
#pragma unroll
        for (int bj = 0; bj < 2; ++bj) { l0[bj] = *(const f32x4*)(lb + colq + bj * HALF); l1[bj] = *(const f32x4*)(lb + colq + bj * HALF + 4); }
#pragma unroll
        for (int ai = 0; ai < 2; ++ai)
#pragma unroll
            for (int m = 0; m < 4; ++m) { bf16_t* rowp = base + (size_t)(row0 + ai * HALF + m * 16) * 1024 + colq;
#pragma unroll
                for (int bj = 0; bj < 2; ++bj) { f32x4 v0 = acc[ai][bj][m][0], v1 = acc[ai][bj][m][1];
                    if (quarter == 0) { v0 = v0 * 0.08838834764831845f; v1 = v1 * 0.08838834764831845f; }
                    else if (quarter == 1) {
#pragma unroll
                        for (int j = 0; j < 4; ++j) { v0[j] = __logf(l0[bj][j] + (1.f - l0[bj][j]) * sigmoidf_(v0[j])); v1[j] = __logf(l1[bj][j] + (1.f - l1[bj][j]) * sigmoidf_(v1[j])); } }
                    else if (quarter == 3) {
#pragma unroll
                        for (int j = 0; j < 4; ++j) { v0[j] = v0[j] * sigmoidf_(v0[j]); v1[j] = v1[j] * sigmoidf_(v1[j]); } }
                    u32x4 w; w.x = cvt_pk_bf16(v0[0], v0[1]); w.y = cvt_pk_bf16(v0[2], v0[3]); w.z = cvt_pk_bf16(v1[0], v1[1]); w.w = cvt_pk_bf16(v1[2], v1[3]);
                    *(u32x4*)(rowp + bj * HALF) = w; } }
    }
};
struct EpiRes {
    static constexpr bool PERM = false;
    float* C; const float* R; int ldc;
    __device__ __forceinline__ void operator()(const f32x4 (&acc)[2][2][4][2], const Unit& u, int wr, int wc, int fr, int fq) const {
        const int row0 = u.pm * BM + wr * 64 + fr, col0 = u.pn * BM + wc * 32 + 4 * fq;
#pragma unroll
        for (int ai = 0; ai < 2; ++ai)
#pragma unroll
            for (int m = 0; m < 4; ++m) { const size_t off = (size_t)(row0 + ai * HALF + m * 16) * ldc + col0;
#pragma unroll
                for (int bj = 0; bj < 2; ++bj)
#pragma unroll
                    for (int n = 0; n < 2; ++n) { const f32x4 r = *(const f32x4*)(R + off + bj * HALF + n * 16); *(f32x4*)(C + off + bj * HALF + n * 16) = r + acc[ai][bj][m][n]; }
                asm volatile("" ::: "memory"); }
    }
};

__device__ __forceinline__ unsigned off_b(unsigned row, unsigned ch) { return 256u * row + 16u * (ch ^ (((row & 3) << 2) | ((row >> 2) & 3))); }
__device__ __forceinline__ unsigned row_rd16(unsigned lane, unsigned rb, unsigned s) { return off_b((lane & 15) + 16 * rb, 4 * s + (lane >> 4)); }
__device__ __forceinline__ unsigned tr_rd16(unsigned lane, unsigned c, unsigned ks, unsigned t) { const unsigned g = lane >> 4, q = (lane & 15) >> 2, p = lane & 3; return off_b(32 * ks + 8 * g + 4 * t + q, 2 * c + (p >> 1)) + 8 * (p & 1); }
__device__ __forceinline__ unsigned elem_off(unsigned row, unsigned col) { return off_b(row, col >> 3) + (col & 7) * 2; }
__device__ __forceinline__ bf16x8 tr_frag(unsigned a0, unsigned a1) {
    bf16x4 lo, hi;
    asm volatile("ds_read_b64_tr_b16 %0, %2\n\tds_read_b64_tr_b16 %1, %3\n\ts_waitcnt lgkmcnt(0)" : "=&v"(lo), "=&v"(hi) : "v"(a0), "v"(a1) : "memory");
    bf16x8 r; r[0] = lo[0]; r[1] = lo[1]; r[2] = lo[2]; r[3] = lo[3]; r[4] = hi[0]; r[5] = hi[1]; r[6] = hi[2]; r[7] = hi[3]; return r;
}
constexpr int GI_Q = 0, GI_K = 16384, GI_KH = 32768, GI_V = 49152, GI_A = 65536, GI_ST = 81920, GI_O = 114688, GI_GTOT = 148480, GI_EBT = 152576;
constexpr int O_PITCH = 132;

template <bool WITH_Q>
__device__ __forceinline__ void gla_prep(LAS unsigned char* lds, const unsigned (&lfw)[8], const unsigned (&qw)[8], const unsigned (&vw)[8], int g, int lane, float& totsum0, float& totsum1) {
    float b0[8], b1[8]; float s0 = 0.f, s1 = 0.f;
#pragma unroll
    for (int i = 0; i < 8; ++i) { s0 += bf_lo(lfw[i]); s1 += bf_hi(lfw[i]); b0[i] = s0; b1[i] = s1; }
    LAS float* gtot = (LAS float*)(lds + GI_GTOT);
    *(LAS f32x2*)(gtot + g * 128 + 2 * lane) = (f32x2){s0, s1};
    __syncthreads();
    float pre0 = 0.f, pre1 = 0.f, tot0 = 0.f, tot1 = 0.f;
#pragma unroll
    for (int gg = 0; gg < 8; ++gg) { const f32x2 v = *(LAS f32x2*)(gtot + gg * 128 + 2 * lane); tot0 += v.x; tot1 += v.y; if (gg < g) { pre0 += v.x; pre1 += v.y; } }
    totsum0 += tot0; totsum1 += tot1;
    if (g == 0) *(LAS f32x2*)((LAS float*)(lds + GI_EBT) + 2 * lane) = (f32x2){__expf(tot0), __expf(tot1)};
    const unsigned d = 2 * lane;
#pragma unroll
    for (int i = 0; i < 8; ++i) {
        const unsigned t = 8 * g + i, eo = elem_off(t, d);
        const float B0 = b0[i] + pre0, B1 = b1[i] + pre1;
        const float k0 = 1.f - __expf(bf_lo(lfw[i])), k1 = 1.f - __expf(bf_hi(lfw[i]));
        *(LAS unsigned*)(lds + GI_KH + eo) = pk2(k0 * __expf(tot0 - B0), k1 * __expf(tot1 - B1));
        *(LAS unsigned*)(lds + GI_V + eo) = vw[i];
        if (WITH_Q) {
            *(LAS unsigned*)(lds + GI_Q + eo) = pk2(bf_lo(qw[i]) * __expf(B0), bf_hi(qw[i]) * __expf(B1));
            *(LAS unsigned*)(lds + GI_K + eo) = pk2(k0 * __expf(fminf(-B0, 80.f)), k1 * __expf(fminf(-B1, 80.f)));
        }
    }
}
__device__ __forceinline__ void gla_state_update(LAS unsigned char* lds, unsigned lds0, f32x4 (&S)[8], const bf16x8 (&vf)[2], int w, int lane) {
    const int fr = lane & 15, fq = lane >> 4;
#pragma unroll
    for (int mb = 0; mb < 8; ++mb) {
        const f32x4 e4 = *(LAS f32x4*)((LAS float*)(lds + GI_EBT) + 16 * mb + 4 * fq);
        f32x4 s = S[mb] * e4;
#pragma unroll
        for (int ks = 0; ks < 2; ++ks) { const bf16x8 kh = tr_frag(lds0 + GI_KH + tr_rd16(lane, mb, ks, 0), lds0 + GI_KH + tr_rd16(lane, mb, ks, 1)); s = __builtin_amdgcn_mfma_f32_16x16x32_bf16(kh, vf[ks], s, 0, 0, 0); }
        S[mb] = s;
        u32x2 o; o.x = pk2(s[0], s[1]); o.y = pk2(s[2], s[3]);
        *(LAS u32x2*)(lds + GI_ST + elem_off(16 * w + fr, 16 * mb + 4 * fq)) = o;
    }
}
template <int PASS>
__device__ __forceinline__ void gla_phase(const Args& a, LAS unsigned char* lds, int wave, int lane) {
    unsigned char* ws = a.ws;
    const unsigned lds0 = (unsigned)(size_t)lds;
    const bf16_t* Qg = (const bf16_t*)(ws + WS_Q); const bf16_t* LFg = (const bf16_t*)(ws + WS_LF); const bf16_t* Vg = (const bf16_t*)(ws + WS_V); const bf16_t* Gg = (const bf16_t*)(ws + WS_G);
    float* STATE = (float*)(ws + WS_STATE); float* DEC = (float*)(ws + WS_DEC); bf16_t* OG = (bf16_t*)(ws + WS_OG);
    const float* onw = a.in[5];
    const int g = wave, w = wave, fr = lane & 15, fq = lane >> 4;
    for (int item = blockIdx.x; item < 1024; item += gridDim.x) {
        const int bh = item >> 5, sc = item & 31, b = bh >> 3, h = bh & 7;
        const size_t tok0 = (size_t)b * L + (size_t)sc * 256;
        const size_t colb = (size_t)h * 128 + 2 * lane;
        f32x4 S[8];
        if (PASS == 1) {
            const float* sp = STATE + (size_t)item * 16384 + (size_t)(16 * w + fr) * 128 + 4 * fq;
#pragma unroll
            for (int mb = 0; mb < 8; ++mb) { S[mb] = *(const f32x4*)(sp + 16 * mb);
                u32x2 o; o.x = pk2(S[mb][0], S[mb][1]); o.y = pk2(S[mb][2], S[mb][3]);
                *(LAS u32x2*)(lds + GI_ST + elem_off(16 * w + fr, 16 * mb + 4 * fq)) = o; }
        } else {
#pragma unroll
            for (int mb = 0; mb < 8; ++mb) S[mb] = (f32x4){0.f, 0.f, 0.f, 0.f};
        }
        float ts0 = 0.f, ts1 = 0.f;
        for (int c = 0; c < 4; ++c) {
            unsigned lfw[8], qw[8], vw[8];
#pragma unroll
            for (int i = 0; i < 8; ++i) { const size_t o = (tok0 + c * 64 + 8 * g + i) * 1024 + colb;
                lfw[i] = *(const unsigned*)(LFg + o); vw[i] = *(const unsigned*)(Vg + o); qw[i] = (PASS == 1) ? *(const unsigned*)(Qg + o) : 0u; }
            gla_prep<PASS == 1>(lds, lfw, qw, vw, g, lane, ts0, ts1);
            __syncthreads();
            bf16x8 vf[2];
#pragma unroll
            for (int ks = 0; ks < 2; ++ks) vf[ks] = tr_frag(lds0 + GI_V + tr_rd16(lane, w, ks, 0), lds0 + GI_V + tr_rd16(lane, w, ks, 1));
            if (PASS == 1) {
                const int tb = w >> 1;
#pragma unroll
                for (int x = 0; x < 2; ++x) { const int sb = 2 * (w & 1) + x;
                    f32x4 acc = (f32x4){0.f, 0.f, 0.f, 0.f};
#pragma unroll
                    for (int ks = 0; ks < 4; ++ks) { const bf16x8 ka = *(const LAS bf16x8*)(lds + GI_K + row_rd16(lane, sb, ks)); const bf16x8 qb = *(const LAS bf16x8*)(lds + GI_Q + row_rd16(lane, tb, ks));
                        acc = __builtin_amdgcn_mfma_f32_16x16x32_bf16(ka, qb, acc, 0, 0, 0); }
                    const int t = tb * 16 + fr, s0 = sb * 16 + 4 * fq;
#pragma unroll
                    for (int r = 0; r < 4; ++r) if (s0 + r > t) acc[r] = 0.f;
                    u32x2 o; o.x = pk2(acc[0], acc[1]); o.y = pk2(acc[2], acc[3]);
                    *(LAS u32x2*)(lds + GI_A + elem_off(t, s0)) = o; }
                bf16x8 stf[4];
#pragma unroll
                for (int ks = 0; ks < 4; ++ks) stf[ks] = *(const LAS bf16x8*)(lds + GI_ST + row_rd16(lane, w, ks));
                __syncthreads();
#pragma unroll
                for (int tb2 = 0; tb2 < 4; ++tb2) {
                    f32x4 acc = (f32x4){0.f, 0.f, 0.f, 0.f};
#pragma unroll
                    for (int ks = 0; ks < 2; ++ks) { const bf16x8 ab = *(const LAS bf16x8*)(lds + GI_A + row_rd16(lane, tb2, ks)); acc = __builtin_amdgcn_mfma_f32_16x16x32_bf16(vf[ks], ab, acc, 0, 0, 0); }
#pragma unroll
                    for (int ks = 0; ks < 4; ++ks) { const bf16x8 qb = *(const LAS bf16x8*)(lds + GI_Q + row_rd16(lane, tb2, ks)); acc = __builtin_amdgcn_mfma_f32_16x16x32_bf16(stf[ks], qb, acc, 0, 0, 0); }
                    *(LAS f32x4*)((LAS float*)(lds + GI_O) + (16 * tb2 + fr) * O_PITCH + 16 * w + 4 * fq) = acc;
                }
            }
            if (PASS == 0 || c < 3) gla_state_update(lds, lds0, S, vf, w, lane);
            __syncthreads();
            if (PASS == 1) {
#pragma unroll
                for (int i = 0; i < 8; ++i) { const int t = 8 * g + i;
                    const f32x2 o = *(LAS f32x2*)((LAS float*)(lds + GI_O) + t * O_PITCH + 2 * lane);
                    const float r = rsqrtf(wave_sum(o.x * o.x + o.y * o.y) * (1.f / 128.f) + EPS);
                    const size_t go = (tok0 + c * 64 + t) * 1024 + colb;
                    const unsigned gw = *(const unsigned*)(Gg + go);
                    const f32x2 nw = *(const f32x2*)(onw + 2 * lane);
                    *(unsigned*)(OG + go) = pk2(o.x * r * nw.x * bf_lo(gw), o.y * r * nw.y * bf_hi(gw)); }
            }
        }
        if (PASS == 0) {
            float* sp = STATE + (size_t)item * 16384 + (size_t)(16 * w + fr) * 128 + 4 * fq;
#pragma unroll
            for (int mb = 0; mb < 8; ++mb) *(f32x4*)(sp + 16 * mb) = S[mb];
            if (g == 0) *(f32x2*)(DEC + (size_t)item * 128 + 2 * lane) = (f32x2){__expf(ts0), __expf(ts1)};
        }
        __syncthreads();
    }
}
__device__ __forceinline__ void gla_scan(const Args& a) {
    float* STATE = (float*)(a.ws + WS_STATE); const float* DEC = (const float*)(a.ws + WS_DEC);
    for (int e = blockIdx.x * 512 + threadIdx.x; e < 32 * 4096; e += gridDim.x * 512) {
        const int bh = e >> 12, q = e & 4095, dk0 = (q & 31) * 4;
        f32x4 carry = (f32x4){0.f, 0.f, 0.f, 0.f};
        float* p = STATE + (size_t)bh * 32 * 16384 + (size_t)q * 4;
        const float* dp = DEC + (size_t)bh * 32 * 128 + dk0;
#pragma unroll 4
        for (int sc = 0; sc < 32; ++sc) { const f32x4 loc = *(const f32x4*)(p + (size_t)sc * 16384); const f32x4 dec = *(const f32x4*)(dp + sc * 128);
            *(f32x4*)(p + (size_t)sc * 16384) = carry; carry = dec * carry + loc; }
    }
}
constexpr int MOE_CAPROWS = T * 2 + NEXP * 256;
constexpr int LDS_MOE_TAB = 131072;

constexpr int RL_BH = 0, RL_BL = 36864, RL_LG = 73728, RL_RS = RL_LG + 8 * 2304, RL_REC = RL_RS + 8 * 64, RL_CNT = RL_REC + 5 * 2048;
__device__ __forceinline__ unsigned rt_off(int c, int k) { return (unsigned)c * 1024u + ((((unsigned)k >> 3) ^ ((unsigned)c & 15u)) << 4) + ((unsigned)k & 7u) * 2u; }
__device__ __forceinline__ void moe_route_phase(const Args& a, LAS unsigned char* lds, int layer, int cslot, const float* xin, int wave, int lane) {
    unsigned char* ws = a.ws;
    const float* wg = a.in[14] + (size_t)layer * D * 4; const float* bg = a.in[15] + layer * 4;
    const float* we = a.in[16] + (size_t)layer * D * 32; const float* be = a.in[17] + layer * 32;
    const float* nw = a.in[2] + (size_t)layer * D;
    unsigned* cnt = (unsigned*)(ws + WS_CTL) + CW_CNT + 64 * cslot;
    u32x4* list = (u32x4*)(ws + WS_LIST); bf16_t* H2 = (bf16_t*)(ws + WS_XN);
    const int tid = threadIdx.x, fr = lane & 15, fq = lane >> 4;
    const int NGW = gridDim.x * 8, ngroups = T / 16, rounds = (ngroups + NGW - 1) / NGW;
    LAS float* lgw = (LAS float*)(lds + RL_LG + wave * 2304);
    LAS float* rsw = (LAS float*)(lds + RL_RS + wave * 64);
    LAS int* re0 = (LAS int*)(lds + RL_REC); LAS int* re1 = re0 + 512; LAS float* rw0 = (LAS float*)(re1 + 512); LAS float* rw1 = rw0 + 512; LAS float* rrs = rw1 + 512;
    LAS int* lcnt = (LAS int*)(lds + RL_CNT); LAS int* lbase = lcnt + 32;
    for (int rd = 0; rd < rounds; ++rd) {
        const int grp = (int)blockIdx.x * 8 + wave + rd * NGW;
        const bool live = grp < ngroups;
        const int t = (live ? grp : 0) * 16 + fr;
        f32x4 acc[3];
#pragma unroll
        for (int n = 0; n < 3; ++n) acc[n] = (f32x4){0.f, 0.f, 0.f, 0.f};
        float ss = 0.f;
#pragma unroll 1
        for (int half = 0; half < 2; ++half) {
            __syncthreads();
            for (int i = tid; i < 36 * 512; i += 512) {
                int c, kk; float w;
                if (i < 4 * 512) { kk = i >> 2; c = i & 3; w = wg[(size_t)(half * 512 + kk) * 4 + c]; }
                else { const int q = i - 4 * 512; kk = q >> 5; c = 4 + (q & 31); w = we[(size_t)(half * 512 + kk) * 32 + (q & 31)]; }
                w *= nw[half * 512 + kk];
                const unsigned hi = f2bf(w); const float lo = w - __builtin_bit_cast(float, hi << 16);
                const unsigned o = rt_off(c, kk);
                *(LAS unsigned short*)(lds + RL_BH + o) = (unsigned short)hi; *(LAS unsigned short*)(lds + RL_BL + o) = (unsigned short)f2bf(lo);
            }
            __syncthreads();
            const float* xr = xin + (size_t)t * D + half * 512 + 8 * fq;
            bf16_t* hr = H2 + (size_t)t * D + half * 512 + 8 * fq;
#pragma unroll 4
            for (int ks = 0; ks < 16; ++ks) {
                const f32x4 xa = *(const GAS f32x4*)(xr + 32 * ks), xb = *(const GAS f32x4*)(xr + 32 * ks + 4);
                ss += (xa.x * xa.x + xa.y * xa.y) + (xa.z * xa.z + xa.w * xa.w) + (xb.x * xb.x + xb.y * xb.y) + (xb.z * xb.z + xb.w * xb.w);
                u32x4 hi; hi.x = pk2(xa.x, xa.y); hi.y = pk2(xa.z, xa.w); hi.z = pk2(xb.x, xb.y); hi.w = pk2(xb.z, xb.w);
                u32x4 lo; lo.x = pk2(xa.x - bf_lo(hi.x), xa.y - bf_hi(hi.x)); lo.y = pk2(xa.z - bf_lo(hi.y), xa.w - bf_hi(hi.y));
                          lo.z = pk2(xb.x - bf_lo(hi.z), xb.y - bf_hi(hi.z)); lo.w = pk2(xb.z - bf_lo(hi.w), xb.w - bf_hi(hi.w));
                if (live) *(GAS u32x4*)(hr + 32 * ks) = hi;
                const bf16x8 ahi = __builtin_bit_cast(bf16x8, hi), alo = __builtin_bit_cast(bf16x8, lo);
#pragma unroll
                for (int n = 0; n < 3; ++n) { const int c = (n == 2 ? 20 : 16 * n) + fr; const unsigned o = (unsigned)c * 1024u + ((((unsigned)(4 * ks + fq)) ^ ((unsigned)c & 15u)) << 4);
                    const bf16x8 bh = *(const LAS bf16x8*)(lds + RL_BH + o), bl = *(const LAS bf16x8*)(lds + RL_BL + o);
                    acc[n] = __builtin_amdgcn_mfma_f32_16x16x32_bf16(ahi, bh, acc[n], 0, 0, 0);
                    acc[n] = __builtin_amdgcn_mfma_f32_16x16x32_bf16(ahi, bl, acc[n], 0, 0, 0);
                    acc[n] = __builtin_amdgcn_mfma_f32_16x16x32_bf16(alo, bh, acc[n], 0, 0, 0); }
            }
        }
        ss += __shfl_xor(ss, 16); ss += __shfl_xor(ss, 32);
        const float rstd = rsqrtf(ss * (1.f / D) + EPS);
        if (fq == 0) rsw[fr] = rstd;
#pragma unroll
        for (int r = 0; r < 4; ++r) { const float rs = rsw[4 * fq + r];
            lgw[(4 * fq + r) * 36 + fr] = acc[0][r] * rs + (fr < 4 ? bg[fr] : be[fr - 4]);
            lgw[(4 * fq + r) * 36 + 16 + fr] = acc[1][r] * rs + be[12 + fr];
            if (fr >= 12) lgw[(4 * fq + r) * 36 + 20 + fr] = acc[2][r] * rs + be[16 + fr]; }
        if (lane < 16) {
            float lg[36];
#pragma unroll
            for (int c = 0; c < 36; ++c) lg[c] = lgw[lane * 36 + c];
            int gi = 0; float gm = lg[0];
#pragma unroll
            for (int i = 1; i < 4; ++i) if (lg[i] > gm) { gm = lg[i]; gi = i; }
            float gs = 0.f;
#pragma unroll
            for (int i = 0; i < 4; ++i) gs += expf(lg[i] - gm);
            const float gw_ = 1.0f / gs;
            float el[8];
#pragma unroll
            for (int i = 0; i < 8; ++i) el[i] = gi == 0 ? lg[4 + i] : gi == 1 ? lg[12 + i] : gi == 2 ? lg[20 + i] : lg[28 + i];
            int i0 = 0; float m0 = el[0];
#pragma unroll
            for (int i = 1; i < 8; ++i) if (el[i] > m0) { m0 = el[i]; i0 = i; }
            int i1 = -1; float m1 = -INFINITY;
#pragma unroll
            for (int i = 0; i < 8; ++i) if (i != i0 && el[i] > m1) { m1 = el[i]; i1 = i; }
            const float p1 = expf(m1 - m0);
            const int li = wave * 16 + lane;
            re0[li] = live ? gi * 8 + i0 : -1; re1[li] = gi * 8 + i1; rw0[li] = gw_ / (1.f + p1); rw1[li] = gw_ * p1 / (1.f + p1); rrs[li] = rsw[lane];
        }
        if (tid < 32) lcnt[tid] = 0;
        __syncthreads();
        int myrank0 = 0, myrank1 = 0, e0 = -1, e1 = 0; float w0 = 0.f, w1 = 0.f, rs = 0.f;
        if (tid < 128) { e0 = re0[tid]; e1 = re1[tid]; w0 = rw0[tid]; w1 = rw1[tid]; rs = rrs[tid]; }
        if (e0 >= 0) { myrank0 = __hip_atomic_fetch_add(&lcnt[e0], 1, __ATOMIC_RELAXED, __HIP_MEMORY_SCOPE_WORKGROUP); myrank1 = __hip_atomic_fetch_add(&lcnt[e1], 1, __ATOMIC_RELAXED, __HIP_MEMORY_SCOPE_WORKGROUP); }
        __syncthreads();
        if (tid < 32) { const int c = lcnt[tid]; lbase[tid] = c ? (int)__hip_atomic_fetch_add(cnt + tid, (unsigned)c, __ATOMIC_RELAXED, __HIP_MEMORY_SCOPE_AGENT) : 0; }
        __syncthreads();
        if (e0 >= 0) { const int tk = (((int)blockIdx.x * 8 + (tid >> 4) + rd * NGW) * 16) + (tid & 15);
            list[(size_t)e0 * (2 * T) + lbase[e0] + myrank0] = (u32x4){(unsigned)(tk * 2), as_u(rs), as_u(w0), 0u};
            list[(size_t)e1 * (2 * T) + lbase[e1] + myrank1] = (u32x4){(unsigned)(tk * 2 + 1), as_u(rs), as_u(w1), 0u}; }
    }
}
__device__ __forceinline__ void moe_tables(const Args& a, LAS unsigned char* lds, int layer) {
    LAS int* tst = (LAS int*)(lds + LDS_MOE_TAB); LAS int* cn = tst + 64;
    const unsigned* cnt = (const unsigned*)(a.ws + WS_CTL) + CW_CNT + 64 * layer;
    if (threadIdx.x == 0) { int acc = 0; for (int e = 0; e < NEXP; ++e) { const int c = (int)__hip_atomic_load(cnt + e, __ATOMIC_RELAXED, __HIP_MEMORY_SCOPE_AGENT); tst[e] = acc; cn[e] = c; acc += (c + 255) >> 8; } tst[NEXP] = acc; }
    __syncthreads();
}
struct MoeOrder {
    const LAS int* tst; const LAS int* cn; const u32x4* list;
    const bf16_t* A; const bf16_t* Bt; int K; size_t bstride;
    int G, c, ntot;
    __device__ bool next(int i, Unit& u) const {
        const int Lx = i * G + c; if (Lx >= ntot * 4) return false;
        u.pm = Lx >> 2; u.pn = Lx & 3; int e = 0;
#pragma unroll 1
        for (int k = 1; k < NEXP; ++k) if (tst[k] <= u.pm) e = k;
        u.e = e; u.aux = u.pm - tst[e]; return true;
    }
    __device__ __forceinline__ const char* b_base(const Unit& u) const { return (const char*)Bt + (size_t)u.e * bstride + (size_t)u.pn * 256 * K * 2; }
};
struct MoeOrder1 : MoeOrder {
    static constexpr bool GATHER = true;
    __device__ __forceinline__ const char* a_base(const Unit&) const { return (const char*)A; }
    __device__ __forceinline__ void a_offs(const Unit& u, const int (&RR)[2], const int (&CC)[2], unsigned (&o)[2][2]) const {
        const int cnte = cn[u.e]; const u32x4* le = list + (size_t)u.e * (2 * T);
#pragma unroll
        for (int h = 0; h < 2; ++h)
#pragma unroll
            for (int i = 0; i < 2; ++i) { const int rank = u.aux * 256 + h * 128 + RR[i]; const int tok = rank < cnte ? (int)(((const unsigned*)(le + rank))[0] >> 1) : 0; o[h][i] = (unsigned)(tok * K + CC[i]) * 2u; }
    }
};
struct MoeOrder2 : MoeOrder {
    static constexpr bool GATHER = false;
    __device__ __forceinline__ const char* a_base(const Unit& u) const { return (const char*)A + (size_t)u.pm * 256 * K * 2; }
    __device__ __forceinline__ void a_offs(const Unit&, const int (&)[2], const int (&)[2], unsigned (&)[2][2]) const {}
};
struct EpiAct {
    static constexpr bool PERM = true;
    bf16_t* ACT; const u32x4* list; const LAS int* cn;
    __device__ __forceinline__ void operator()(const f32x4 (&acc)[2][2][4][2], const Unit& u, int wr, int wc, int fr, int fq) const {
        const int row0 = u.pm * BM + wr * 64 + fr, col0 = u.pn * 128 + wc * 32 + 8 * fq;
        const int cnte = cn[u.e]; const u32x4* le = list + (size_t)u.e * (2 * T);
        float rs[2][4];
#pragma unroll
        for (int ai = 0; ai < 2; ++ai)
#pragma unroll
            for (int m = 0; m < 4; ++m) { const int rank = u.aux * 256 + ai * HALF + wr * 64 + m * 16 + fr; rs[ai][m] = rank < cnte ? as_f(((const unsigned*)(le + rank))[1]) : 0.f; }
#pragma unroll
        for (int ai = 0; ai < 2; ++ai)
#pragma unroll
            for (int m = 0; m < 4; ++m) { bf16_t* rowp = ACT + (size_t)(row0 + ai * HALF + m * 16) * FF + col0; const float r = rs[ai][m];
                f32x4 g0 = acc[ai][0][m][0] * r, g1 = acc[ai][0][m][1] * r; const f32x4 u0 = acc[ai][1][m][0] * r, u1 = acc[ai][1][m][1] * r;
#pragma unroll
                for (int j = 0; j < 4; ++j) { g0[j] = g0[j] * sigmoidf_(g0[j]) * u0[j]; g1[j] = g1[j] * sigmoidf_(g1[j]) * u1[j]; }
                u32x4 w; w.x = cvt_pk_bf16(g0[0], g0[1]); w.y = cvt_pk_bf16(g0[2], g0[3]); w.z = cvt_pk_bf16(g1[0], g1[1]); w.w = cvt_pk_bf16(g1[2], g1[3]);
                *(u32x4*)rowp = w; }
    }
};
struct EpiY {
    static constexpr bool PERM = true;
    bf16_t* YB; const u32x4* list; const LAS int* cn;
    __device__ __forceinline__ void operator()(const f32x4 (&acc)[2][2][4][2], const Unit& u, int wr, int wc, int fr, int fq) const {
        const int cnte = cn[u.e]; const u32x4* le = list + (size_t)u.e * (2 * T);
        const int col0 = u.pn * BM + wc * 32 + 8 * fq;
        u32x4 en[2][4];
#pragma unroll
        for (int ai = 0; ai < 2; ++ai)
#pragma unroll
            for (int m = 0; m < 4; ++m) { const int rank = u.aux * 256 + ai * HALF + wr * 64 + m * 16 + fr; en[ai][m] = le[rank < cnte ? rank : 0]; }
#pragma unroll
        for (int ai = 0; ai < 2; ++ai)
#pragma unroll
            for (int m = 0; m < 4; ++m) { const int rank = u.aux * 256 + ai * HALF + wr * 64 + m * 16 + fr;
                if (rank < cnte) { const unsigned wz = en[ai][m].z; const float w = as_f(wz);   bf16_t* rowp = YB + (size_t)en[ai][m].x * D + col0;
#pragma unroll
                    for (int bj = 0; bj < 2; ++bj) { const f32x4 v0 = acc[ai][bj][m][0] * w, v1 = acc[ai][bj][m][1] * w;
                        u32x4 o; o.x = cvt_pk_bf16(v0[0], v0[1]); o.y = cvt_pk_bf16(v0[2], v0[3]); o.z = cvt_pk_bf16(v1[0], v1[1]); o.w = cvt_pk_bf16(v1[2], v1[3]);
                        *(u32x4*)(rowp + bj * HALF) = o; } } }
    }
};
template <bool NORM>
__device__ __forceinline__ void moe_combine_phase(const Args& a, const float* xin, float* xout, int wave, int lane) {
    const bf16_t* YB = (const bf16_t*)(a.ws + WS_YB); bf16_t* XN = (bf16_t*)(a.ws + WS_XN);
    const int gw = blockIdx.x * 8 + wave, NGW = gridDim.x * 8;
    for (int t = gw; t < T; t += NGW) {
        const GAS f32x4* xr = (const GAS f32x4*)(xin + (size_t)t * D) + lane; GAS f32x4* xo = (GAS f32x4*)(xout + (size_t)t * D) + lane;
        const GAS u32x2* y0 = (const GAS u32x2*)(YB + (size_t)(2 * t) * D) + lane; const GAS u32x2* y1 = (const GAS u32x2*)(YB + (size_t)(2 * t + 1) * D) + lane;
        f32x4 v[4]; float s = 0.f;
#pragma unroll
        for (int j = 0; j < 4; ++j) { v[j] = xr[64 * j]; const u32x2 p = y0[64 * j], q = y1[64 * j];
            v[j].x += bf_lo(p.x) + bf_lo(q.x); v[j].y += bf_hi(p.x) + bf_hi(q.x); v[j].z += bf_lo(p.y) + bf_lo(q.y); v[j].w += bf_hi(p.y) + bf_hi(q.y); xo[64 * j] = v[j];
            s += (v[j].x * v[j].x + v[j].y * v[j].y) + (v[j].z * v[j].z + v[j].w * v[j].w); }
        if (NORM) { const float r = rsqrtf(wave_sum(s) * (1.f / D) + EPS); GAS u32x2* o8 = (GAS u32x2*)(XN + (size_t)t * D) + lane;
#pragma unroll
            for (int j = 0; j < 4; ++j) { u32x2 o; o.x = pk2(v[j].x * r, v[j].y * r); o.y = pk2(v[j].z * r, v[j].w * r); o8[64 * j] = o; } }
    }
}
constexpr size_t WS_K2 = 320 * MiB, WS_V2 = 384 * MiB, WS_Q2 = 448 * MiB;
constexpr size_t WS_OP = 512 * MiB;
constexpr size_t WS_LP = 704 * MiB;
constexpr size_t WS_ATT = 708 * MiB;
constexpr size_t WS_SELX = 1001 * MiB;
constexpr int CW_TOT = 16384;
constexpr float ATT_C1 = 0.08838834764831845f * 1.4426950408889634f;

__device__ __forceinline__ void att_norm_phase(const Args& a, int wave, int lane) {
    const int gw = blockIdx.x * 8 + wave, NGW = gridDim.x * 8;
    for (int m = gw; m < T; m += NGW) norm_row_bf16(a.xin + (size_t)m * D, nullptr, (bf16_t*)(a.ws + WS_XN) + (size_t)m * D, lane);
}
constexpr int LDS_KVQ_SS = 131072, LDS_KVQ_CS = 131072 + 8192;
struct EpiKVQ {
    static constexpr bool PERM = true;
    bf16_t* Ko; const float* kw; const float* qw; float* KM; LAS unsigned char* lds;
    __device__ __forceinline__ void operator()(const f32x4 (&acc)[2][2][4][2], const Unit& u, int wr, int wc, int fr, int fq) const {
        const int sec = u.pn >> 2, hp = (u.pn & 3) * 2, d0 = wc * 32 + 8 * fq;
        bf16_t* base = Ko + (size_t)sec * (64 * MiB / 2);
        float rs[2][4][2];
        f32x4 w0 = (f32x4){1.f, 1.f, 1.f, 1.f}, w1 = w0;
        if (sec != 1) {
            const float* nw = sec == 0 ? kw : qw;
            w0 = *(const f32x4*)(nw + d0); w1 = *(const f32x4*)(nw + d0 + 4);
            LAS float* SS = (LAS float*)(lds + LDS_KVQ_SS);
#pragma unroll
            for (int ai = 0; ai < 2; ++ai)
#pragma unroll
                for (int m = 0; m < 4; ++m)
#pragma unroll
                    for (int bj = 0; bj < 2; ++bj) { const f32x4 a = acc[ai][bj][m][0], b = acc[ai][bj][m][1];
                        float s = (a[0] * a[0] + a[1] * a[1]) + (a[2] * a[2] + a[3] * a[3]) + (b[0] * b[0] + b[1] * b[1]) + (b[2] * b[2] + b[3] * b[3]);
                        s += __shfl_xor(s, 16); s += __shfl_xor(s, 32);
                        if (fq == 0) SS[((ai * HALF + wr * 64 + m * 16 + fr) * 2 + bj) * 4 + wc] = s; }
            asm volatile("s_waitcnt lgkmcnt(0)" ::: "memory"); __builtin_amdgcn_s_barrier(); asm volatile("" ::: "memory");
#pragma unroll
            for (int ai = 0; ai < 2; ++ai)
#pragma unroll
                for (int m = 0; m < 4; ++m)
#pragma unroll
                    for (int bj = 0; bj < 2; ++bj) { const f32x4 p = *(const LAS f32x4*)(SS + ((ai * HALF + wr * 64 + m * 16 + fr) * 2 + bj) * 4);
                        rs[ai][m][bj] = rsqrtf(((p[0] + p[1]) + (p[2] + p[3])) * (1.f / HD) + EPS); }
        } else {
#pragma unroll
            for (int ai = 0; ai < 2; ++ai)
#pragma unroll
                for (int m = 0; m < 4; ++m) { rs[ai][m][0] = 1.f; rs[ai][m][1] = 1.f; }
        }
        f32x4 cs0[2], cs1[2];
#pragma unroll
        for (int bj = 0; bj < 2; ++bj) { cs0[bj] = (f32x4){0.f, 0.f, 0.f, 0.f}; cs1[bj] = cs0[bj]; }
#pragma unroll
        for (int ai = 0; ai < 2; ++ai)
#pragma unroll
            for (int m = 0; m < 4; ++m) { const int r = u.pm * BM + ai * HALF + wr * 64 + m * 16 + fr, b = r >> 13, pos = r & 8191;
#pragma unroll
                for (int bj = 0; bj < 2; ++bj) { const f32x4 v0 = acc[ai][bj][m][0] * rs[ai][m][bj] * w0, v1 = acc[ai][bj][m][1] * rs[ai][m][bj] * w1;
                    cs0[bj] += v0; cs1[bj] += v1;
                    u32x4 w; w.x = cvt_pk_bf16(v0[0], v0[1]); w.y = cvt_pk_bf16(v0[2], v0[3]); w.z = cvt_pk_bf16(v1[0], v1[1]); w.w = cvt_pk_bf16(v1[2], v1[3]);
                    *(u32x4*)(base + (((size_t)(b * NH + hp + bj) * L + pos) * HD + d0)) = w; } }
        if (sec == 0) {
            LAS float* CS = (LAS float*)(lds + LDS_KVQ_CS);
#pragma unroll
            for (int bj = 0; bj < 2; ++bj)
#pragma unroll
                for (int j = 0; j < 4; ++j) {
                    float a = cs0[bj][j], b2 = cs1[bj][j];
#pragma unroll
                    for (int o = 1; o < 16; o <<= 1) { a += __shfl_xor(a, o); b2 += __shfl_xor(b2, o); }
                    if (fr == 0) { CS[wr * 256 + bj * 128 + d0 + j] = a; CS[wr * 256 + bj * 128 + d0 + 4 + j] = b2; } }
            asm volatile("s_waitcnt lgkmcnt(0)" ::: "memory"); __builtin_amdgcn_s_barrier(); asm volatile("" ::: "memory");
            const int t = threadIdx.x;
            if (t < 256) { const int bb = (u.pm * BM) >> 13, nb = ((u.pm * BM) & 8191) >> 8;
                KM[(((size_t)(bb * NH + hp + (t >> 7))) * NBLK + nb) * HD + (t & 127)] = (CS[t] + CS[256 + t]) * (1.f / 256.f); }
        }
    }
};
__device__ __forceinline__ void att_post_phase(const Args& a, LAS unsigned char* lds, int rep, int wave, int lane) {
    bf16_t* Kb = (bf16_t*)(a.ws + WS_K2); bf16_t* Qb = (bf16_t*)(a.ws + WS_Q2); float* KM = (float*)(a.ws + (rep ? WS_DUMMY + 96 * MiB : WS_KM));
    const size_t wofs = rep ? (WS_DUMMY - WS_K2) / 2 : 0;
    const f32x2 kw = *(const f32x2*)(a.in[9] + 2 * lane), qw = *(const f32x2*)(a.in[11] + 2 * lane);
    LAS float* cs = (LAS float*)lds;
    for (int item = blockIdx.x; item < B * NH * NBLK; item += gridDim.x) {
        const size_t row0 = (size_t)(item >> 5) * L + (size_t)(item & 31) * 256 + 32 * wave;
        float c0 = 0.f, c1 = 0.f;
#pragma unroll 4
        for (int i = 0; i < 32; ++i) {
            unsigned* kp = (unsigned*)(Kb + (row0 + i) * HD) + lane; unsigned* qp = (unsigned*)(Qb + (row0 + i) * HD) + lane;
            const unsigned ku = *kp, qu = *qp;
            float k0 = bf_lo(ku), k1 = bf_hi(ku), q0 = bf_lo(qu), q1 = bf_hi(qu);
            const float rk = rsqrtf(wave_sum(k0 * k0 + k1 * k1) * (1.f / HD) + EPS), rq = rsqrtf(wave_sum(q0 * q0 + q1 * q1) * (1.f / HD) + EPS);
            k0 *= rk * kw.x; k1 *= rk * kw.y; q0 *= rq * qw.x; q1 *= rq * qw.y;
            c0 += k0; c1 += k1;
            kp[wofs / 2] = pk2(k0, k1); qp[(rep ? (WS_DUMMY + 64 * MiB - WS_Q2) / 4 : 0)] = pk2(q0, q1);
        }
        *(LAS f32x2*)(cs + wave * 128 + 2 * lane) = (f32x2){c0, c1};
        __syncthreads();
        if (threadIdx.x < 128) { float s = 0.f;
#pragma unroll
            for (int w8 = 0; w8 < 8; ++w8) s += cs[w8 * 128 + threadIdx.x];
            KM[(size_t)item * HD + threadIdx.x] = s * (1.f / 256.f); }
        __syncthreads();
    }
}
__device__ __forceinline__ void att_sel_phase(const Args& a, LAS unsigned char* lds, int rep, int wave, int lane) {
    const bf16_t* Qb = (const bf16_t*)(a.ws + WS_Q2); const float* KM = (const float*)(a.ws + WS_KM);
    unsigned short* LISTS = (unsigned short*)(a.ws + WS_SEL); int* CNTS = (int*)(a.ws + WS_SELCNT); unsigned* TOT = (unsigned*)(a.ws + WS_CTL) + CW_TOT + 1024 * rep; int* SELX = (int*)(a.ws + WS_SELX);
    LAS float* kms = (LAS float*)lds;
    LAS int* cnts = (LAS int*)(lds + 16384);
    const int tid = threadIdx.x;
    for (int item = blockIdx.x; item < B * NH * NBLK; item += gridDim.x) {
        const int bsel = (item >> 8) & 3, q0 = ((item & 31) + ((bsel & 2) ? 16 : 0)) & 31;
        const int bh = item >> 5, qb = (bsel & 1) ? 31 - q0 : q0, b = bh >> 3, h = bh & 7;
        for (int i = tid; i < qb * 128; i += 512) kms[i] = KM[(size_t)bh * NBLK * HD + i];
        if (tid < 32) cnts[tid] = 0;
        __syncthreads();
        if (tid < 256) {
            const size_t qrow = (size_t)bh * L + (size_t)qb * 256 + tid;
            u32x4 qv[16];
#pragma unroll
            for (int i = 0; i < 16; ++i) qv[i] = ((const GAS u32x4*)(Qb + qrow * HD))[i];
            float v0 = -INFINITY, v1 = -INFINITY, v2 = -INFINITY; int i0 = -1, i1 = -1, i2 = -1;
#pragma unroll 1
            for (int n = 0; n < qb; ++n) {
                const LAS f32x4* kp = (const LAS f32x4*)(kms + n * 128);
                float g = 0.f;
#pragma unroll
                for (int i = 0; i < 16; ++i) { const f32x4 ka = kp[2 * i], kb2 = kp[2 * i + 1];
                    g += bf_lo(qv[i].x) * ka.x + bf_hi(qv[i].x) * ka.y + bf_lo(qv[i].y) * ka.z + bf_hi(qv[i].y) * ka.w
                       + bf_lo(qv[i].z) * kb2.x + bf_hi(qv[i].z) * kb2.y + bf_lo(qv[i].w) * kb2.z + bf_hi(qv[i].w) * kb2.w; }
                if (g > v0) { v2 = v1; i2 = i1; v1 = v0; i1 = i0; v0 = g; i0 = n; }
                else if (g > v1) { v2 = v1; i2 = i1; v1 = g; i1 = n; }
                else if (g > v2) { v2 = g; i2 = n; }
            }
            const int sel[3] = {i0, i1, i2};
#pragma unroll
            for (int s = 0; s < 3; ++s) {
                const int j = sel[s];
                if (j >= 0) { const int p = __hip_atomic_fetch_add(&cnts[j], 1, __ATOMIC_RELAXED, __HIP_MEMORY_SCOPE_WORKGROUP); LISTS[((size_t)(bh * NBLK + j) * NBLK + qb) * 256 + p] = (unsigned short)(tid | (s << 8)); }
                SELX[((size_t)(b * L + qb * 256 + tid) * NH + h) * 3 + s] = j;
            }
        }
        __syncthreads();
        if (tid < qb) { const int c = cnts[tid]; CNTS[(size_t)(bh * NBLK + tid) * NBLK + qb] = c; if (c) __hip_atomic_fetch_add(TOT + bh * NBLK + tid, (unsigned)c, __ATOMIC_RELAXED, __HIP_MEMORY_SCOPE_AGENT); }
        __syncthreads();
    }
}

__device__ __forceinline__ unsigned off_a(unsigned row, unsigned ch) { return 2048u * (row >> 3) + 512u * (ch >> 2) + 64u * (row & 7) + 16u * ((ch & 3) ^ ((row >> 2) & 3)); }
__device__ __forceinline__ unsigned elem_off_a(unsigned row, unsigned col) { return off_a(row, col >> 3) + (col & 7) * 2; }
__device__ __forceinline__ unsigned rowa_base(unsigned lane) { return off_a(lane & 15, lane >> 4); }
__device__ __forceinline__ unsigned tra_base(unsigned lane, unsigned t, unsigned codd) { const unsigned g = lane >> 4, q = (lane & 15) >> 2, p = lane & 3; return off_a(8 * g + 4 * t + q, 2 * codd + (p >> 1)) + 8 * (p & 1); }
constexpr int AL_K = 0, AL_V = 32768, AL_P = 65536, AL_BT = 131072, AL_TAB = 135168;
struct QRow { int qpos; int valid; };
__device__ __forceinline__ void att_stage(LAS unsigned char* lds, const bf16_t* Kg, const bf16_t* Vg, int c, int buf, int wave) {
    const int tid = threadIdx.x;
#pragma unroll
    for (int i = 0; i < 2; ++i) { const int e = tid + 512 * i, row = 8 * (e >> 7) + ((e >> 2) & 7), ch = 4 * ((e >> 5) & 3) + ((e & 3) ^ ((row >> 2) & 3));
        const size_t o = (size_t)c * 64 * HD + (size_t)row * HD + ch * 8;
        __builtin_amdgcn_global_load_lds((const unsigned*)(Kg + o), (LAS unsigned*)(lds + AL_K + buf * 16384 + wave * 1024 + i * 8192), 16, 0, 0);
        __builtin_amdgcn_global_load_lds((const unsigned*)(Vg + o), (LAS unsigned*)(lds + AL_V + buf * 16384 + wave * 1024 + i * 8192), 16, 0, 0); }
}
__device__ __forceinline__ void tr_frag2(unsigned a0, unsigned a1, unsigned b0, unsigned b1, bf16x8& fa, bf16x8& fb) {
    bf16x4 l0, h0, l1, h1;
    asm volatile("ds_read_b64_tr_b16 %0, %4\n\tds_read_b64_tr_b16 %1, %5\n\tds_read_b64_tr_b16 %2, %6\n\tds_read_b64_tr_b16 %3, %7\n\ts_waitcnt lgkmcnt(0)"
                 : "=&v"(l0), "=&v"(h0), "=&v"(l1), "=&v"(h1) : "v"(a0), "v"(a1), "v"(b0), "v"(b1) : "memory");
    fa[0] = l0[0]; fa[1] = l0[1]; fa[2] = l0[2]; fa[3] = l0[3]; fa[4] = h0[0]; fa[5] = h0[1]; fa[6] = h0[2]; fa[7] = h0[3];
    fb[0] = l1[0]; fb[1] = l1[1]; fb[2] = l1[2]; fb[3] = l1[3]; fb[4] = h1[0]; fb[5] = h1[1]; fb[6] = h1[2]; fb[7] = h1[3];
}
template <bool OWN>
__device__ __forceinline__ void att_tile(LAS unsigned char* lds, const bf16_t* Kg, const bf16_t* Vg, const bf16_t* const (&qptr)[2], const QRow (&qr)[2], const int (&xblk)[2], int kbase,
                                         f32x4 (&O)[8][2], float (&lsum)[2], int wave, int lane) {
    const int fr = lane & 15, fq = lane >> 4;
    const unsigned lds0 = (unsigned)(size_t)lds;
    LAS unsigned char* Pw = lds + AL_P + wave * 8192;
    const LAS float* bt = (const LAS float*)(lds + AL_BT);
    const unsigned kbase_a = rowa_base(lane);
    const unsigned trb[2][2] = {{tra_base(lane, 0, 0), tra_base(lane, 0, 1)}, {tra_base(lane, 1, 0), tra_base(lane, 1, 1)}};
    const unsigned pwb[2] = {elem_off_a(fr, 4 * fq), elem_off_a(fr, 16 + 4 * fq)};
    bf16x8 qf[2][4];
#pragma unroll
    for (int x = 0; x < 2; ++x)
#pragma unroll
        for (int ks = 0; ks < 4; ++ks) qf[x][ks] = *(const GAS bf16x8*)(qptr[x] + 32 * ks + 8 * fq);
#pragma unroll
    for (int db = 0; db < 8; ++db)
#pragma unroll
        for (int x = 0; x < 2; ++x) O[db][x] = (f32x4){0.f, 0.f, 0.f, 0.f};
    lsum[0] = 0.f; lsum[1] = 0.f;
    __syncthreads();
    att_stage(lds, Kg, Vg, 0, 0, wave);
    asm volatile("s_waitcnt vmcnt(0)" ::: "memory");
    __syncthreads();
    for (int c = 0; c < 4; ++c) {
        const int buf = c & 1;
        if (c < 3) att_stage(lds, Kg, Vg, c + 1, buf ^ 1, wave);
        if (!OWN || 64 * c <= 16 * xblk[1] + 15) {
#pragma unroll
            for (int kb = 0; kb < 4; ++kb) {
                bf16x8 ka[4];
#pragma unroll
                for (int ks = 0; ks < 4; ++ks) ka[ks] = *(const LAS bf16x8*)(lds + AL_K + buf * 16384 + kbase_a + 4096 * kb + 512 * ks);
#pragma unroll
                for (int x = 0; x < 2; ++x) {
                    f32x4 s = (f32x4){0.f, 0.f, 0.f, 0.f};
#pragma unroll
                    for (int ks = 0; ks < 4; ++ks) s = __builtin_amdgcn_mfma_f32_16x16x32_bf16(ka[ks], qf[x][ks], s, 0, 0, 0);
                    const int key0 = kbase + 64 * c + 16 * kb + 4 * fq;
                    float p[4];
#pragma unroll
                    for (int r = 0; r < 4; ++r) { const int dist = qr[x].qpos - (key0 + r); const int idx = dist < 0 ? 0 : (dist > 1023 ? 1023 : dist);
                        const float e = __builtin_amdgcn_exp2f(s[r] * ATT_C1 + bt[idx]);
                        p[r] = (qr[x].valid && dist >= 0) ? e : 0.f; lsum[x] += p[r]; }
                    u32x2 o; o.x = cvt_pk_bf16(p[0], p[1]); o.y = cvt_pk_bf16(p[2], p[3]);
                    *(LAS u32x2*)(Pw + pwb[kb & 1] + 4096 * x + 512 * (kb >> 1)) = o;
                }
            }
#pragma unroll
            for (int db = 0; db < 8; ++db) {
                bf16x8 vf[2];
                const unsigned vb = lds0 + AL_V + buf * 16384 + 512 * (db >> 1);
                tr_frag2(vb + trb[0][db & 1], vb + trb[1][db & 1], vb + trb[0][db & 1] + 8192, vb + trb[1][db & 1] + 8192, vf[0], vf[1]);
#pragma unroll
                for (int x = 0; x < 2; ++x) {
#pragma unroll
                    for (int ks = 0; ks < 2; ++ks) { const bf16x8 pb = *(const LAS bf16x8*)(Pw + kbase_a + 4096 * x + 512 * ks); O[db][x] = __builtin_amdgcn_mfma_f32_16x16x32_bf16(vf[ks], pb, O[db][x], 0, 0, 0); }
                }
            }
        }
        asm volatile("s_waitcnt vmcnt(0)" ::: "memory");
        __syncthreads();
    }
#pragma unroll
    for (int x = 0; x < 2; ++x) { lsum[x] += __shfl_xor(lsum[x], 16); lsum[x] += __shfl_xor(lsum[x], 32); }
}
__device__ __forceinline__ void att_load_bias(const Args& a, LAS unsigned char* lds, int h) {
    LAS float* bt = (LAS float*)(lds + AL_BT); LAS float* red = (LAS float*)(lds + AL_TAB + 8192);
    const int tid = threadIdx.x;
    float m = 0.f;
    if (tid < 128) m = fabsf(a.in[11][tid]);
    else if (tid < 256) m = fabsf(a.in[9][tid - 128]);
    else m = fabsf(a.in[13][tid - 256]);
#pragma unroll
    for (int o = 1; o < 64; o <<= 1) m = fmaxf(m, __shfl_xor(m, o));
    if ((tid & 63) == 0) red[tid >> 6] = m;
    __syncthreads();
    const float mq = fmaxf(red[0], red[1]), mk = fmaxf(red[2], red[3]), mb = fmaxf(fmaxf(red[4], red[5]), fmaxf(red[6], red[7]));
    const float M = 128.f * 0.08838834764831845f * mq * mk * 1.02f + mb;
    const float* bias_tab = (const float*)(a.ws + WS_SMALL) + 2048 + h * 1024;
    for (int i = tid; i < 1024; i += 512) bt[i] = (bias_tab[i] - M) * 1.4426950408889634f;
    __syncthreads();
}
__device__ __forceinline__ void att_selatt_phase(const Args& a, LAS unsigned char* lds, int wave, int lane) {
    const bf16_t* Kb = (const bf16_t*)(a.ws + WS_K2); const bf16_t* Vb = (const bf16_t*)(a.ws + WS_V2); const bf16_t* Qb = (const bf16_t*)(a.ws + WS_Q2);
    const unsigned short* LISTS = (const unsigned short*)(a.ws + WS_SEL); const int* CNTS = (const int*)(a.ws + WS_SELCNT); const unsigned* TOT = (const unsigned*)(a.ws + WS_CTL) + CW_TOT;
    bf16_t* OP = (bf16_t*)(a.ws + WS_OP); float* LP = (float*)(a.ws + WS_LP);
    LAS int* pfx = (LAS int*)(lds + AL_TAB);
    LAS int* seg = (LAS int*)(lds + AL_TAB + 4352);
    const int tid = threadIdx.x, fr = lane & 15, fq = lane >> 4;
    if (wave == 0) {
        int loc[16]; int s = 0;
#pragma unroll
        for (int i = 0; i < 16; ++i) { const unsigned t = __hip_atomic_load(TOT + lane * 16 + i, __ATOMIC_RELAXED, __HIP_MEMORY_SCOPE_AGENT); loc[i] = s; s += (int)((t + 255u) >> 8); }
        int inc = s;
#pragma unroll
        for (int o = 1; o < 64; o <<= 1) { const int v = __shfl_up(inc, o); if (lane >= o) inc += v; }
        const int excl = inc - s;
#pragma unroll
        for (int i = 0; i < 16; ++i) pfx[lane * 16 + i] = excl + loc[i];
        if (lane == 63) pfx[1024] = inc;
    }
    __syncthreads();
    const int ntiles = pfx[1024];
    int cur_h = -1, cur_lid = -1;
    LAS unsigned char* Pw = lds + AL_P + wave * 8192;
    LAS float* lsw = (LAS float*)(lds + AL_TAB + 12288 + wave * 256); LAS unsigned* riw = (LAS unsigned*)(lsw + 32);
    const int g0 = (int)(((long)blockIdx.x * ntiles) / gridDim.x), g1 = (int)(((long)(blockIdx.x + 1) * ntiles) / gridDim.x);
    for (int g = g0; g < g1; ++g) {
        int lo = 0, hi = 1024;
        while (hi - lo > 1) { const int mid = (lo + hi) >> 1; if (pfx[mid] <= g) lo = mid; else hi = mid; }
        const int lid = lo, ti = g - pfx[lid], bh = lid >> 5, j = lid & 31, h = bh & 7;
        if (lid != cur_lid) {
            __syncthreads();
            if (h != cur_h) { att_load_bias(a, lds, h); cur_h = h; }
            if (wave == 0) {
                int cq = 0; if (lane < NBLK) { const int v = CNTS[(size_t)lid * NBLK + lane]; cq = lane > j ? v : 0; }
                int inc = cq;
#pragma unroll
                for (int o = 1; o < 32; o <<= 1) { const int v = __shfl_up(inc, o); if (lane >= o) inc += v; }
                if (lane < NBLK) seg[lane] = inc - cq;
                if (lane == NBLK - 1) seg[NBLK] = inc;
            }
            __syncthreads();
            cur_lid = lid;
        }
        const int total = seg[NBLK];
        const bf16_t* qptr[2]; QRow qr[2]; int slot[2]; int xblk[2] = {0, 0};
#pragma unroll
        for (int x = 0; x < 2; ++x) {
            const int R = ti * 256 + 32 * wave + 16 * x + fr;
            qr[x].valid = R < total; qr[x].qpos = 0; slot[x] = 0;
            if (qr[x].valid) { int qb = j + 1;
#pragma unroll 1
                for (int k = j + 2; k < NBLK; ++k) if (seg[k] <= R) qb = k;
                const unsigned e = LISTS[((size_t)lid * NBLK + qb) * 256 + (R - seg[qb])];
                qr[x].qpos = qb * 256 + (int)(e & 255u); slot[x] = (int)(e >> 8); }
            qptr[x] = Qb + ((size_t)bh * L + qr[x].qpos) * HD;
        }
        f32x4 O[8][2]; float lsum[2];
        att_tile<false>(lds, Kb + ((size_t)bh * L + j * 256) * HD, Vb + ((size_t)bh * L + j * 256) * HD, qptr, qr, xblk, j * 256, O, lsum, wave, lane);
#pragma unroll
        for (int x = 0; x < 2; ++x) {
#pragma unroll
            for (int db = 0; db < 8; ++db) { u32x2 o; o.x = pk2(O[db][x][0], O[db][x][1]); o.y = pk2(O[db][x][2], O[db][x][3]); *(LAS u32x2*)(Pw + elem_off(16 * x + fr, 16 * db + 4 * fq)) = o; }
            if (fq == 0) { lsw[16 * x + fr] = lsum[x]; riw[16 * x + fr] = qr[x].valid ? (0x80000000u | ((unsigned)slot[x] << 16) | (unsigned)qr[x].qpos) : 0u; }
        }
#pragma unroll
        for (int i = 0; i < 8; ++i) { const int row = 4 * i + fq, ch = fr;
            const unsigned ri = riw[row];
            if (ri & 0x80000000u) { const size_t ro = ((size_t)bh * L + (ri & 0xffffu)) * 3 + ((ri >> 16) & 3u);
                *(GAS u32x4*)(OP + ro * HD + ch * 8) = *(const LAS u32x4*)(Pw + off_b(row, ch));
                if (ch == 0) LP[ro] = lsw[row]; }
        }
    }
}
__device__ __forceinline__ void att_own_phase(const Args& a, LAS unsigned char* lds, int rep, int var, int wave, int lane) {
    const bf16_t* Kb = (const bf16_t*)(a.ws + WS_K2); const bf16_t* Vb = (const bf16_t*)(a.ws + WS_V2); const bf16_t* Qb = (const bf16_t*)(a.ws + WS_Q2);
    const bf16_t* OP = (const bf16_t*)(a.ws + WS_OP); const float* LP = (const float*)(a.ws + WS_LP); bf16_t* ATT = (bf16_t*)(a.ws + (rep ? WS_DUMMY : WS_ATT));
    const int fr = lane & 15, fq = lane >> 4;
    int cur_h = -1;
    for (int item = blockIdx.x; item < B * NH * NBLK; item += gridDim.x) {
        const int bh = item >> 5, qb = item & 31, b = bh >> 3, h = bh & 7;
        __syncthreads();
        if (h != cur_h) { att_load_bias(a, lds, h); cur_h = h; }
        const bf16_t* qptr[2]; QRow qr[2]; int xblk[2] = {wave, 15 - wave};
#pragma unroll
        for (int x = 0; x < 2; ++x) { qr[x].valid = 1; qr[x].qpos = qb * 256 + 16 * xblk[x] + fr; qptr[x] = Qb + ((size_t)bh * L + qr[x].qpos) * HD; }
        f32x4 O[8][2]; float lsum[2];
        att_tile<true>(lds, Kb + ((size_t)bh * L + qb * 256) * HD, Vb + ((size_t)bh * L + qb * 256) * HD, qptr, qr, xblk, qb * 256, O, lsum, wave, lane);
        const int nsel = qb < 3 ? qb : 3;
        LAS unsigned char* Pw = lds + AL_P + wave * 8192; LAS float* lsw = (LAS float*)(lds + AL_TAB + 12288 + wave * 256);
#pragma unroll
        for (int x = 0; x < 2; ++x) {
#pragma unroll
            for (int db = 0; db < 8; ++db) { u32x2 o; o.x = pk2(O[db][x][0], O[db][x][1]); o.y = pk2(O[db][x][2], O[db][x][3]); *(LAS u32x2*)(Pw + elem_off(16 * x + fr, 16 * db + 4 * fq)) = o; }
            if (fq == 0) lsw[16 * x + fr] = lsum[x];
        }
#pragma unroll 1
        for (int i = 0; i < 8; ++i) { const int row = 4 * i + fq, ch = fr, qpos = qb * 256 + 16 * (row < 16 ? wave : 15 - wave) + (row & 15);
            const size_t ro = ((size_t)bh * L + qpos) * 3;
            u32x4 pv[3]; float lp[3];
#pragma unroll
            for (int s = 0; s < 3; ++s) { pv[s] = (u32x4){0u, 0u, 0u, 0u}; lp[s] = 0.f; if (s < nsel) { pv[s] = *(const GAS u32x4*)(OP + (ro + s) * HD + ch * 8); lp[s] = LP[ro + s]; } }
            const u32x4 ov = *(const LAS u32x4*)(Pw + off_b(row, ch));
            const float inv = 1.0f / (lsw[row] + lp[0] + lp[1] + lp[2]);
            const unsigned o0 = ov.x, o1 = ov.y, o2 = ov.z, o3 = ov.w;
            float f[8] = {bf_lo(o0), bf_hi(o0), bf_lo(o1), bf_hi(o1), bf_lo(o2), bf_hi(o2), bf_lo(o3), bf_hi(o3)};
#pragma unroll
            for (int s = 0; s < 3; ++s) { const unsigned p0 = pv[s].x, p1 = pv[s].y, p2 = pv[s].z, p3 = pv[s].w;
                f[0] += bf_lo(p0); f[1] += bf_hi(p0); f[2] += bf_lo(p1); f[3] += bf_hi(p1); f[4] += bf_lo(p2); f[5] += bf_hi(p2); f[6] += bf_lo(p3); f[7] += bf_hi(p3); }
            u32x4 w; w.x = pk2(f[0] * inv, f[1] * inv); w.y = pk2(f[2] * inv, f[3] * inv); w.z = pk2(f[4] * inv, f[5] * inv); w.w = pk2(f[6] * inv, f[7] * inv);
            *(GAS u32x4*)(ATT + ((size_t)b * L + qpos) * D + h * HD + ch * 8) = w;
        }
    }
}
enum Phase { PH_PROLOGUE = 0, PH_INPROJ, PH_GLA_A, PH_GLA_SCAN, PH_GLA_C, PH_OUTPROJ, PH_END_S1,
             PH_M0_ROUTE = PH_END_S1, PH_M0_G1, PH_M0_G2, PH_M0_COMB, PH_END_S2,
             PH_A_NORM = PH_END_S2, PH_A_KVQ, PH_A_POST, PH_A_SEL, PH_A_SELATT, PH_A_OWN, PH_A_OPROJ, PH_END_S3,
             PH_M1_ROUTE = PH_END_S3, PH_M1_G1, PH_M1_G2, PH_M1_COMB, PH_END_S4,
             PH_COUNT = PH_END_S4 };
#ifndef DUP_MASK
#define DUP_MASK 0ull
#endif
#ifndef TVAR
#define TVAR 0
#endif
#define REPS(k) ((((DUP_MASK) >> (k)) & 1ull) ? a.rep2 : 1)
#define PHASE(k) if (IN(k)) for (int rep = 0; rep < REPS(k); ++rep)
#ifndef ROUTE_FN
#define ROUTE_FN moe_route_phase
#endif
#define REPBAR() do { if (rep) xcd_barrier(bar); } while (0)
#define MOE_PHASES(base, layer) \
    PHASE(base) { REPBAR(); ROUTE_FN(a, lds, layer, (layer) + 2 * rep, a.xin, wave, lane); } \
    SEAM(base); \
    PHASE((base) + 1) { REPBAR(); moe_tables(a, lds, layer); MoeOrder1 S; S.tst = (const LAS int*)(lds + LDS_MOE_TAB); S.cn = S.tst + 64; S.list = (const u32x4*)(ws + WS_LIST); \
        S.A = (const bf16_t*)(ws + WS_XN); S.Bt = (const bf16_t*)(ws + WS_MWIN) + (size_t)(layer) * NEXP * 1024 * 1024; S.K = D; S.bstride = (size_t)1024 * 1024 * 2; S.G = gridDim.x; S.c = blockIdx.x; S.ntot = S.tst[NEXP]; \
        EpiAct E{(bf16_t*)(ws + WS_ACT), (const u32x4*)(ws + WS_LIST), S.cn}; gemm_phase<EpiAct, MoeOrder1>(lds, S, E); } \
    SEAM((base) + 1); \
    PHASE((base) + 2) { REPBAR(); moe_tables(a, lds, layer); MoeOrder2 S; S.tst = (const LAS int*)(lds + LDS_MOE_TAB); S.cn = S.tst + 64; S.list = (const u32x4*)(ws + WS_LIST); \
        S.A = (const bf16_t*)(ws + WS_ACT); S.Bt = (const bf16_t*)(ws + WS_MWOUT) + (size_t)(layer) * NEXP * 1024 * 512; S.K = FF; S.bstride = (size_t)1024 * 512 * 2; S.G = gridDim.x; S.c = blockIdx.x; S.ntot = S.tst[NEXP]; \
        EpiY E{(bf16_t*)(ws + WS_YB), (const u32x4*)(ws + WS_LIST), S.cn}; gemm_phase<EpiY, MoeOrder2>(lds, S, E); } \
    SEAM((base) + 2); \
    PHASE((base) + 3) { REPBAR(); moe_combine_phase<(layer) == 0>(a, a.xin, rep ? (float*)(ws + WS_DUMMY) : a.out, wave, lane); }

__global__ void __launch_bounds__(512, 2) fwd(Args a) {
    extern __shared__ __attribute__((aligned(16))) unsigned char smem[];
    LAS unsigned char* lds = (LAS unsigned char*)smem;
    const int tid = threadIdx.x, lane = tid & 63, wave = __builtin_amdgcn_readfirstlane(tid >> 6);
    volatile LAS unsigned* MISC = (volatile LAS unsigned*)(lds + LDS_MISC);
    if (tid < 4) MISC[tid] = 0u;
    __syncthreads();
    unsigned* ctl = (unsigned*)(a.ws + WS_CTL);
    XcdBarrier bar = xcd_barrier_post(ctl + CW_BAR, MISC);
    const int lo = a.ph_lo, hi = a.ph_hi;
    unsigned char* ws = a.ws;
#ifndef ENABLE_MASK
#define ENABLE_MASK (~0ull)
#endif
#define IN(k) ((((ENABLE_MASK) >> (k)) & 1ull) && lo <= (k) && (k) < hi)
#define SEAM(k) do { if (IN(k) && IN((k) + 1)) xcd_barrier(bar); } while (0)
    PHASE(PH_PROLOGUE) { REPBAR(); p0_prologue(a, lds, wave, lane); }
    SEAM(PH_PROLOGUE);
    PHASE(PH_INPROJ) { REPBAR();
        DenseOrder S; S.init((const bf16_t*)(ws + WS_XN), (const bf16_t*)(ws + WS_WIN), T, 4096, D, gridDim.x, blockIdx.x);
        EpiHG E{(bf16_t*)(ws + WS_Q), (const float*)(ws + WS_SMALL)};
        gemm_phase<EpiHG, DenseOrder>(lds, S, E);
    }
    SEAM(PH_INPROJ);
    PHASE(PH_GLA_A) { REPBAR(); gla_phase<0>(a, lds, wave, lane); }
    SEAM(PH_GLA_A);
    if (IN(PH_GLA_SCAN)) gla_scan(a);
    SEAM(PH_GLA_SCAN);
    PHASE(PH_GLA_C) { REPBAR(); gla_phase<1>(a, lds, wave, lane); }
    SEAM(PH_GLA_C);
    PHASE(PH_OUTPROJ) { REPBAR();
        DenseOrder S; S.init((const bf16_t*)(ws + WS_OG), (const bf16_t*)(ws + WS_WOUT), T, D, D, gridDim.x, blockIdx.x);
        EpiRes E{a.out, a.in[0], D};
        gemm_phase<EpiRes, DenseOrder>(lds, S, E);
    }
    SEAM(PH_OUTPROJ);
    MOE_PHASES(PH_M0_ROUTE, 0)
    SEAM(PH_M0_COMB);
    if (IN(PH_A_NORM) && !IN(PH_M0_COMB)) att_norm_phase(a, wave, lane);
    if (IN(PH_A_NORM) && !IN(PH_M0_COMB)) SEAM(PH_A_NORM);
    PHASE(PH_A_KVQ) { REPBAR();
        DenseOrder S; S.init((const bf16_t*)(ws + WS_XN), (const bf16_t*)(ws + WS_WKVQ), T, 3072, D, gridDim.x, blockIdx.x);
        EpiKVQ E{(bf16_t*)(ws + WS_K2), a.in[9], a.in[11], (float*)(ws + WS_KM), lds};
        gemm_phase<EpiKVQ, DenseOrder>(lds, S, E);
    }
    SEAM(PH_A_KVQ);
    PHASE(PH_A_SEL) { REPBAR(); att_sel_phase(a, lds, rep, wave, lane); }
    SEAM(PH_A_SEL);
    PHASE(PH_A_SELATT) { REPBAR(); att_selatt_phase(a, lds, wave, lane); }
    SEAM(PH_A_SELATT);
    PHASE(PH_A_OWN) { REPBAR(); att_own_phase(a, lds, rep, rep ? TVAR : 0, wave, lane); }
    SEAM(PH_A_OWN);
    PHASE(PH_A_OPROJ) { REPBAR();
        DenseOrder S; S.init((const bf16_t*)(ws + WS_ATT), (const bf16_t*)(ws + WS_WO), T, D, D, gridDim.x, blockIdx.x);
        EpiRes E{rep ? (float*)(ws + WS_DUMMY) : a.out, a.xin, D};
        gemm_phase<EpiRes, DenseOrder>(lds, S, E);
    }
    SEAM(PH_A_OPROJ);
    MOE_PHASES(PH_M1_ROUTE, 1)
#undef IN
#undef SEAM
}
}

static int g_grid = 0;
static void fast_launch(void* const* d_in, const float* xin, float* d_out, void* d_ws, hipStream_t stream, int lo, int hi, bool per_phase) {
    if (g_grid == 0) {
        int dev = 0, cus = 0;
        if (hipGetDevice(&dev) != hipSuccess || hipDeviceGetAttribute(&cus, hipDeviceAttributeMultiprocessorCount, dev) != hipSuccess) { fprintf(stderr, "kernel_launch: device query failed\n"); g_grid = -1; return; }
        if (hipFuncSetAttribute((const void*)fk::fwd, hipFuncAttributeMaxDynamicSharedMemorySize, fk::LDS_BYTES) != hipSuccess) { fprintf(stderr, "kernel_launch: hipFuncSetAttribute failed\n"); g_grid = -1; return; }
        int per_cu = 0;
        if (hipOccupancyMaxActiveBlocksPerMultiprocessor(&per_cu, (const void*)fk::fwd, 512, fk::LDS_BYTES) != hipSuccess || per_cu < 1) fprintf(stderr, "kernel_launch: occupancy query says %d\n", per_cu);
        (void)hipGetLastError();
        g_grid = cus;
    }
    if (g_grid < 0) return;
    fk::Args a{};
    for (int i = 0; i < 20; ++i) a.in[i] = (const float*)d_in[i];
    a.out = d_out; a.xin = xin; a.ws = (unsigned char*)d_ws; a.rep2 = 2;
    (void)hipMemsetAsync((char*)d_ws + fk::WS_CTL, 0, fk::CTL_ZERO_BYTES, stream);
    if (per_phase) {
        for (int p = lo; p < hi; ++p) { a.ph_lo = p; a.ph_hi = p + 1; hipLaunchKernelGGL(fk::fwd, dim3(g_grid), dim3(512), fk::LDS_BYTES, stream, a); }
    } else {
        a.ph_lo = lo; a.ph_hi = hi;
        hipLaunchKernelGGL(fk::fwd, dim3(g_grid), dim3(512), fk::LDS_BYTES, stream, a);
    }
    const hipError_t le = hipPeekAtLastError();
    if (le != hipSuccess) fprintf(stderr, "kernel_launch: launch failed: %s\n", hipGetErrorName(le));
}


extern "C" void kernel_launch(void* const* d_in, const int* in_sizes, int n_in, void* d_out, int out_size, void* d_ws, size_t ws_size, hipStream_t stream) {
    if (n_in != 20 || out_size != fk::T * fk::D || ws_size < fk::WS_END) { fprintf(stderr, "kernel_launch: unexpected shapes n_in %d out %d ws %zu\n", n_in, out_size, ws_size); return; }
    float* X = (float*)d_out; unsigned char* ws = (unsigned char*)d_ws;
    const size_t N = (size_t)fk::T * fk::D;
#if DBG_STAGE == 0
    fast_launch(d_in, X, X, d_ws, stream, fk::PH_PROLOGUE, fk::PH_END_S4, HYB_PER_PHASE);
#else
    float* TMP = (float*)(ws + 800 * fk::MiB); unsigned short* FB = (unsigned short*)(ws + 928 * fk::MiB); double* ACC = (double*)(ws + 1000 * fk::MiB);
    (void)hipMemsetAsync(ACC, 0, 64, stream);
#if DBG_STAGE == 1
    fast_launch(d_in, X, TMP, d_ws, stream, fk::PH_PROLOGUE, fk::PH_END_S1, HYB_PER_PHASE);
    hipLaunchKernelGGL(dbg::k_store, dim3(4096), dim3(256), 0, stream, (const float*)TMP, (const float*)d_in[0], FB, N);
    slow::stage1(d_in, X, ws, stream);
    hipLaunchKernelGGL(dbg::k_cmp, dim3(4096), dim3(256), 0, stream, (const unsigned short*)FB, (const float*)X, (const float*)d_in[0], 0, ACC, N);
    slow::stage_moe(d_in, X, ws, stream, 0);
    slow::stage3(d_in, X, ws, stream);
    slow::stage_moe(d_in, X, ws, stream, 1);
#elif DBG_STAGE == 2
    slow::stage1(d_in, X, ws, stream);
    fast_launch(d_in, X, TMP, d_ws, stream, fk::PH_PROLOGUE, fk::PH_PROLOGUE + 1, HYB_PER_PHASE);
    fast_launch(d_in, X, TMP, d_ws, stream, fk::PH_M0_ROUTE, fk::PH_END_S2, HYB_PER_PHASE);
    hipLaunchKernelGGL(dbg::k_store, dim3(4096), dim3(256), 0, stream, (const float*)TMP, (const float*)X, FB, N);
    slow::stage_moe(d_in, X, ws, stream, 0);
    hipLaunchKernelGGL(dbg::k_cmp, dim3(4096), dim3(256), 0, stream, (const unsigned short*)FB, (const float*)(ws + 672 * fk::MiB), (const float*)nullptr, 1, ACC, N);
    slow::stage3(d_in, X, ws, stream);
    slow::stage_moe(d_in, X, ws, stream, 1);
#elif DBG_STAGE == 3
    slow::stage1(d_in, X, ws, stream);
    slow::stage_moe(d_in, X, ws, stream, 0);
    fast_launch(d_in, X, TMP, d_ws, stream, fk::PH_PROLOGUE, fk::PH_PROLOGUE + 1, HYB_PER_PHASE);
    fast_launch(d_in, X, TMP, d_ws, stream, fk::PH_A_NORM, fk::PH_END_S3, HYB_PER_PHASE);
    hipLaunchKernelGGL(dbg::k_store, dim3(4096), dim3(256), 0, stream, (const float*)TMP, (const float*)X, FB, N);
    slow::stage3(d_in, X, ws, stream, (const int*)(ws + fk::WS_SELX), (float*)(ws + 672 * fk::MiB));
    hipLaunchKernelGGL(dbg::k_cmp, dim3(4096), dim3(256), 0, stream, (const unsigned short*)FB, (const float*)(ws + 672 * fk::MiB), (const float*)nullptr, 2, ACC, N);
    slow::stage_moe(d_in, X, ws, stream, 1);
#endif
    hipLaunchKernelGGL(dbg::k_scale, dim3(4096), dim3(256), 0, stream, X, (const double*)ACC, N);
#endif
}
```

```cpp
#include <hip/hip_runtime.h>
#include <cstdio>
#include <cstdint>
#include <cmath>
#ifndef HYB_PER_PHASE
#define HYB_PER_PHASE false
#endif
#ifndef DBG_STAGE
#define DBG_STAGE 0
#endif
namespace slow {
constexpr int B = 4, L = 8192, D = 1024, T = B * L, NH = 8, HD = 128, NEXP = 32, FF = 512, NBLK = 32, BLK = 256;
constexpr int CAP = T * 2 + NEXP * 256;
constexpr float EPS = 1e-6f;

__device__ __forceinline__ float wsum(float v) {
#pragma unroll
    for (int o = 1; o < 64; o <<= 1) v += __shfl_xor(v, o);
    return v;
}
__device__ __forceinline__ float wmax(float v) {
#pragma unroll
    for (int o = 1; o < 64; o <<= 1) v = fmaxf(v, __shfl_xor(v, o));
    return v;
}
__device__ __forceinline__ int t5_bucket(int n) {
    if (n < 16) return n;
    const float lr = logf((float)n / 16.0f) / 4.1588830833596715f;
    int large = 16 + (int)(lr * 16.0f);
    return large < 31 ? large : 31;
}
__global__ void k_prep(const float* __restrict__ hg_lb, const float* __restrict__ rel_bias, float* lb, float* bias_tab) {
    const int i = blockIdx.x * blockDim.x + threadIdx.x;
    if (i < 1024) { const float a = hg_lb[i], b = hg_lb[1024 + i], m = fmaxf(a, b), ea = expf(a - m), eb = expf(b - m); lb[i] = ea / (ea + eb); }
    if (i < 8 * 1024) { const int h = i >> 10, d = i & 1023; bias_tab[i] = rel_bias[t5_bucket(d) * 8 + h]; }
}
template <int N> __global__ void k_rmsnorm(const float* __restrict__ x, const float* __restrict__ w, float* __restrict__ y, int rows) {
    const int row = blockIdx.x * (blockDim.x >> 6) + (threadIdx.x >> 6), lane = threadIdx.x & 63;
    if (row >= rows) return;
    const float* xr = x + (size_t)row * N; float* yr = y + (size_t)row * N;
    float s = 0.f;
    for (int i = lane; i < N; i += 64) { const float v = xr[i]; s += v * v; }
    s = wsum(s);
    const float r = rsqrtf(s * (1.0f / N) + EPS);
    for (int i = lane; i < N; i += 64) yr[i] = xr[i] * r * w[i];
}
__global__ void k_headnorm(const float* __restrict__ x, int ld, int col0, const float* __restrict__ w, float* __restrict__ y, int ldy) {
    const int gw = blockIdx.x * (blockDim.x >> 6) + (threadIdx.x >> 6), lane = threadIdx.x & 63;
    if (gw >= T * NH) return;
    const int t = gw >> 3, h = gw & 7;
    const float* xr = x + (size_t)t * ld + col0 + h * HD;
    const float a = xr[lane], b = xr[lane + 64];
    const float s = wsum(a * a + b * b);
    const float r = rsqrtf(s * (1.0f / HD) + EPS);
    float* yr = y + (size_t)t * ldy + h * HD;
    yr[lane] = a * r * w[lane]; yr[lane + 64] = b * r * w[lane + 64];
}
struct GemmP {
    const float* A; int lda; const int* arow;
    const float* W; int ldw; size_t wstride; const int* tile_e;
    float* C; int ldc; const int* crow; const float* cscale; const float* R;
    int M, N, K, pad;
};
__global__ __launch_bounds__(256) void k_gemm(GemmP p) {
    __shared__ float As[16][68];
    __shared__ float Ws[16][68];
    const int tm = blockIdx.y, tn = blockIdx.x, tid = threadIdx.x;
    int e = 0;
    if (p.tile_e) { e = p.tile_e[tm]; if (e < 0) return; }
    const float* W = p.W + (size_t)e * p.wstride;
    const int ar = tid >> 2, ak = (tid & 3) * 4;
    const int wk = tid >> 4, wn = (tid & 15) * 4;
    const int m0 = tm * 64, n0 = tn * 64;
    int arow = m0 + ar; if (p.arow) { arow = p.arow[m0 + ar]; if (arow < 0) arow = 0; }
    const float* Ap = p.A + (size_t)arow * p.lda + ak;
    const float* Wp = W + (size_t)wk * p.ldw + n0 + wn;
    const int ty = tid >> 4, tx = tid & 15;
    float acc[4][4];
#pragma unroll
    for (int i = 0; i < 4; ++i)
#pragma unroll
        for (int j = 0; j < 4; ++j) acc[i][j] = 0.f;
    for (int k0 = 0; k0 < p.K; k0 += 16) {
        const float4 av = *(const float4*)(Ap + k0);
        const float4 wv = *(const float4*)(Wp + (size_t)k0 * p.ldw);
        __syncthreads();
        As[ak + 0][ar] = av.x; As[ak + 1][ar] = av.y; As[ak + 2][ar] = av.z; As[ak + 3][ar] = av.w;
        *(float4*)&Ws[wk][wn] = wv;
        __syncthreads();
#pragma unroll
        for (int kk = 0; kk < 16; ++kk) {
            const float4 a = *(const float4*)&As[kk][ty * 4];
            const float4 b = *(const float4*)&Ws[kk][tx * 4];
            const float aa[4] = {a.x, a.y, a.z, a.w}, bb[4] = {b.x, b.y, b.z, b.w};
#pragma unroll
            for (int i = 0; i < 4; ++i)
#pragma unroll
                for (int j = 0; j < 4; ++j) acc[i][j] += aa[i] * bb[j];
        }
    }
#pragma unroll
    for (int i = 0; i < 4; ++i) {
        const int m = m0 + ty * 4 + i;
        int cr = m; float sc = 1.f;
        if (p.crow) { cr = p.crow[m]; if (cr < 0) continue; }
        if (p.cscale) sc = p.cscale[cr];
        float* Cp = p.C + (size_t)cr * p.ldc + n0 + tx * 4;
        float4 o = make_float4(acc[i][0] * sc, acc[i][1] * sc, acc[i][2] * sc, acc[i][3] * sc);
        if (p.R) { const float4 r = *(const float4*)(p.R + (size_t)cr * p.ldc + n0 + tx * 4); o.x += r.x; o.y += r.y; o.z += r.z; o.w += r.w; }
        *(float4*)Cp = o;
    }
}
__global__ void k_hg_gates(float* proj, const float* __restrict__ lb) {
    const size_t i = (size_t)blockIdx.x * blockDim.x + threadIdx.x;
    if (i >= (size_t)T * 1024) return;
    const size_t t = i >> 10; const int c = (int)(i & 1023);
    float* row = proj + t * 4096;
    row[c] *= 0.08838834764831845f;
    const float l = lb[c], z = row[1024 + c];
    row[1024 + c] = l + (1.f - l) * (1.f / (1.f + expf(-z)));
}
__global__ __launch_bounds__(128) void k_gla(const float* __restrict__ proj, float* __restrict__ o) {
    const int bh = blockIdx.x, b = bh >> 3, h = bh & 7, dv = threadIdx.x;
    float S[128];
#pragma unroll
    for (int d = 0; d < 128; ++d) S[d] = 0.f;
    const float* base = proj + (size_t)b * L * 4096 + h * 128;
    for (int t = 0; t < L; ++t) {
        const float* row = base + (size_t)t * 4096;
        const float v = row[2048 + dv];
        float acc = 0.f;
#pragma unroll
        for (int d = 0; d < 128; ++d) { const float f = row[1024 + d], q = row[d]; S[d] = f * S[d] + (1.f - f) * v; acc += q * S[d]; }
        o[((size_t)b * L + t) * 1024 + h * 128 + dv] = acc;
    }
}
__global__ void k_onorm_gate(const float* __restrict__ o, const float* __restrict__ proj, const float* __restrict__ w, float* __restrict__ og) {
    const int gw = blockIdx.x * (blockDim.x >> 6) + (threadIdx.x >> 6), lane = threadIdx.x & 63;
    if (gw >= T * NH) return;
    const int t = gw >> 3, h = gw & 7;
    const float* xr = o + (size_t)t * 1024 + h * HD;
    const float a = xr[lane], b = xr[lane + 64];
    const float r = rsqrtf(wsum(a * a + b * b) * (1.0f / HD) + EPS);
    const float* g = proj + (size_t)t * 4096 + 3072 + h * HD;
    const float g0 = g[lane], g1 = g[lane + 64];
    float* yr = og + (size_t)t * 1024 + h * HD;
    yr[lane] = a * r * w[lane] * (g0 / (1.f + expf(-g0)));
    yr[lane + 64] = b * r * w[lane + 64] * (g1 / (1.f + expf(-g1)));
}
__global__ void k_route(const float* __restrict__ h2, const float* __restrict__ wg, const float* __restrict__ bg, const float* __restrict__ we, const float* __restrict__ be,
                        int* cnt, int* list, float* wgt) {
    const int t = blockIdx.x * (blockDim.x >> 6) + (threadIdx.x >> 6), lane = threadIdx.x & 63;
    if (t >= T) return;
    const float* xr = h2 + (size_t)t * D;
    float acc = 0.f;
    const bool isg = lane < 4, ise = lane >= 32;
    for (int k = 0; k < D; ++k) {
        const float xv = xr[k];
        float w = 0.f;
        if (isg) w = wg[k * 4 + lane]; else if (ise) w = we[k * 32 + (lane - 32)];
        acc += xv * w;
    }
    if (isg) acc += bg[lane]; else if (ise) acc += be[lane - 32];
    float gl[4];
#pragma unroll
    for (int i = 0; i < 4; ++i) gl[i] = __shfl(acc, i);
    int gi = 0; float gm = gl[0];
#pragma unroll
    for (int i = 1; i < 4; ++i) if (gl[i] > gm) { gm = gl[i]; gi = i; }
    float gs = 0.f;
#pragma unroll
    for (int i = 0; i < 4; ++i) gs += expf(gl[i] - gm);
    const float gw_ = 1.0f / gs;
    float el[8];
#pragma unroll
    for (int i = 0; i < 8; ++i) el[i] = __shfl(acc, 32 + gi * 8 + i);
    int i0 = 0; float m0 = el[0];
#pragma unroll
    for (int i = 1; i < 8; ++i) if (el[i] > m0) { m0 = el[i]; i0 = i; }
    int i1 = -1; float m1 = -INFINITY;
#pragma unroll
    for (int i = 0; i < 8; ++i) if (i != i0 && el[i] > m1) { m1 = el[i]; i1 = i; }
    const float p1 = expf(m1 - m0);
    const float w0 = gw_ / (1.f + p1), w1 = gw_ * p1 / (1.f + p1);
    if (lane == 0) {
        const int e0 = gi * 8 + i0, e1 = gi * 8 + i1;
        const int r0 = atomicAdd(&cnt[e0], 1); list[(size_t)e0 * (2 * T) + r0] = t * 2;     wgt[t * 2] = w0;
        const int r1 = atomicAdd(&cnt[e1], 1); list[(size_t)e1 * (2 * T) + r1] = t * 2 + 1; wgt[t * 2 + 1] = w1;
    }
}
__global__ void k_moe_rows(const int* __restrict__ cnt, const int* __restrict__ list, int* row_src, int* row_dst, int* tile_e) {
    const int r = blockIdx.x * blockDim.x + threadIdx.x;
    if (r >= CAP) return;
    int start = 0, e = -1, rank = 0;
    for (int i = 0; i < NEXP; ++i) { const int c = cnt[i], pc = (c + 255) & ~255; if (r >= start && r < start + pc) { e = i; rank = r - start; } start += pc; }
    int src = -1, dst = -1;
    if (e >= 0 && rank < cnt[e]) { dst = list[(size_t)e * (2 * T) + rank]; src = dst >> 1; }
    row_src[r] = src; row_dst[r] = dst;
    if ((r & 63) == 0) tile_e[r >> 6] = e;
}
__global__ void k_silu_mul(const float* __restrict__ hu, float* __restrict__ act) {
    const size_t i = (size_t)blockIdx.x * blockDim.x + threadIdx.x;
    if (i >= (size_t)CAP * FF) return;
    const size_t r = i / FF; const int c = (int)(i % FF);
    const float a = hu[r * 1024 + c], b = hu[r * 1024 + 512 + c];
    act[i] = a / (1.f + expf(-a)) * b;
}
__global__ void k_combine(float* x, const float* __restrict__ ybuf) {
    const size_t i = (size_t)blockIdx.x * blockDim.x + threadIdx.x;
    if (i >= (size_t)T * D) return;
    const size_t t = i >> 10; const int c = (int)(i & 1023);
    x[i] += ybuf[(t * 2) * D + c] + ybuf[(t * 2 + 1) * D + c];
}
__global__ void k_kv_split(const float* __restrict__ kv, const float* __restrict__ knw, float* __restrict__ K, float* __restrict__ V) {
    const int gw = blockIdx.x * (blockDim.x >> 6) + (threadIdx.x >> 6), lane = threadIdx.x & 63;
    if (gw >= T * NH) return;
    const int t = gw >> 3, h = gw & 7, b = t / L, pos = t % L;
    const float* kr = kv + (size_t)t * 2048 + h * HD;
    const float a = kr[lane], c = kr[lane + 64];
    const float r = rsqrtf(wsum(a * a + c * c) * (1.0f / HD) + EPS);
    const size_t o = (((size_t)b * NH + h) * L + pos) * HD;
    K[o + lane] = a * r * knw[lane]; K[o + lane + 64] = c * r * knw[lane + 64];
    V[o + lane] = kr[1024 + lane]; V[o + lane + 64] = kr[1024 + lane + 64];
}
__global__ void k_kmean(const float* __restrict__ K, float* __restrict__ km) {
    const int bhn = blockIdx.x, d = threadIdx.x;
    const float* p = K + (size_t)bhn * BLK * HD + d;
    float s = 0.f;
    for (int j = 0; j < BLK; ++j) s += p[(size_t)j * HD];
    km[(size_t)bhn * HD + d] = s * (1.0f / BLK);
}
__global__ __launch_bounds__(256) void k_moba(const float* __restrict__ q, const float* __restrict__ K, const float* __restrict__ V, const float* __restrict__ km,
                                              const float* __restrict__ bias_tab, float* __restrict__ att, int* __restrict__ sel_out, const int* __restrict__ sel_in) {
    __shared__ float qs[128];
    __shared__ float gate[32];
    __shared__ int selb[4];
    __shared__ float lg[4][256];
    __shared__ float red[8];
    __shared__ float osum[128];
    const int bid = blockIdx.x, t = bid >> 3, h = bid & 7, b = t / L, pos = t % L, blk = pos >> 8, tid = threadIdx.x, lane = tid & 63, wv = tid >> 6;
    if (tid < 128) qs[tid] = q[(size_t)t * 1024 + h * HD + tid];
    __syncthreads();
    const size_t bh = (size_t)b * NH + h;
    if (tid < 32) {
        float g = -INFINITY;
        if (tid < blk) { const float* kp = km + (bh * NBLK + tid) * HD; float s = 0.f; for (int d = 0; d < HD; ++d) s += qs[d] * kp[d]; g = s; }
        gate[tid] = g;
    }
    __syncthreads();
    const int nsel = blk < 3 ? blk : 3;
    if (tid == 0 && sel_in) { selb[0] = sel_in[(size_t)bid * 3 + 0]; selb[1] = sel_in[(size_t)bid * 3 + 1]; selb[2] = sel_in[(size_t)bid * 3 + 2]; selb[3] = blk; }
    if (tid == 0 && !sel_in) {
        int u0 = -1, u1 = -1;
        for (int s = 0; s < 3; ++s) {
            int bi = -1; float bv = -INFINITY;
            for (int n = 0; n < blk; ++n) { if (n == u0 || n == u1) continue; if (bi < 0 || gate[n] > bv) { bv = gate[n]; bi = n; } }
            selb[s] = bi; if (s == 0) u0 = bi; else if (s == 1) u1 = bi;
        }
        selb[3] = blk;
        if (sel_out) { sel_out[(size_t)bid * 3 + 0] = selb[0]; sel_out[(size_t)bid * 3 + 1] = selb[1]; sel_out[(size_t)bid * 3 + 2] = selb[2]; }
    }
    __syncthreads();
    const float scale = 0.08838834764831845f;
    float mx = -INFINITY;
    for (int s = 0; s < 4; ++s) {
        float l = -INFINITY;
        const bool on = (s == 3) || (s < nsel);
        if (on) {
            const int kb = selb[s], kpos = kb * BLK + tid, dist = pos - kpos;
            if (dist >= 0) {
                const float* kp = K + (bh * L + kpos) * HD; float a = 0.f;
                for (int d = 0; d < HD; ++d) a += qs[d] * kp[d];
                l = a * scale + bias_tab[h * 1024 + (dist < 1023 ? dist : 1023)];
            }
        }
        lg[s][tid] = l; mx = fmaxf(mx, l);
    }
    mx = wmax(mx); if (lane == 0) red[wv] = mx; __syncthreads();
    mx = fmaxf(fmaxf(red[0], red[1]), fmaxf(red[2], red[3])); __syncthreads();
    float sm = 0.f;
    for (int s = 0; s < 4; ++s) { const float l = lg[s][tid]; const float p = (l == -INFINITY) ? 0.f : expf(l - mx); lg[s][tid] = p; sm += p; }
    sm = wsum(sm); if (lane == 0) red[4 + wv] = sm; __syncthreads();
    sm = red[4] + red[5] + red[6] + red[7];
    const int d = tid & 127, half = tid >> 7;
    float o = 0.f;
    for (int s = 0; s < 4; ++s) {
        const bool on = (s == 3) || (s < nsel);
        if (!on) continue;
        const float* vp = V + (bh * L + (size_t)selb[s] * BLK + half * 128) * HD + d;
        for (int j = 0; j < 128; ++j) o += lg[s][half * 128 + j] * vp[(size_t)j * HD];
    }
    if (half == 1) osum[d] = o;
    __syncthreads();
    if (half == 0) att[(size_t)t * 1024 + h * HD + d] = (o + osum[d]) / sm;
}

struct Bufs {
    float *lb, *bias_tab, *wgt, *km; int *cnt, *list, *row_src, *row_dst, *tile_e, *sel;
    float *HN, *BIG, *O;
};
constexpr size_t MiB = 1u << 20;
static void launch_gemm(hipStream_t s, GemmP p) { dim3 g(p.N / 64, p.M / 64); hipLaunchKernelGGL(k_gemm, g, dim3(256), 0, s, p); }

static void moe_layer(hipStream_t s, const Bufs& bf, float* X, int layer, void* const* d_in) {
    const float* ffn_norm = (const float*)d_in[2] + layer * D;
    const float* wg = (const float*)d_in[14] + (size_t)layer * D * 4;  const float* bg = (const float*)d_in[15] + layer * 4;
    const float* we = (const float*)d_in[16] + (size_t)layer * D * 32; const float* be = (const float*)d_in[17] + layer * 32;
    const float* win = (const float*)d_in[18] + (size_t)layer * NEXP * D * 1024;
    const float* wout = (const float*)d_in[19] + (size_t)layer * NEXP * FF * D;
    float* HU = bf.BIG;
    float* ACT = bf.BIG + (size_t)CAP * 1024;
    float* YB = bf.O;
    hipLaunchKernelGGL(k_rmsnorm<1024>, dim3(T / 4), dim3(256), 0, s, X, ffn_norm, bf.HN, T);
    (void)hipMemsetAsync(bf.cnt, 0, 32 * sizeof(int), s);
    hipLaunchKernelGGL(k_route, dim3(T / 4), dim3(256), 0, s, bf.HN, wg, bg, we, be, bf.cnt, bf.list, bf.wgt);
    hipLaunchKernelGGL(k_moe_rows, dim3((CAP + 255) / 256), dim3(256), 0, s, bf.cnt, bf.list, bf.row_src, bf.row_dst, bf.tile_e);
    GemmP p1{}; p1.A = bf.HN; p1.lda = D; p1.arow = bf.row_src; p1.W = win; p1.ldw = 1024; p1.wstride = (size_t)D * 1024; p1.tile_e = bf.tile_e;
    p1.C = HU; p1.ldc = 1024; p1.M = CAP; p1.N = 1024; p1.K = D; launch_gemm(s, p1);
    hipLaunchKernelGGL(k_silu_mul, dim3((unsigned)(((size_t)CAP * FF + 255) / 256)), dim3(256), 0, s, HU, ACT);
    GemmP p2{}; p2.A = ACT; p2.lda = FF; p2.W = wout; p2.ldw = D; p2.wstride = (size_t)FF * D; p2.tile_e = bf.tile_e;
    p2.C = YB; p2.ldc = D; p2.crow = bf.row_dst; p2.cscale = bf.wgt; p2.M = CAP; p2.N = D; p2.K = FF; launch_gemm(s, p2);
    hipLaunchKernelGGL(k_combine, dim3((unsigned)(((size_t)T * D + 255) / 256)), dim3(256), 0, s, X, YB);
}

static Bufs make_bufs(unsigned char* ws) {
    Bufs bf;
    bf.cnt = (int*)(ws + 0); bf.lb = (float*)(ws + 4096); bf.bias_tab = (float*)(ws + 8192);
    bf.wgt = (float*)(ws + 1 * MiB); bf.km = (float*)(ws + 2 * MiB);
    bf.row_src = (int*)(ws + 3 * MiB); bf.row_dst = (int*)(ws + 4 * MiB); bf.tile_e = (int*)(ws + 5 * MiB);
    bf.sel = (int*)(ws + 6 * MiB);
    bf.list = (int*)(ws + 16 * MiB);
    bf.HN = (float*)(ws + 32 * MiB);
    bf.BIG = (float*)(ws + 160 * MiB);
    bf.O = (float*)(ws + 672 * MiB);
    return bf;
}
static void stage1(void* const* d_in, float* X, unsigned char* ws, hipStream_t s) {
    Bufs bf = make_bufs(ws);
    const float* x = (const float*)d_in[0]; const float* mix_norm = (const float*)d_in[1];
    const float* hg_w_in = (const float*)d_in[3]; const float* hg_lb = (const float*)d_in[4]; const float* hg_o_norm = (const float*)d_in[5]; const float* hg_w_out = (const float*)d_in[6];
    hipLaunchKernelGGL(k_prep, dim3(32), dim3(256), 0, s, hg_lb, (const float*)d_in[13], bf.lb, bf.bias_tab);
    hipLaunchKernelGGL(k_rmsnorm<1024>, dim3(T / 4), dim3(256), 0, s, x, mix_norm, bf.HN, T);
    float* PROJ = bf.BIG;
    { GemmP p{}; p.A = bf.HN; p.lda = D; p.W = hg_w_in; p.ldw = 4096; p.C = PROJ; p.ldc = 4096; p.M = T; p.N = 4096; p.K = D; launch_gemm(s, p); }
    hipLaunchKernelGGL(k_hg_gates, dim3((unsigned)(((size_t)T * 1024 + 255) / 256)), dim3(256), 0, s, PROJ, bf.lb);
    hipLaunchKernelGGL(k_gla, dim3(B * NH), dim3(128), 0, s, PROJ, bf.O);
    hipLaunchKernelGGL(k_onorm_gate, dim3(T * NH / 4), dim3(256), 0, s, bf.O, PROJ, hg_o_norm, bf.HN);
    { GemmP p{}; p.A = bf.HN; p.lda = D; p.W = hg_w_out; p.ldw = D; p.C = X; p.ldc = D; p.R = x; p.M = T; p.N = D; p.K = D; launch_gemm(s, p); }
}
static void stage_moe(void* const* d_in, float* X, unsigned char* ws, hipStream_t s, int layer) { Bufs bf = make_bufs(ws); moe_layer(s, bf, X, layer, d_in); }
__global__ void k_add(float* x, const float* __restrict__ y, size_t n) { for (size_t i = (size_t)blockIdx.x * blockDim.x + threadIdx.x; i < n; i += (size_t)gridDim.x * blockDim.x) x[i] += y[i]; }
static void stage3(void* const* d_in, float* X, unsigned char* ws, hipStream_t s, const int* sel_in = nullptr, float* branch_out = nullptr) {
    Bufs bf = make_bufs(ws);
    const float* mix_norm = (const float*)d_in[1];
    const float* kv_norm = (const float*)d_in[7]; const float* w_kv = (const float*)d_in[8]; const float* k_norm = (const float*)d_in[9];
    const float* att_w_q = (const float*)d_in[10]; const float* q_norm = (const float*)d_in[11]; const float* att_w_o = (const float*)d_in[12]; const float* rel_bias = (const float*)d_in[13];
    hipLaunchKernelGGL(k_prep, dim3(32), dim3(256), 0, s, (const float*)d_in[4], rel_bias, bf.lb, bf.bias_tab);
    hipLaunchKernelGGL(k_rmsnorm<1024>, dim3(T / 4), dim3(256), 0, s, X, kv_norm, bf.HN, T);
    float* KV = bf.BIG; float* Kb = bf.BIG + (size_t)T * 2048; float* Vb = Kb + (size_t)T * 1024;
    { GemmP p{}; p.A = bf.HN; p.lda = D; p.W = w_kv; p.ldw = 2048; p.C = KV; p.ldc = 2048; p.M = T; p.N = 2048; p.K = D; launch_gemm(s, p); }
    hipLaunchKernelGGL(k_kv_split, dim3(T * NH / 4), dim3(256), 0, s, KV, k_norm, Kb, Vb);
    hipLaunchKernelGGL(k_kmean, dim3(B * NH * NBLK), dim3(128), 0, s, Kb, bf.km);
    hipLaunchKernelGGL(k_rmsnorm<1024>, dim3(T / 4), dim3(256), 0, s, X, mix_norm + D, bf.HN, T);
    float* Q = bf.BIG; float* ATT = bf.BIG + (size_t)T * 1024;
    { GemmP p{}; p.A = bf.HN; p.lda = D; p.W = att_w_q; p.ldw = D; p.C = Q; p.ldc = D; p.M = T; p.N = D; p.K = D; launch_gemm(s, p); }
    hipLaunchKernelGGL(k_headnorm, dim3(T * NH / 4), dim3(256), 0, s, Q, D, 0, q_norm, Q, D);
    hipLaunchKernelGGL(k_moba, dim3(T * NH), dim3(256), 0, s, Q, Kb, Vb, bf.km, bf.bias_tab, ATT, bf.sel, sel_in);
    if (branch_out) { GemmP p{}; p.A = ATT; p.lda = D; p.W = att_w_o; p.ldw = D; p.C = branch_out; p.ldc = D; p.M = T; p.N = D; p.K = D; launch_gemm(s, p);
        hipLaunchKernelGGL(k_add, dim3(4096), dim3(256), 0, s, X, (const float*)branch_out, (size_t)T * D); }
    else { GemmP p{}; p.A = ATT; p.lda = D; p.W = att_w_o; p.ldw = D; p.C = X; p.ldc = D; p.R = X; p.M = T; p.N = D; p.K = D; launch_gemm(s, p); }
}
}
namespace dbg {
__device__ __forceinline__ unsigned f2bf(float f) { unsigned u = __builtin_bit_cast(unsigned, f); return (u + 0x7fffu + ((u >> 16) & 1u)) >> 16; }
__global__ void k_store(const float* __restrict__ a, const float* __restrict__ b, unsigned short* __restrict__ out, size_t n) {
    for (size_t i = (size_t)blockIdx.x * blockDim.x + threadIdx.x; i < n; i += (size_t)gridDim.x * blockDim.x) out[i] = (unsigned short)f2bf(a[i] - b[i]);
}
__global__ void k_cmp(const unsigned short* __restrict__ fb, const float* __restrict__ s1, const float* __restrict__ s2, int mode, double* acc, size_t n) {
    double num = 0.0, den = 0.0;
    for (size_t i = (size_t)blockIdx.x * blockDim.x + threadIdx.x; i < n; i += (size_t)gridDim.x * blockDim.x) {
        float sl;
        if (mode == 0) sl = s1[i] - s2[i];
        else if (mode == 1) { const size_t t = i >> 10, c = i & 1023; sl = s1[(2 * t) * 1024 + c] + s1[(2 * t + 1) * 1024 + c]; }
        else sl = s1[i];
        const float f = __builtin_bit_cast(float, (unsigned)fb[i] << 16);
        const double d = (double)f - (double)sl; num += d * d; den += (double)sl * (double)sl;
    }
    for (int o = 32; o >= 1; o >>= 1) { num += __shfl_xor(num, o); den += __shfl_xor(den, o); }
    if ((threadIdx.x & 63) == 0) { atomicAdd(acc, num); atomicAdd(acc + 1, den); }
}
__global__ void k_scale(float* out, const double* acc, size_t n) {
    const float f = 1.0f + (float)sqrt(acc[0] / acc[1]);
    for (size_t i = (size_t)blockIdx.x * blockDim.x + threadIdx.x; i < n; i += (size_t)gridDim.x * blockDim.x) out[i] *= f;
}
}
namespace fk {
constexpr int B = 4, L = 8192, D = 1024, T = B * L, NH = 8, HD = 128, NEXP = 32, FF = 512, NBLK = 32, BLK = 256;
constexpr float EPS = 1e-6f;
#define LAS __attribute__((address_space(3)))
#define GAS __attribute__((address_space(1)))
typedef unsigned short bf16_t;
typedef short bf16x8 __attribute__((ext_vector_type(8)));
typedef short bf16x4 __attribute__((ext_vector_type(4)));
typedef float f32x4 __attribute__((ext_vector_type(4)));
typedef float f32x2 __attribute__((ext_vector_type(2)));
typedef unsigned u32x4 __attribute__((ext_vector_type(4)));
typedef unsigned u32x2 __attribute__((ext_vector_type(2)));
#define LDS_WAIT() asm volatile("s_waitcnt lgkmcnt(0)" ::: "memory")
#define VM_WAIT() asm volatile("s_waitcnt vmcnt(0)" ::: "memory")
__device__ __forceinline__ unsigned f2bf(float f) { unsigned u = __builtin_bit_cast(unsigned, f); return (u + 0x7fffu + ((u >> 16) & 1u)) >> 16; }
typedef __bf16 hwbf2 __attribute__((ext_vector_type(2)));
__device__ __forceinline__ unsigned pk2(float lo, float hi) { hwbf2 v; v[0] = (__bf16)lo; v[1] = (__bf16)hi; return __builtin_bit_cast(unsigned, v); }
__device__ __forceinline__ float as_f(unsigned u) { return __builtin_bit_cast(float, u); }
__device__ __forceinline__ unsigned as_u(float f) { return __builtin_bit_cast(unsigned, f); }
__device__ __forceinline__ float bf_lo(unsigned u) { return __builtin_bit_cast(float, u << 16); }
__device__ __forceinline__ float bf_hi(unsigned u) { return __builtin_bit_cast(float, u & 0xffff0000u); }
__device__ __forceinline__ float wave_sum(float v) {
#pragma unroll
    for (int o = 1; o < 64; o <<= 1) v += __shfl_xor(v, o);
    return v;
}
__device__ __forceinline__ float sigmoidf_(float z) { return __builtin_amdgcn_rcpf(1.0f + __expf(-z)); }

#define XB_TMO      128
#define XB_XCNT(j)  (256  + 64 * (j))
#define XB_XSUB(j)  (1280 + 64 * (j))
#define XB_XGEN(j)  (2304 + 64 * (j))
#define XB_TOP      3328
#define XB_TOPGEN   3392
#define XCD_BAR_WORDS 3456
#define XB_SPIN_CAP (1u << 18)
__device__ __forceinline__ unsigned xb_ld(unsigned* p)              { return __hip_atomic_load(p, __ATOMIC_RELAXED, __HIP_MEMORY_SCOPE_AGENT); }
__device__ __forceinline__ unsigned xb_add(unsigned* p, unsigned v) { return __hip_atomic_fetch_add(p, v, __ATOMIC_RELAXED, __HIP_MEMORY_SCOPE_AGENT); }
__device__ __forceinline__ unsigned xb_xcc_id() { return (unsigned)__builtin_amdgcn_s_getreg((3 << 11) | 20) & 0xFu; }
#define XB_SPIN(cond, bar) do { unsigned _sp = 0; while (cond) { __builtin_amdgcn_s_sleep(1); \
    if ((++_sp & 255u) == 0u) { if (xb_ld(&(bar)[XB_TMO])) break; if (_sp > XB_SPIN_CAP) { atomicAdd(&(bar)[XB_TMO], 1u); break; } } } } while (0)
struct XcdBarrier { unsigned* bar; unsigned x; volatile LAS unsigned* st; };
__device__ __forceinline__ XcdBarrier xcd_barrier_post(unsigned* bar, volatile LAS unsigned* st) {
    XcdBarrier b; b.bar = bar; b.x = xb_xcc_id(); b.st = st;
    if (threadIdx.x == 0) (void)xb_add(&bar[XB_XCNT(b.x)], 1u);
    return b;
}
__device__ __forceinline__ void xcd_barrier_complete(unsigned* bar, unsigned x, unsigned& nloc, unsigned& nx) {
    const unsigned G = gridDim.x * gridDim.y * gridDim.z;
    unsigned sum, cnt, mine, sp = 0u;
    for (;;) {
        sum = 0u; cnt = 0u; mine = 0u;
#pragma unroll
        for (unsigned j = 0; j < 16; ++j) { const unsigned c = xb_ld(&bar[XB_XCNT(j)]); sum += c; cnt += (c > 0u) ? 1u : 0u; mine = (j == x) ? c : mine; }
        if (sum == G) break;
        __builtin_amdgcn_s_sleep(1);
        if ((++sp & 255u) == 0u) { if (xb_ld(&bar[XB_TMO])) break; if (sp > XB_SPIN_CAP) { atomicAdd(&bar[XB_TMO], 1u); break; } }
    }
    nloc = mine > 0u ? mine : 1u; nx = cnt > 0u ? cnt : 1u;
}
__device__ __forceinline__ void xcd_barrier(const XcdBarrier& b) {
    asm volatile("s_waitcnt vmcnt(0)" ::: "memory");
    __syncthreads();
    if (threadIdx.x == 0) {
        unsigned* bar = b.bar;
        __builtin_amdgcn_s_waitcnt(0);
        unsigned nloc = b.st[0], nx = b.st[1];
        if (nloc == 0u) { xcd_barrier_complete(bar, b.x, nloc, nx); b.st[0] = nloc; b.st[1] = nx; }
        const unsigned old = xb_add(&bar[XB_XSUB(b.x)], 1u);
        const unsigned gen = old / nloc;
        if (old + 1u == (gen + 1u) * nloc) {
            __builtin_amdgcn_fence(__ATOMIC_RELEASE, "agent");
            asm volatile("s_waitcnt vmcnt(0)" ::: "memory");
            const unsigned og = xb_add(&bar[XB_TOP], 1u);
            const unsigned tg = og / nx;
            if (og + 1u == (tg + 1u) * nx) xb_add(&bar[XB_TOPGEN], 1u);
            else XB_SPIN(xb_ld(&bar[XB_TOPGEN]) == tg, bar);
            __builtin_amdgcn_fence(__ATOMIC_ACQUIRE, "agent");
            xb_add(&bar[XB_XGEN(b.x)], 1u);
            asm volatile("s_waitcnt vmcnt(0)" ::: "memory");
        } else {
            XB_SPIN(xb_ld(&bar[XB_XGEN(b.x)]) == gen, bar);
            __builtin_amdgcn_fence(__ATOMIC_ACQUIRE, "agent");
            asm volatile("s_waitcnt vmcnt(0)" ::: "memory");
        }
    }
    __syncthreads();
}

constexpr int BM = 256, BK = 64, HALF = 128, HTB = HALF * BK * 2, STAGE_BYTES = 8 * HTB, NXCD = 8, WGM = 8;
__host__ __device__ __forceinline__ int lds_byte(int r, int c) { const int st = (r >> 4) * 2 + (c >> 5), rr = r & 15, cc = c & 31, ob = rr * 64 + cc * 2; return st * 1024 + (ob ^ (((ob >> 9) & 1) << 5)); }
__host__ __device__ __forceinline__ void stage_rc(int b, int& R, int& C) { const int st = b / 1024, sb = b % 1024, swz = sb ^ (((sb >> 9) & 1) << 5); R = (st >> 1) * 16 + swz / 64; C = (st & 1) * 32 + (swz % 64) / 2; }
__host__ __device__ __forceinline__ int perm32(int rho) { const int n = rho >> 4, i = rho & 15; return 8 * (i >> 2) + 4 * n + (i & 3); }
struct Unit { int pm, pn, e, aux; };
__device__ __forceinline__ unsigned cvt_pk_bf16(float lo, float hi) { return pk2(lo, hi); }

struct DenseOrder {
    static constexpr bool GATHER = false;
    const bf16_t* A; const bf16_t* Bt; int K;
    int nM, nN, nwg, G, c;
    __device__ void init(const bf16_t* A_, const bf16_t* Bt_, int M, int N, int K_, int G_, int c_) { A = A_; Bt = Bt_; K = K_; nM = M / BM; nN = N / BM; nwg = nM * nN; G = G_; c = c_; }
    __device__ bool next(int i, Unit& u) const {
        const long Lx = (long)i * G + c; if (Lx >= nwg) return false;
        int wgid = (int)Lx; { const int q = nwg / NXCD, r = nwg % NXCD, xcd = wgid % NXCD, off = wgid / NXCD; wgid = (xcd < r ? xcd * (q + 1) : r * (q + 1) + (xcd - r) * q) + off; }
        const int nig = WGM * nN, gid = wgid / nig, fm = gid * WGM, gsz = (nM - fm) < WGM ? (nM - fm) : WGM;
        u.pm = fm + ((wgid % nig) % gsz); u.pn = (wgid % nig) / gsz; u.e = 0; u.aux = 0; return true;
    }
    __device__ __forceinline__ const char* a_base(const Unit& u) const { return (const char*)A + (size_t)u.pm * 256 * K * 2; }
    __device__ __forceinline__ const char* b_base(const Unit& u) const { return (const char*)Bt + (size_t)u.pn * 256 * K * 2; }
    __device__ __forceinline__ void a_offs(const Unit&, const int (&)[2], const int (&)[2], unsigned (&)[2][2]) const {}
};

template <class Epi, class Sched>
__device__ __forceinline__ void gemm_phase(LAS unsigned char* lds, const Sched& S, const Epi& E) {
    const int tid = threadIdx.x, wid = __builtin_amdgcn_readfirstlane(tid >> 6), lane = tid & 63, wr = wid >> 2, wc = wid & 3, fr = lane & 15, fq = lane >> 4;
    const int K = S.K, nt = K / BK;
    unsigned voffA[2], voffB[2]; int RR[2], CC[2];
#pragma unroll
    for (int i = 0; i < 2; ++i) { int R, C; stage_rc(tid * 16 + i * 8192, R, C); const int Rb = Epi::PERM ? ((R & ~31) + perm32(R & 31)) : R; RR[i] = R; CC[i] = C;
        voffA[i] = (unsigned)(R * K + C) * 2u; voffB[i] = (unsigned)(Rb * K + C) * 2u; }
    const size_t kstep = (size_t)(BK * 2);
    const size_t hstep = (size_t)HALF * K * 2;
    const unsigned ldsw = (unsigned)wid * 1024u;
    const int aoff = lds_byte(wr * 64 + fr, fq * 8), boff = lds_byte(wc * 32 + fr, fq * 8);
#define PG8_SA(b, h) (((b) * 2 + (h)) * HTB)
#define PG8_SB(b, h) ((4 + (b) * 2 + (h)) * HTB)
#define PG8_STAGE(bufoff, gbase, voff) do { _Pragma("unroll") for (int _i = 0; _i < 2; ++_i) \
        __builtin_amdgcn_global_load_lds((const unsigned*)((const char*)(gbase) + (voff)[_i]), (LAS unsigned*)(lds + (bufoff) + ldsw + _i * 8192), 16, 0, 0); } while (0)
#define PG8_STAGE_A(bufoff, ap, h, go) do { if constexpr (Sched::GATHER) { PG8_STAGE(bufoff, ap, (go)[h]); } else { PG8_STAGE(bufoff, (ap) + (h) * hstep, voffA); } } while (0)
#define PG8_LDA(dst, b, h) do { _Pragma("unroll") for (int m = 0; m < 4; ++m) _Pragma("unroll") for (int k = 0; k < 2; ++k) dst[m][k] = *(const LAS bf16x8*)(lds + PG8_SA(b, h) + aoff + m * 2048 + k * 1024); } while (0)
#define PG8_LDB(dst, b, h) do { _Pragma("unroll") for (int n = 0; n < 2; ++n) _Pragma("unroll") for (int k = 0; k < 2; ++k) dst[n][k] = *(const LAS bf16x8*)(lds + PG8_SB(b, h) + boff + n * 2048 + k * 1024); } while (0)
#define PG8_MMA(ai, bj, At, Bt) do { __builtin_amdgcn_s_setprio(1); _Pragma("unroll") for (int m = 0; m < 4; ++m) _Pragma("unroll") for (int n = 0; n < 2; ++n) _Pragma("unroll") for (int k = 0; k < 2; ++k) \
        acc[ai][bj][m][n] = __builtin_amdgcn_mfma_f32_16x16x32_bf16(Bt[n][k], At[m][k], acc[ai][bj][m][n], 0, 0, 0); __builtin_amdgcn_s_setprio(0); } while (0)
#define PG8_WAIT_V(n) asm volatile("s_waitcnt vmcnt(" #n ")" ::: "memory")
#define PG8_WAIT_L(n) asm volatile("s_waitcnt lgkmcnt(" #n ")" ::: "memory")
#define PG8_BAR __builtin_amdgcn_s_barrier()
#define PG8_SCHED __builtin_amdgcn_sched_barrier(0)
    Unit cur, nxt; int ui = 0;
    if (!S.next(0, cur)) return;
    f32x4 acc[2][2][4][2];
#pragma unroll
    for (int a = 0; a < 2; ++a)
#pragma unroll
        for (int b = 0; b < 2; ++b)
#pragma unroll
            for (int m = 0; m < 4; ++m)
#pragma unroll
                for (int n = 0; n < 2; ++n) acc[a][b][m][n] = (f32x4){0.f, 0.f, 0.f, 0.f};
    bf16x8 At[4][2], B0[2][2], B1[2][2];
    const char* cA = S.a_base(cur); const char* cB = S.b_base(cur);
    unsigned ca[2][2] = {{0u, 0u}, {0u, 0u}}, na[2][2] = {{0u, 0u}, {0u, 0u}};
    if constexpr (Sched::GATHER) S.a_offs(cur, RR, CC, ca);
    PG8_STAGE(PG8_SB(0, 0), cB, voffB); PG8_STAGE(PG8_SB(0, 1), cB + hstep, voffB); PG8_STAGE_A(PG8_SA(0, 0), cA, 0, ca); PG8_STAGE_A(PG8_SA(0, 1), cA, 1, ca);
    if (wr == 1) PG8_BAR;
    PG8_WAIT_V(2); PG8_BAR;
    PG8_STAGE(PG8_SB(1, 0), cB + kstep, voffB); PG8_STAGE_A(PG8_SA(1, 0), cA + kstep, 0, ca); PG8_STAGE(PG8_SB(1, 1), cB + hstep + kstep, voffB);
    PG8_WAIT_V(6); PG8_BAR;
    for (;;) {
        const bool has_next = S.next(ui + 1, nxt);
        const char* nA = has_next ? S.a_base(nxt) : cA; const char* nB = has_next ? S.b_base(nxt) : cB;
        if constexpr (Sched::GATHER) { if (has_next) S.a_offs(nxt, RR, CC, na); else {
#pragma unroll
            for (int h = 0; h < 2; ++h)
#pragma unroll
                for (int i = 0; i < 2; ++i) na[h][i] = ca[h][i]; } }
        for (int t = 0; t < nt; t += 2) {
            const bool last = (t == nt - 2);
            const char* a1 = cA + (size_t)(t + 1) * kstep;
            const char* a2 = last ? nA : cA + (size_t)(t + 2) * kstep; const char* b2 = last ? nB : cB + (size_t)(t + 2) * kstep;
            const char* a3 = a2 + kstep; const char* b3 = b2 + kstep;
            unsigned o2[2][2];
#pragma unroll
            for (int h = 0; h < 2; ++h)
#pragma unroll
                for (int i = 0; i < 2; ++i) o2[h][i] = last ? na[h][i] : ca[h][i];
            PG8_LDB(B0, 0, 0); PG8_LDB(B1, 0, 1); PG8_SCHED; PG8_LDA(At, 0, 0); PG8_STAGE_A(PG8_SA(1, 1), a1, 1, ca);
            PG8_WAIT_V(8); PG8_WAIT_L(0); PG8_BAR; PG8_MMA(0, 0, At, B0); PG8_MMA(0, 1, At, B1); PG8_BAR; PG8_SCHED;
            PG8_LDA(At, 0, 1); PG8_STAGE(PG8_SB(0, 0), b2, voffB); PG8_STAGE(PG8_SB(0, 1), b2 + hstep, voffB); PG8_STAGE_A(PG8_SA(0, 0), a2, 0, o2);
            PG8_WAIT_V(8); PG8_WAIT_L(0); PG8_BAR; PG8_MMA(1, 0, At, B0); PG8_MMA(1, 1, At, B1); PG8_BAR; PG8_SCHED;
            PG8_LDB(B0, 1, 0); PG8_LDB(B1, 1, 1); PG8_SCHED; PG8_LDA(At, 1, 0); PG8_STAGE_A(PG8_SA(0, 1), a2, 1, o2);
            PG8_WAIT_V(8); PG8_WAIT_L(0); PG8_BAR; PG8_MMA(0, 0, At, B0); PG8_MMA(0, 1, At, B1); PG8_BAR; PG8_SCHED;
            PG8_LDA(At, 1, 1); PG8_STAGE(PG8_SB(1, 0), b3, voffB); PG8_STAGE(PG8_SB(1, 1), b3 + hstep, voffB); PG8_STAGE_A(PG8_SA(1, 0), a3, 0, o2);
            PG8_WAIT_V(8); PG8_WAIT_L(0); PG8_BAR; PG8_MMA(1, 0, At, B0); PG8_MMA(1, 1, At, B1); PG8_BAR; PG8_SCHED;
        }
        if (wr == 0) PG8_BAR;
        E(acc, cur, wr, wc, fr, fq);
        if (!has_next) break;
#pragma unroll
        for (int a = 0; a < 2; ++a)
#pragma unroll
            for (int b = 0; b < 2; ++b)
#pragma unroll
                for (int m = 0; m < 4; ++m)
#pragma unroll
                    for (int n = 0; n < 2; ++n) acc[a][b][m][n] = (f32x4){0.f, 0.f, 0.f, 0.f};
        cur = nxt; cA = nA; cB = nB; ++ui;
#pragma unroll
        for (int h = 0; h < 2; ++h)
#pragma unroll
            for (int i = 0; i < 2; ++i) ca[h][i] = na[h][i];
        if (wr == 1) PG8_BAR;
    }
    PG8_WAIT_V(0);
    PG8_BAR;
#undef PG8_SA
#undef PG8_SB
#undef PG8_STAGE
#undef PG8_STAGE_A
#undef PG8_LDA
#undef PG8_LDB
#undef PG8_MMA
#undef PG8_WAIT_V
#undef PG8_WAIT_L
#undef PG8_BAR
#undef PG8_SCHED
}
constexpr size_t MiB = 1u << 20;
constexpr size_t WS_CTL = 0, CTL_ZERO_BYTES = 256 * 1024;
constexpr size_t WS_SMALL = 1 * MiB;
constexpr size_t WS_DEC = 2 * MiB;
constexpr size_t WS_KM = 3 * MiB;
constexpr size_t WS_LIST = 520 * MiB;
constexpr size_t WS_WGT = 12 * MiB;
constexpr size_t WS_SELCNT = 13 * MiB;
constexpr size_t WS_SEL = 16 * MiB;
constexpr size_t WS_WIN = 40 * MiB, WS_WOUT = 48 * MiB, WS_WKVQ = 50 * MiB, WS_WO = 56 * MiB;
constexpr size_t WS_MWIN = 64 * MiB, WS_MWOUT = 192 * MiB;
constexpr size_t WS_XN = 256 * MiB;
constexpr size_t WS_Q = 320 * MiB, WS_LF = 384 * MiB, WS_V = 448 * MiB, WS_G = 512 * MiB;
constexpr size_t WS_STATE = 576 * MiB;
constexpr size_t WS_OG = 640 * MiB;
constexpr size_t WS_ACT = 320 * MiB;
constexpr size_t WS_YB = 392 * MiB;
constexpr size_t WS_DUMMY = 800 * MiB;
constexpr size_t WS_END = 1024 * MiB;
constexpr int CW_BAR = 1024;
constexpr int CW_CNT = 8192;
constexpr int LDS_BYTES = 163840;
constexpr int LDS_MISC = LDS_BYTES - 64;

struct Args {
    const float* in[20]; const float* xin; float* out; unsigned char* ws; int ph_lo, ph_hi, rep2, pad;
};

__device__ __forceinline__ void p0_item(const float* W, int K, int N, bf16_t* WT, int dst_row0, int dst_row1, const float* kscale, LAS float* scr, int k0, int n0, int lane) {
    f32x4 wv[16];
    const int lk = lane >> 4, ln = (lane & 15) * 4;
#pragma unroll
    for (int i = 0; i < 16; ++i) wv[i] = *(const GAS f32x4*)(W + (size_t)(k0 + 4 * i + lk) * N + n0 + ln);
    if (kscale) {
#pragma unroll
        for (int i = 0; i < 16; ++i) wv[i] = wv[i] * kscale[k0 + 4 * i + lk]; }
#pragma unroll
    for (int i = 0; i < 16; ++i) *(LAS f32x4*)(scr + (4 * i + lk) * 68 + ln) = wv[i];
    LDS_WAIT(); asm volatile("" ::: "memory");
    const int c = lane & 7;
#pragma unroll
    for (int j = 0; j < 8; ++j) { const int n = (lane >> 3) + 8 * j; const LAS float* s = scr + (8 * c) * 68 + n;
        u32x4 o; o.x = pk2(s[0 * 68], s[1 * 68]); o.y = pk2(s[2 * 68], s[3 * 68]); o.z = pk2(s[4 * 68], s[5 * 68]); o.w = pk2(s[6 * 68], s[7 * 68]);
        const int drow = (n < 32 ? dst_row0 + n : dst_row1 + n - 32);
        *(GAS u32x4*)(WT + (size_t)drow * K + k0 + 8 * c) = o; }
    LDS_WAIT(); asm volatile("" ::: "memory");
}
__device__ __forceinline__ int t5_bucket(int n) {
    if (n < 16) return n;
    const float lr = logf((float)n / 16.0f) / 4.1588830833596715f;
    int large = 16 + (int)(lr * 16.0f);
    return large < 31 ? large : 31;
}
__device__ __forceinline__ void norm_row_bf16(const float* xrow, const float* w, bf16_t* orow, int lane) {
    const GAS f32x4* xr = (const GAS f32x4*)xrow + lane;
    f32x4 v[4]; float s = 0.f;
#pragma unroll
    for (int j = 0; j < 4; ++j) { v[j] = xr[64 * j]; s += (v[j].x * v[j].x + v[j].y * v[j].y) + (v[j].z * v[j].z + v[j].w * v[j].w); }
    const float r = rsqrtf(wave_sum(s) * (1.f / D) + EPS);
    GAS u32x2* o8 = (GAS u32x2*)orow + lane;
#pragma unroll
    for (int j = 0; j < 4; ++j) { f32x4 ww = (f32x4){1.f, 1.f, 1.f, 1.f}; if (w) ww = ((const GAS f32x4*)w)[lane + 64 * j];
        u32x2 o; o.x = pk2(v[j].x * r * ww.x, v[j].y * r * ww.y); o.y = pk2(v[j].z * r * ww.z, v[j].w * r * ww.w); o8[64 * j] = o; }
}
__device__ __forceinline__ void p0_prologue(const Args& a, LAS unsigned char* lds, int wave, int lane) {
    LAS float* scr = (LAS float*)(lds + wave * 17920);
    const int gw = blockIdx.x * 8 + wave, NGW = gridDim.x * 8;
    unsigned char* ws = a.ws;
    constexpr int J0 = 1024, J1 = J0 + 256, J2 = J1 + 512, J3 = J2 + 256, J4 = J3 + 256, J5 = J4 + 64 * 256, J6 = J5 + 64 * 128;
    for (int it = gw; it < J6; it += NGW) {
        if (it < J0) { const int r = it, kb = r / 64, nb = r % 64; p0_item(a.in[3], 1024, 4096, (bf16_t*)(ws + WS_WIN), 64 * nb, 64 * nb + 32, nullptr, scr, 64 * kb, 64 * nb, lane); }
        else if (it < J1) { const int r = it - J0, kb = r / 16, nb = r % 16; p0_item(a.in[6], 1024, 1024, (bf16_t*)(ws + WS_WOUT), 64 * nb, 64 * nb + 32, nullptr, scr, 64 * kb, 64 * nb, lane); }
        else if (it < J2) { const int r = it - J1, kb = r / 32, nb = r % 32; p0_item(a.in[8], 1024, 2048, (bf16_t*)(ws + WS_WKVQ), 64 * nb, 64 * nb + 32, a.in[7], scr, 64 * kb, 64 * nb, lane); }
        else if (it < J3) { const int r = it - J2, kb = r / 16, nb = r % 16; p0_item(a.in[10], 1024, 1024, (bf16_t*)(ws + WS_WKVQ), 2048 + 64 * nb, 2048 + 64 * nb + 32, a.in[1] + D, scr, 64 * kb, 64 * nb, lane); }
        else if (it < J4) { const int r = it - J3, kb = r / 16, nb = r % 16; p0_item(a.in[12], 1024, 1024, (bf16_t*)(ws + WS_WO), 64 * nb, 64 * nb + 32, nullptr, scr, 64 * kb, 64 * nb, lane); }
        else if (it < J5) { const int r = it - J4, mat = r / 256, q = r % 256, kb = q / 16, nb = q % 16; const int n0 = 64 * nb;
            const int dst = (n0 < 512) ? ((n0 >> 7) * 256 + (n0 & 127)) : ((((n0 - 512) >> 7) * 256) + 128 + ((n0 - 512) & 127));
            p0_item(a.in[18] + (size_t)mat * 1024 * 1024, 1024, 1024, (bf16_t*)(ws + WS_MWIN) + (size_t)mat * 1024 * 1024, dst, dst + 32, a.in[2] + (mat >> 5) * D, scr, 64 * kb, n0, lane); }
        else { const int r = it - J5, mat = r / 128, q = r % 128, kb = q / 16, nb = q % 16;
            p0_item(a.in[19] + (size_t)mat * 512 * 1024, 512, 1024, (bf16_t*)(ws + WS_MWOUT) + (size_t)mat * 1024 * 512, 64 * nb, 64 * nb + 32, nullptr, scr, 64 * kb, 64 * nb, lane); }
    }
    for (int m = gw; m < T; m += NGW) norm_row_bf16(a.in[0] + (size_t)m * D, a.in[1], (bf16_t*)(ws + WS_XN) + (size_t)m * D, lane);
    if (blockIdx.x == 0) {
        float* lb = (float*)(ws + WS_SMALL); float* bt = lb + 2048;
        for (int i = threadIdx.x; i < 1024; i += 512) { const float x0 = a.in[4][i], x1 = a.in[4][1024 + i], m = fmaxf(x0, x1), e0 = expf(x0 - m), e1 = expf(x1 - m); lb[i] = e0 / (e0 + e1); }
        for (int i = threadIdx.x; i < 8192; i += 512) { const int h = i >> 10, d = i & 1023; bt[i] = a.in[13][t5_bucket(d) * 8 + h]; }
    }
}

struct EpiHG {
    static constexpr bool PERM = true;
    bf16_t* Qo; const float* lb;
    __device__ __forceinline__ void operator()(const f32x4 (&acc)[2][2][4][2], const Unit& u, int wr, int wc, int fr, int fq) const {
        const int quarter = u.pn >> 2, colq = (u.pn & 3) * 256 + wc * 32 + 8 * fq;
        bf16_t* base = Qo + (size_t)quarter * (64 * MiB / 2);
        const int row0 = u.pm * BM + wr * 64 + fr;
        f32x4 l0[2], l1[2];
#pragma unroll
        for (int bj = 0; bj < 2; ++bj) { l0[bj] = *(const f32x4*)(lb + colq + bj * HALF); l1[bj] = *(const f32x4*)(lb + colq + bj * HALF + 4); }
#pragma unroll
        for (int ai = 0; ai < 2; ++ai)
#pragma unroll
            for (int m = 0; m < 4; ++m) { bf16_t* rowp = base + (size_t)(row0 + ai * HALF + m * 16) * 1024 + colq;
#pragma unroll
                for (int bj = 0; bj < 2; ++bj) { f32x4 v0 = acc[ai][bj][m][0], v1 = acc[ai][bj][m][1];
                    if (quarter == 0) { v0 = v0 * 0.08838834764831845f; v1 = v1 * 0.08838834764831845f; }
                    else if (quarter == 1) {
#pragma unroll
                        for (int j = 0; j < 4; ++j) { v0[j] = __logf(l0[bj][j] + (1.f - l0[bj][j]) * sigmoidf_(v0[j])); v1[j] = __logf(l1[bj][j] + (1.f - l1[bj][j]) * sigmoidf_(v1[j])); } }
                    else if (quarter == 3) {
#pragma unroll
                        for (int j = 0; j < 4; ++j) { v0[j] = v0[j] * sigmoidf_(v0[j]); v1[j] = v1[j] * sigmoidf_(v1[j]); } }
                    u32x4 w; w.x = cvt_pk_bf16(v0[0], v0[1]); w.y = cvt_pk_bf16(v0[2], v0[3]); w.z = cvt_pk_bf16(v1[0], v1[1]); w.w = cvt_pk_bf16(v1[2], v1[3]);
                    *(u32x4*)(rowp + bj * HALF) = w; } }
    }
};
struct EpiRes {
    static constexpr bool PERM = false;
    float* C; const float* R; int ldc;
    __device__ __forceinline__ void operator()(const f32x4 (&acc)[2][2][4][2], const Unit& u, int wr, int wc, int fr, int fq) const {
        const int row0 = u.pm * BM + wr * 64 + fr, col0 = u.pn * BM + wc * 32 + 4 * fq;
#pragma unroll
        for (int ai = 0; ai < 2; ++ai)
#pragma unroll
            for (int m = 0; m < 4; ++m) { const size_t off = (size_t)(row0 + ai * HALF + m * 16) * ldc + col0;
#pragma unroll
                for (int bj = 0; bj < 2; ++bj)
#pragma unroll
                    for (int n = 0; n < 2; ++n) { const f32x4 r = *(const f32x4*)(R + off + bj * HALF + n * 16); *(f32x4*)(C + off + bj * HALF + n * 16) = r + acc[ai][bj][m][n]; }
                asm volatile("" ::: "memory"); }
    }
};

__device__ __forceinline__ unsigned off_b(unsigned row, unsigned ch) { return 256u * row + 16u * (ch ^ (((row & 3) << 2) | ((row >> 2) & 3))); }
__device__ __forceinline__ unsigned row_rd16(unsigned lane, unsigned rb, unsigned s) { return off_b((lane & 15) + 16 * rb, 4 * s + (lane >> 4)); }
__device__ __forceinline__ unsigned tr_rd16(unsigned lane, unsigned c, unsigned ks, unsigned t) { const unsigned g = lane >> 4, q = (lane & 15) >> 2, p = lane & 3; return off_b(32 * ks + 8 * g + 4 * t + q, 2 * c + (p >> 1)) + 8 * (p & 1); }
__device__ __forceinline__ unsigned elem_off(unsigned row, unsigned col) { return off_b(row, col >> 3) + (col & 7) * 2; }
__device__ __forceinline__ bf16x8 tr_frag(unsigned a0, unsigned a1) {
    bf16x4 lo, hi;
    asm volatile("ds_read_b64_tr_b16 %0, %2\n\tds_read_b64_tr_b16 %1, %3\n\ts_waitcnt lgkmcnt(0)" : "=&v"(lo), "=&v"(hi) : "v"(a0), "v"(a1) : "memory");
    bf16x8 r; r[0] = lo[0]; r[1] = lo[1]; r[2] = lo[2]; r[3] = lo[3]; r[4] = hi[0]; r[5] = hi[1]; r[6] = hi[2]; r[7] = hi[3]; return r;
}
__device__ __forceinline__ void tr_frag2(unsigned a0, unsigned a1, unsigned b0, unsigned b1, bf16x8& fa, bf16x8& fb) {
    bf16x4 l0, h0, l1, h1;
    asm volatile("ds_read_b64_tr_b16 %0, %4\n\tds_read_b64_tr_b16 %1, %5\n\tds_read_b64_tr_b16 %2, %6\n\tds_read_b64_tr_b16 %3, %7\n\ts_waitcnt lgkmcnt(0)"
                 : "=&v"(l0), "=&v"(h0), "=&v"(l1), "=&v"(h1) : "v"(a0), "v"(a1), "v"(b0), "v"(b1) : "memory");
    fa[0] = l0[0]; fa[1] = l0[1]; fa[2] = l0[2]; fa[3] = l0[3]; fa[4] = h0[0]; fa[5] = h0[1]; fa[6] = h0[2]; fa[7] = h0[3];
    fb[0] = l1[0]; fb[1] = l1[1]; fb[2] = l1[2]; fb[3] = l1[3]; fb[4] = h1[0]; fb[5] = h1[1]; fb[6] = h1[2]; fb[7] = h1[3];
}
constexpr int GI_Q = 0, GI_K = 16384, GI_KH = 32768, GI_V = 49152, GI_A = 65536, GI_ST = 81920, GI_O = 114688, GI_GTOT = 148480, GI_EBT = 152576;
constexpr int O_PITCH = 132;

template <bool WITH_Q>
__device__ __forceinline__ void gla_prep(LAS unsigned char* lds, const unsigned (&lfw)[8], const unsigned (&qw)[8], const unsigned (&vw)[8], int g, int lane, float& totsum0, float& totsum1) {
    float b0[8], b1[8]; float s0 = 0.f, s1 = 0.f;
#pragma unroll
    for (int i = 0; i < 8; ++i) { s0 += bf_lo(lfw[i]); s1 += bf_hi(lfw[i]); b0[i] = s0; b1[i] = s1; }
    LAS float* gtot = (LAS float*)(lds + GI_GTOT);
    *(LAS f32x2*)(gtot + g * 128 + 2 * lane) = (f32x2){s0, s1};
    __syncthreads();
    float pre0 = 0.f, pre1 = 0.f, tot0 = 0.f, tot1 = 0.f;
#pragma unroll
    for (int gg = 0; gg < 8; ++gg) { const f32x2 v = *(LAS f32x2*)(gtot + gg * 128 + 2 * lane); tot0 += v.x; tot1 += v.y; if (gg < g) { pre0 += v.x; pre1 += v.y; } }
    totsum0 += tot0; totsum1 += tot1;
    if (g == 0) *(LAS f32x2*)((LAS float*)(lds + GI_EBT) + 2 * lane) = (f32x2){__expf(tot0), __expf(tot1)};
    const unsigned d = 2 * lane;
#pragma unroll
    for (int i = 0; i < 8; ++i) {
        const unsigned t = 8 * g + i, eo = elem_off(t, d);
        const float B0 = b0[i] + pre0, B1 = b1[i] + pre1;
        const float k0 = 1.f - __expf(bf_lo(lfw[i])), k1 = 1.f - __expf(bf_hi(lfw[i]));
        *(LAS unsigned*)(lds + GI_KH + eo) = cvt_pk_bf16(k0 * __expf(tot0 - B0), k1 * __expf(tot1 - B1));
        *(LAS unsigned*)(lds + GI_V + eo) = vw[i];
        if (WITH_Q) {
            *(LAS unsigned*)(lds + GI_Q + eo) = cvt_pk_bf16(bf_lo(qw[i]) * __expf(B0), bf_hi(qw[i]) * __expf(B1));
            *(LAS unsigned*)(lds + GI_K + eo) = cvt_pk_bf16(k0 * __expf(fminf(-B0, 80.f)), k1 * __expf(fminf(-B1, 80.f)));
        }
    }
}
__device__ __forceinline__ void gla_state_update(LAS unsigned char* lds, unsigned lds0, f32x4 (&S)[8], const bf16x8 (&vf)[2], int w, int lane) {
    const int fr = lane & 15, fq = lane >> 4;
#pragma unroll
    for (int mb = 0; mb < 8; ++mb) {
        const f32x4 e4 = *(LAS f32x4*)((LAS float*)(lds + GI_EBT) + 16 * mb + 4 * fq);
        f32x4 s = S[mb] * e4;
        bf16x8 kh0, kh1;
        tr_frag2(lds0 + GI_KH + tr_rd16(lane, mb, 0, 0), lds0 + GI_KH + tr_rd16(lane, mb, 0, 1), lds0 + GI_KH + tr_rd16(lane, mb, 1, 0), lds0 + GI_KH + tr_rd16(lane, mb, 1, 1), kh0, kh1);
        s = __builtin_amdgcn_mfma_f32_16x16x32_bf16(kh0, vf[0], s, 0, 0, 0); s = __builtin_amdgcn_mfma_f32_16x16x32_bf16(kh1, vf[1], s, 0, 0, 0);
        S[mb] = s;
        u32x2 o; o.x = cvt_pk_bf16(s[0], s[1]); o.y = cvt_pk_bf16(s[2], s[3]);
        *(LAS u32x2*)(lds + GI_ST + elem_off(16 * w + fr, 16 * mb + 4 * fq)) = o;
    }
}
#ifndef GLA_PREFETCH
#define GLA_PREFETCH 1
#endif
template <int PASS>
__device__ __forceinline__ void gla_phase(const Args& a, LAS unsigned char* lds, int wave, int lane) {
    unsigned char* ws = a.ws;
    const unsigned lds0 = (unsigned)(size_t)lds;
    const bf16_t* Qg = (const bf16_t*)(ws + WS_Q); const bf16_t* LFg = (const bf16_t*)(ws + WS_LF); const bf16_t* Vg = (const bf16_t*)(ws + WS_V); const bf16_t* Gg = (const bf16_t*)(ws + WS_G);
    float* STATE = (float*)(ws + WS_STATE); float* DEC = (float*)(ws + WS_DEC); bf16_t* OG = (bf16_t*)(ws + WS_OG);
    const float* onw = a.in[5];
    const int g = wave, w = wave, fr = lane & 15, fq = lane >> 4;
    const int nitems = (1024 - (int)blockIdx.x + (int)gridDim.x - 1) / (int)gridDim.x, nsteps = nitems * 4;
    if (nsteps <= 0) return;
#define GLA_OFF(s) ((((size_t)((((int)blockIdx.x + ((s) >> 2) * (int)gridDim.x) >> 5) >> 3) * L + (size_t)((((int)blockIdx.x + ((s) >> 2) * (int)gridDim.x)) & 31) * 256 + ((s) & 3) * 64 + 8 * g) * 1024) + (size_t)((((int)blockIdx.x + ((s) >> 2) * (int)gridDim.x) >> 5) & 7) * 128 + 2 * lane)
    unsigned nlf[8], nq[8], nv[8], ng[8];
    { const size_t o = GLA_OFF(0);
#pragma unroll
      for (int i = 0; i < 8; ++i) { nlf[i] = *(const unsigned*)(LFg + o + (size_t)i * 1024); nv[i] = *(const unsigned*)(Vg + o + (size_t)i * 1024);
          nq[i] = (PASS == 1) ? *(const unsigned*)(Qg + o + (size_t)i * 1024) : 0u; ng[i] = (PASS == 1) ? *(const unsigned*)(Gg + o + (size_t)i * 1024) : 0u; } }
    f32x4 S[8];
    float ts0 = 0.f, ts1 = 0.f;
    for (int s = 0; s < nsteps; ++s) {
        const int item = (int)blockIdx.x + (s >> 2) * (int)gridDim.x, c = s & 3;
        const size_t ocur = GLA_OFF(s);
        if (c == 0) {
            ts0 = 0.f; ts1 = 0.f;
            if (PASS == 1) {
                const float* sp = STATE + (size_t)item * 16384 + (size_t)(16 * w + fr) * 128 + 4 * fq;
#pragma unroll
                for (int mb = 0; mb < 8; ++mb) { S[mb] = *(const f32x4*)(sp + 16 * mb);
                    u32x2 o; o.x = cvt_pk_bf16(S[mb][0], S[mb][1]); o.y = cvt_pk_bf16(S[mb][2], S[mb][3]);
                    *(LAS u32x2*)(lds + GI_ST + elem_off(16 * w + fr, 16 * mb + 4 * fq)) = o; }
            } else {
#pragma unroll
                for (int mb = 0; mb < 8; ++mb) S[mb] = (f32x4){0.f, 0.f, 0.f, 0.f};
            }
        }
        unsigned lfw[8], qw[8], vw[8], gw8[8];
        if (!GLA_PREFETCH && s > 0) {
#pragma unroll
            for (int i = 0; i < 8; ++i) { nlf[i] = *(const unsigned*)(LFg + ocur + (size_t)i * 1024); nv[i] = *(const unsigned*)(Vg + ocur + (size_t)i * 1024);
                if (PASS == 1) { nq[i] = *(const unsigned*)(Qg + ocur + (size_t)i * 1024); ng[i] = *(const unsigned*)(Gg + ocur + (size_t)i * 1024); } } }
#pragma unroll
        for (int i = 0; i < 8; ++i) { lfw[i] = nlf[i]; qw[i] = nq[i]; vw[i] = nv[i]; gw8[i] = ng[i]; }
        if (GLA_PREFETCH && s + 1 < nsteps) { const size_t o = GLA_OFF(s + 1);
#pragma unroll
            for (int i = 0; i < 8; ++i) { nlf[i] = *(const unsigned*)(LFg + o + (size_t)i * 1024); nv[i] = *(const unsigned*)(Vg + o + (size_t)i * 1024);
                if (PASS == 1) { nq[i] = *(const unsigned*)(Qg + o + (size_t)i * 1024); ng[i] = *(const unsigned*)(Gg + o + (size_t)i * 1024); } } }
        gla_prep<PASS == 1>(lds, lfw, qw, vw, g, lane, ts0, ts1);
        __syncthreads();
        bf16x8 vf[2];
        tr_frag2(lds0 + GI_V + tr_rd16(lane, w, 0, 0), lds0 + GI_V + tr_rd16(lane, w, 0, 1), lds0 + GI_V + tr_rd16(lane, w, 1, 0), lds0 + GI_V + tr_rd16(lane, w, 1, 1), vf[0], vf[1]);
        if (PASS == 1) {
            const int tb = w >> 1;
#pragma unroll
            for (int x = 0; x < 2; ++x) { const int sb = 2 * (w & 1) + x;
                f32x4 acc = (f32x4){0.f, 0.f, 0.f, 0.f};
#pragma unroll
                for (int ks = 0; ks < 4; ++ks) { const bf16x8 ka = *(const LAS bf16x8*)(lds + GI_K + row_rd16(lane, sb, ks)); const bf16x8 qb = *(const LAS bf16x8*)(lds + GI_Q + row_rd16(lane, tb, ks));
                    acc = __builtin_amdgcn_mfma_f32_16x16x32_bf16(ka, qb, acc, 0, 0, 0); }
                const int t = tb * 16 + fr, s0 = sb * 16 + 4 * fq;
#pragma unroll
                for (int r = 0; r < 4; ++r) if (s0 + r > t) acc[r] = 0.f;
                u32x2 o; o.x = cvt_pk_bf16(acc[0], acc[1]); o.y = cvt_pk_bf16(acc[2], acc[3]);
                *(LAS u32x2*)(lds + GI_A + elem_off(t, s0)) = o; }
            bf16x8 stf[4];
#pragma unroll
            for (int ks = 0; ks < 4; ++ks) stf[ks] = *(const LAS bf16x8*)(lds + GI_ST + row_rd16(lane, w, ks));
            __syncthreads();
#pragma unroll
            for (int tb2 = 0; tb2 < 4; ++tb2) {
                f32x4 acc = (f32x4){0.f, 0.f, 0.f, 0.f};
#pragma unroll
                for (int ks = 0; ks < 2; ++ks) { const bf16x8 ab = *(const LAS bf16x8*)(lds + GI_A + row_rd16(lane, tb2, ks)); acc = __builtin_amdgcn_mfma_f32_16x16x32_bf16(vf[ks], ab, acc, 0, 0, 0); }
#pragma unroll
                for (int ks = 0; ks < 4; ++ks) { const bf16x8 qb = *(const LAS bf16x8*)(lds + GI_Q + row_rd16(lane, tb2, ks)); acc = __builtin_amdgcn_mfma_f32_16x16x32_bf16(stf[ks], qb, acc, 0, 0, 0); }
                *(LAS f32x4*)((LAS float*)(lds + GI_O) + (16 * tb2 + fr) * O_PITCH + 16 * w + 4 * fq) = acc;
            }
        }
        if (PASS == 0 || c < 3) gla_state_update(lds, lds0, S, vf, w, lane);
        __syncthreads();
        if (PASS == 1) {
            const f32x2 nw = *(const f32x2*)(onw + 2 * lane);
#pragma unroll
            for (int i = 0; i < 8; ++i) { const int t = 8 * g + i;
                const f32x2 o = *(LAS f32x2*)((LAS float*)(lds + GI_O) + t * O_PITCH + 2 * lane);
                const float r = rsqrtf(wave_sum(o.x * o.x + o.y * o.y) * (1.f / 128.f) + EPS);
                *(unsigned*)(OG + ocur + (size_t)i * 1024) = cvt_pk_bf16(o.x * r * nw.x * bf_lo(gw8[i]), o.y * r * nw.y * bf_hi(gw8[i])); }
        }
        if (PASS == 0 && c == 3) {
            float* sp = STATE + (size_t)item * 16384 + (size_t)(16 * w + fr) * 128 + 4 * fq;
#pragma unroll
            for (int mb = 0; mb < 8; ++mb) *(f32x4*)(sp + 16 * mb) = S[mb];
            if (g == 0) *(f32x2*)(DEC + (size_t)item * 128 + 2 * lane) = (f32x2){__expf(ts0), __expf(ts1)};
        }
        if (c == 3) __syncthreads();
    }
#undef GLA_OFF
}
__device__ __forceinline__ void gla_scan(const Args& a) {
    float* STATE = (float*)(a.ws + WS_STATE); const float* DEC = (const float*)(a.ws + WS_DEC);
    for (int e = blockIdx.x * 512 + threadIdx.x; e < 32 * 4096; e += gridDim.x * 512) {
        const int bh = e >> 12, q = e & 4095, dk0 = (q & 31) * 4;
        f32x4 carry = (f32x4){0.f, 0.f, 0.f, 0.f};
        float* p = STATE + (size_t)bh * 32 * 16384 + (size_t)q * 4;
        const float* dp = DEC + (size_t)bh * 32 * 128 + dk0;
#pragma unroll 4
        for (int sc = 0; sc < 32; ++sc) { const f32x4 loc = *(const f32x4*)(p + (size_t)sc * 16384); const f32x4 dec = *(const f32x4*)(dp + sc * 128);
            *(f32x4*)(p + (size_t)sc * 16384) = carry; carry = dec * carry + loc; }
    }
}
constexpr int MOE_CAPROWS = T * 2 + NEXP * 256;
constexpr int LDS_MOE_TAB = 131072;

constexpr int RL_BH = 0, RL_BL = 36864, RL_LG = 73728, RL_RS = RL_LG + 8 * 2304, RL_REC = RL_RS + 8 * 64, RL_CNT = RL_REC + 5 * 2048;
__device__ __forceinline__ unsigned rt_off(int c, int k) { return (unsigned)c * 1024u + ((((unsigned)k >> 3) ^ ((unsigned)c & 15u)) << 4) + ((unsigned)k & 7u) * 2u; }
__device__ __forceinline__ void moe_route_phase(const Args& a, LAS unsigned char* lds, int layer, int cslot, const float* xin, int wave, int lane) {
    unsigned char* ws = a.ws;
    const float* wg = a.in[14] + (size_t)layer * D * 4; const float* bg = a.in[15] + layer * 4;
    const float* we = a.in[16] + (size_t)layer * D * 32; const float* be = a.in[17] + layer * 32;
    const float* nw = a.in[2] + (size_t)layer * D;
    unsigned* cnt = (unsigned*)(ws + WS_CTL) + CW_CNT + 64 * cslot;
    u32x4* list = (u32x4*)(ws + WS_LIST); bf16_t* H2 = (bf16_t*)(ws + WS_XN);
    const int tid = threadIdx.x, fr = lane & 15, fq = lane >> 4;
    const int NGW = gridDim.x * 8, ngroups = T / 16, rounds = (ngroups + NGW - 1) / NGW;
    LAS float* lgw = (LAS float*)(lds + RL_LG + wave * 2304);
    LAS float* rsw = (LAS float*)(lds + RL_RS + wave * 64);
    LAS int* re0 = (LAS int*)(lds + RL_REC); LAS int* re1 = re0 + 512; LAS float* rw0 = (LAS float*)(re1 + 512); LAS float* rw1 = rw0 + 512; LAS float* rrs = rw1 + 512;
    LAS int* lcnt = (LAS int*)(lds + RL_CNT); LAS int* lbase = lcnt + 32;
    for (int rd = 0; rd < rounds; ++rd) {
        const int grp = (int)blockIdx.x * 8 + wave + rd * NGW;
        const bool live = grp < ngroups;
        const int t = (live ? grp : 0) * 16 + fr;
        f32x4 acc[3];
#pragma unroll
        for (int n = 0; n < 3; ++n) acc[n] = (f32x4){0.f, 0.f, 0.f, 0.f};
        float ss = 0.f;
#pragma unroll 1
        for (int half = 0; half < 2; ++half) {
            __syncthreads();
            for (int i = tid; i < 36 * 512; i += 512) {
                int c, kk; float w;
                if (i < 4 * 512) { kk = i >> 2; c = i & 3; w = wg[(size_t)(half * 512 + kk) * 4 + c]; }
                else { const int q = i - 4 * 512; kk = q >> 5; c = 4 + (q & 31); w = we[(size_t)(half * 512 + kk) * 32 + (q & 31)]; }
                w *= nw[half * 512 + kk];
                const unsigned hi = f2bf(w); const float lo = w - __builtin_bit_cast(float, hi << 16);
                const unsigned o = rt_off(c, kk);
                *(LAS unsigned short*)(lds + RL_BH + o) = (unsigned short)hi; *(LAS unsigned short*)(lds + RL_BL + o) = (unsigned short)f2bf(lo);
            }
            __syncthreads();
            const float* xr = xin + (size_t)t * D + half * 512 + 8 * fq;
            bf16_t* hr = H2 + (size_t)t * D + half * 512 + 8 * fq;
#pragma unroll 4
            for (int ks = 0; ks < 16; ++ks) {
                const f32x4 xa = *(const GAS f32x4*)(xr + 32 * ks), xb = *(const GAS f32x4*)(xr + 32 * ks + 4);
                ss += (xa.x * xa.x + xa.y * xa.y) + (xa.z * xa.z + xa.w * xa.w) + (xb.x * xb.x + xb.y * xb.y) + (xb.z * xb.z + xb.w * xb.w);
                u32x4 hi; hi.x = pk2(xa.x, xa.y); hi.y = pk2(xa.z, xa.w); hi.z = pk2(xb.x, xb.y); hi.w = pk2(xb.z, xb.w);
                u32x4 lo; lo.x = pk2(xa.x - bf_lo(hi.x), xa.y - bf_hi(hi.x)); lo.y = pk2(xa.z - bf_lo(hi.y), xa.w - bf_hi(hi.y));
                          lo.z = pk2(xb.x - bf_lo(hi.z), xb.y - bf_hi(hi.z)); lo.w = pk2(xb.z - bf_lo(hi.w), xb.w - bf_hi(hi.w));
                if (live) *(GAS u32x4*)(hr + 32 * ks) = hi;
                const bf16x8 ahi = __builtin_bit_cast(bf16x8, hi), alo = __builtin_bit_cast(bf16x8, lo);
#pragma unroll
                for (int n = 0; n < 3; ++n) { const int c = (n == 2 ? 20 : 16 * n) + fr; const unsigned o = (unsigned)c * 1024u + ((((unsigned)(4 * ks + fq)) ^ ((unsigned)c & 15u)) << 4);
                    const bf16x8 bh = *(const LAS bf16x8*)(lds + RL_BH + o), bl = *(const LAS bf16x8*)(lds + RL_BL + o);
                    acc[n] = __builtin_amdgcn_mfma_f32_16x16x32_bf16(ahi, bh, acc[n], 0, 0, 0);
                    acc[n] = __builtin_amdgcn_mfma_f32_16x16x32_bf16(ahi, bl, acc[n], 0, 0, 0);
                    acc[n] = __builtin_amdgcn_mfma_f32_16x16x32_bf16(alo, bh, acc[n], 0, 0, 0); }
            }
        }
        ss += __shfl_xor(ss, 16); ss += __shfl_xor(ss, 32);
        const float rstd = rsqrtf(ss * (1.f / D) + EPS);
        if (fq == 0) rsw[fr] = rstd;
#pragma unroll
        for (int r = 0; r < 4; ++r) { const float rs = rsw[4 * fq + r];
            lgw[(4 * fq + r) * 36 + fr] = acc[0][r] * rs + (fr < 4 ? bg[fr] : be[fr - 4]);
            lgw[(4 * fq + r) * 36 + 16 + fr] = acc[1][r] * rs + be[12 + fr];
            if (fr >= 12) lgw[(4 * fq + r) * 36 + 20 + fr] = acc[2][r] * rs + be[16 + fr]; }
        if (lane < 16) {
            float lg[36];
#pragma unroll
            for (int c = 0; c < 36; ++c) lg[c] = lgw[lane * 36 + c];
            int gi = 0; float gm = lg[0];
#pragma unroll
            for (int i = 1; i < 4; ++i) if (lg[i] > gm) { gm = lg[i]; gi = i; }
            float gs = 0.f;
#pragma unroll
            for (int i = 0; i < 4; ++i) gs += expf(lg[i] - gm);
            const float gw_ = 1.0f / gs;
            float el[8];
#pragma unroll
            for (int i = 0; i < 8; ++i) el[i] = gi == 0 ? lg[4 + i] : gi == 1 ? lg[12 + i] : gi == 2 ? lg[20 + i] : lg[28 + i];
            int i0 = 0; float m0 = el[0];
#pragma unroll
            for (int i = 1; i < 8; ++i) if (el[i] > m0) { m0 = el[i]; i0 = i; }
            int i1 = -1; float m1 = -INFINITY;
#pragma unroll
            for (int i = 0; i < 8; ++i) if (i != i0 && el[i] > m1) { m1 = el[i]; i1 = i; }
            const float p1 = expf(m1 - m0);
            const int li = wave * 16 + lane;
            re0[li] = live ? gi * 8 + i0 : -1; re1[li] = gi * 8 + i1; rw0[li] = gw_ / (1.f + p1); rw1[li] = gw_ * p1 / (1.f + p1); rrs[li] = rsw[lane];
        }
        if (tid < 32) lcnt[tid] = 0;
        __syncthreads();
        int myrank0 = 0, myrank1 = 0, e0 = -1, e1 = 0; float w0 = 0.f, w1 = 0.f, rs = 0.f;
        if (tid < 128) { e0 = re0[tid]; e1 = re1[tid]; w0 = rw0[tid]; w1 = rw1[tid]; rs = rrs[tid]; }
        if (e0 >= 0) { myrank0 = __hip_atomic_fetch_add(&lcnt[e0], 1, __ATOMIC_RELAXED, __HIP_MEMORY_SCOPE_WORKGROUP); myrank1 = __hip_atomic_fetch_add(&lcnt[e1], 1, __ATOMIC_RELAXED, __HIP_MEMORY_SCOPE_WORKGROUP); }
        __syncthreads();
        if (tid < 32) { const int c = lcnt[tid]; lbase[tid] = c ? (int)__hip_atomic_fetch_add(cnt + tid, (unsigned)c, __ATOMIC_RELAXED, __HIP_MEMORY_SCOPE_AGENT) : 0; }
        __syncthreads();
        if (e0 >= 0) { const int tk = (((int)blockIdx.x * 8 + (tid >> 4) + rd * NGW) * 16) + (tid & 15);
            list[(size_t)e0 * (2 * T) + lbase[e0] + myrank0] = (u32x4){(unsigned)(tk * 2), as_u(rs), as_u(w0), 0u};
            list[(size_t)e1 * (2 * T) + lbase[e1] + myrank1] = (u32x4){(unsigned)(tk * 2 + 1), as_u(rs), as_u(w1), 0u}; }
    }
}
__device__ __forceinline__ void moe_tables(const Args& a, LAS unsigned char* lds, int layer) {
    LAS int* tst = (LAS int*)(lds + LDS_MOE_TAB); LAS int* cn = tst + 64;
    const unsigned* cnt = (const unsigned*)(a.ws + WS_CTL) + CW_CNT + 64 * layer;
    if (threadIdx.x == 0) { int acc = 0; for (int e = 0; e < NEXP; ++e) { const int c = (int)__hip_atomic_load(cnt + e, __ATOMIC_RELAXED, __HIP_MEMORY_SCOPE_AGENT); tst[e] = acc; cn[e] = c; acc += (c + 255) >> 8; } tst[NEXP] = acc; }
    __syncthreads();
}
struct MoeOrder {
    const LAS int* tst; const LAS int* cn; const u32x4* list;
    const bf16_t* A; const bf16_t* Bt; int K; size_t bstride;
    int G, c, ntot;
    __device__ bool next(int i, Unit& u) const {
        const int Lx = i * G + c; if (Lx >= ntot * 4) return false;
        u.pm = Lx >> 2; u.pn = Lx & 3; int e = 0;
#pragma unroll 1
        for (int k = 1; k < NEXP; ++k) if (tst[k] <= u.pm) e = k;
        u.e = e; u.aux = u.pm - tst[e]; return true;
    }
    __device__ __forceinline__ const char* b_base(const Unit& u) const { return (const char*)Bt + (size_t)u.e * bstride + (size_t)u.pn * 256 * K * 2; }
};
struct MoeOrder1 : MoeOrder {
    static constexpr bool GATHER = true;
    __device__ __forceinline__ const char* a_base(const Unit&) const { return (const char*)A; }
    __device__ __forceinline__ void a_offs(const Unit& u, const int (&RR)[2], const int (&CC)[2], unsigned (&o)[2][2]) const {
        const int cnte = cn[u.e]; const u32x4* le = list + (size_t)u.e * (2 * T);
#pragma unroll
        for (int h = 0; h < 2; ++h)
#pragma unroll
            for (int i = 0; i < 2; ++i) { const int rank = u.aux * 256 + h * 128 + RR[i]; const int tok = rank < cnte ? (int)(((const unsigned*)(le + rank))[0] >> 1) : 0; o[h][i] = (unsigned)(tok * K + CC[i]) * 2u; }
    }
};
struct MoeOrder2 : MoeOrder {
    static constexpr bool GATHER = false;
    __device__ __forceinline__ const char* a_base(const Unit& u) const { return (const char*)A + (size_t)u.pm * 256 * K * 2; }
    __device__ __forceinline__ void a_offs(const Unit&, const int (&)[2], const int (&)[2], unsigned (&)[2][2]) const {}
};
struct EpiAct {
    static constexpr bool PERM = true;
    bf16_t* ACT; const u32x4* list; const LAS int* cn;
    __device__ __forceinline__ void operator()(const f32x4 (&acc)[2][2][4][2], const Unit& u, int wr, int wc, int fr, int fq) const {
        const int row0 = u.pm * BM + wr * 64 + fr, col0 = u.pn * 128 + wc * 32 + 8 * fq;
        const int cnte = cn[u.e]; const u32x4* le = list + (size_t)u.e * (2 * T);
        float rs[2][4];
#pragma unroll
        for (int ai = 0; ai < 2; ++ai)
#pragma unroll
            for (int m = 0; m < 4; ++m) { const int rank = u.aux * 256 + ai * HALF + wr * 64 + m * 16 + fr; rs[ai][m] = rank < cnte ? as_f(((const unsigned*)(le + rank))[1]) : 0.f; }
#pragma unroll
        for (int ai = 0; ai < 2; ++ai)
#pragma unroll
            for (int m = 0; m < 4; ++m) { bf16_t* rowp = ACT + (size_t)(row0 + ai * HALF + m * 16) * FF + col0; const float r = rs[ai][m];
                f32x4 g0 = acc[ai][0][m][0] * r, g1 = acc[ai][0][m][1] * r; const f32x4 u0 = acc[ai][1][m][0] * r, u1 = acc[ai][1][m][1] * r;
#pragma unroll
                for (int j = 0; j < 4; ++j) { g0[j] = g0[j] * sigmoidf_(g0[j]) * u0[j]; g1[j] = g1[j] * sigmoidf_(g1[j]) * u1[j]; }
                u32x4 w; w.x = cvt_pk_bf16(g0[0], g0[1]); w.y = cvt_pk_bf16(g0[2], g0[3]); w.z = cvt_pk_bf16(g1[0], g1[1]); w.w = cvt_pk_bf16(g1[2], g1[3]);
                *(u32x4*)rowp = w; }
    }
};
struct EpiY {
    static constexpr bool PERM = true;
    bf16_t* YB; const u32x4* list; const LAS int* cn;
    __device__ __forceinline__ void operator()(const f32x4 (&acc)[2][2][4][2], const Unit& u, int wr, int wc, int fr, int fq) const {
        const int cnte = cn[u.e]; const u32x4* le = list + (size_t)u.e * (2 * T);
        const int col0 = u.pn * BM + wc * 32 + 8 * fq;
        u32x4 en[2][4];
#pragma unroll
        for (int ai = 0; ai < 2; ++ai)
#pragma unroll
            for (int m = 0; m < 4; ++m) { const int rank = u.aux * 256 + ai * HALF + wr * 64 + m * 16 + fr; en[ai][m] = le[rank < cnte ? rank : 0]; }
#pragma unroll
        for (int ai = 0; ai < 2; ++ai)
#pragma unroll
            for (int m = 0; m < 4; ++m) { const int rank = u.aux * 256 + ai * HALF + wr * 64 + m * 16 + fr;
                if (rank < cnte) { const unsigned wz = en[ai][m].z; const float w = as_f(wz);   bf16_t* rowp = YB + (size_t)en[ai][m].x * D + col0;
#pragma unroll
                    for (int bj = 0; bj < 2; ++bj) { const f32x4 v0 = acc[ai][bj][m][0] * w, v1 = acc[ai][bj][m][1] * w;
                        u32x4 o; o.x = cvt_pk_bf16(v0[0], v0[1]); o.y = cvt_pk_bf16(v0[2], v0[3]); o.z = cvt_pk_bf16(v1[0], v1[1]); o.w = cvt_pk_bf16(v1[2], v1[3]);
                        *(u32x4*)(rowp + bj * HALF) = o; } } }
    }
};
template <bool NORM>
__device__ __forceinline__ void moe_combine_phase(const Args& a, const float* xin, float* xout, int wave, int lane) {
    const bf16_t* YB = (const bf16_t*)(a.ws + WS_YB); bf16_t* XN = (bf16_t*)(a.ws + WS_XN);
    const int gw = blockIdx.x * 8 + wave, NGW = gridDim.x * 8;
    for (int t = gw; t < T; t += NGW) {
        const GAS f32x4* xr = (const GAS f32x4*)(xin + (size_t)t * D) + lane; GAS f32x4* xo = (GAS f32x4*)(xout + (size_t)t * D) + lane;
        const GAS u32x2* y0 = (const GAS u32x2*)(YB + (size_t)(2 * t) * D) + lane; const GAS u32x2* y1 = (const GAS u32x2*)(YB + (size_t)(2 * t + 1) * D) + lane;
        f32x4 v[4]; float s = 0.f;
#pragma unroll
        for (int j = 0; j < 4; ++j) { v[j] = xr[64 * j]; const u32x2 p = y0[64 * j], q = y1[64 * j];
            v[j].x += bf_lo(p.x) + bf_lo(q.x); v[j].y += bf_hi(p.x) + bf_hi(q.x); v[j].z += bf_lo(p.y) + bf_lo(q.y); v[j].w += bf_hi(p.y) + bf_hi(q.y); xo[64 * j] = v[j];
            s += (v[j].x * v[j].x + v[j].y * v[j].y) + (v[j].z * v[j].z + v[j].w * v[j].w); }
        if (NORM) { const float r = rsqrtf(wave_sum(s) * (1.f / D) + EPS); GAS u32x2* o8 = (GAS u32x2*)(XN + (size_t)t * D) + lane;
#pragma unroll
            for (int j = 0; j < 4; ++j) { u32x2 o; o.x = pk2(v[j].x * r, v[j].y * r); o.y = pk2(v[j].z * r, v[j].w * r); o8[64 * j] = o; } }
    }
}
constexpr size_t WS_K2 = 320 * MiB, WS_V2 = 384 * MiB, WS_Q2 = 448 * MiB;
constexpr size_t WS_OP = 512 * MiB;
constexpr size_t WS_LP = 704 * MiB;
constexpr size_t WS_ATT = 708 * MiB;
constexpr size_t WS_SELX = 1001 * MiB;
constexpr int CW_TOT = 16384;
constexpr float ATT_C1 = 0.08838834764831845f * 1.4426950408889634f;

__device__ __forceinline__ void att_norm_phase(const Args& a, int wave, int lane) {
    const int gw = blockIdx.x * 8 + wave, NGW = gridDim.x * 8;
    for (int m = gw; m < T; m += NGW) norm_row_bf16(a.xin + (size_t)m * D, nullptr, (bf16_t*)(a.ws + WS_XN) + (size_t)m * D, lane);
}
constexpr int LDS_KVQ_SS = 131072, LDS_KVQ_CS = 131072 + 8192;
struct EpiKVQ {
    static constexpr bool PERM = true;
    bf16_t* Ko; const float* kw; const float* qw; float* KM; LAS unsigned char* lds;
    __device__ __forceinline__ void operator()(const f32x4 (&acc)[2][2][4][2], const Unit& u, int wr, int wc, int fr, int fq) const {
        const int sec = u.pn >> 2, hp = (u.pn & 3) * 2, d0 = wc * 32 + 8 * fq;
        bf16_t* base = Ko + (size_t)sec * (64 * MiB / 2);
        f32x4 w0 = (f32x4){1.f, 1.f, 1.f, 1.f}, w1 = w0;
        LAS float* SS = (LAS float*)(lds + LDS_KVQ_SS);
        if (sec != 1) {
            const float* nw = sec == 0 ? kw : qw;
            w0 = *(const f32x4*)(nw + d0); w1 = *(const f32x4*)(nw + d0 + 4);
#pragma unroll
            for (int ai = 0; ai < 2; ++ai)
#pragma unroll
                for (int m = 0; m < 4; ++m)
#pragma unroll
                    for (int bj = 0; bj < 2; ++bj) { const f32x4 a = acc[ai][bj][m][0], b = acc[ai][bj][m][1];
                        float s = (a[0] * a[0] + a[1] * a[1]) + (a[2] * a[2] + a[3] * a[3]) + (b[0] * b[0] + b[1] * b[1]) + (b[2] * b[2] + b[3] * b[3]);
                        s += __shfl_xor(s, 16); s += __shfl_xor(s, 32);
                        if (fq == 0) SS[((ai * HALF + wr * 64 + m * 16 + fr) * 2 + bj) * 4 + wc] = s; }
            asm volatile("s_waitcnt lgkmcnt(0)" ::: "memory"); __builtin_amdgcn_s_barrier(); asm volatile("" ::: "memory");
        }
        f32x4 cs0[2], cs1[2];
#pragma unroll
        for (int bj = 0; bj < 2; ++bj) { cs0[bj] = (f32x4){0.f, 0.f, 0.f, 0.f}; cs1[bj] = cs0[bj]; }
#pragma unroll
        for (int ai = 0; ai < 2; ++ai)
#pragma unroll
            for (int m = 0; m < 4; ++m) { const int r = u.pm * BM + ai * HALF + wr * 64 + m * 16 + fr, b = r >> 13, pos = r & 8191;
#pragma unroll
                for (int bj = 0; bj < 2; ++bj) {
                    float rsv = 1.f;
                    if (sec != 1) { const f32x4 p = *(const LAS f32x4*)(SS + ((ai * HALF + wr * 64 + m * 16 + fr) * 2 + bj) * 4); rsv = rsqrtf(((p[0] + p[1]) + (p[2] + p[3])) * (1.f / HD) + EPS); }
                    const f32x4 v0 = acc[ai][bj][m][0] * rsv * w0, v1 = acc[ai][bj][m][1] * rsv * w1;
                    cs0[bj] += v0; cs1[bj] += v1;
                    u32x4 w; w.x = cvt_pk_bf16(v0[0], v0[1]); w.y = cvt_pk_bf16(v0[2], v0[3]); w.z = cvt_pk_bf16(v1[0], v1[1]); w.w = cvt_pk_bf16(v1[2], v1[3]);
                    *(u32x4*)(base + (((size_t)(b * NH + hp + bj) * L + pos) * HD + d0)) = w; } }
        if (sec == 0) {
            LAS float* CS = (LAS float*)(lds + LDS_KVQ_CS);
#pragma unroll
            for (int bj = 0; bj < 2; ++bj)
#pragma unroll
                for (int j = 0; j < 4; ++j) {
                    float a = cs0[bj][j], b2 = cs1[bj][j];
#pragma unroll
                    for (int o = 1; o < 16; o <<= 1) { a += __shfl_xor(a, o); b2 += __shfl_xor(b2, o); }
                    if (fr == 0) { CS[wr * 256 + bj * 128 + d0 + j] = a; CS[wr * 256 + bj * 128 + d0 + 4 + j] = b2; } }
            asm volatile("s_waitcnt lgkmcnt(0)" ::: "memory"); __builtin_amdgcn_s_barrier(); asm volatile("" ::: "memory");
            const int t = threadIdx.x;
            if (t < 256) { const int bb = (u.pm * BM) >> 13, nb = ((u.pm * BM) & 8191) >> 8;
                KM[(((size_t)(bb * NH + hp + (t >> 7))) * NBLK + nb) * HD + (t & 127)] = (CS[t] + CS[256 + t]) * (1.f / 256.f); }
        }
    }
};
__device__ __forceinline__ void att_post_phase(const Args& a, LAS unsigned char* lds, int rep, int wave, int lane) {
    bf16_t* Kb = (bf16_t*)(a.ws + WS_K2); bf16_t* Qb = (bf16_t*)(a.ws + WS_Q2); float* KM = (float*)(a.ws + (rep ? WS_DUMMY + 96 * MiB : WS_KM));
    const size_t wofs = rep ? (WS_DUMMY - WS_K2) / 2 : 0;
    const f32x2 kw = *(const f32x2*)(a.in[9] + 2 * lane), qw = *(const f32x2*)(a.in[11] + 2 * lane);
    LAS float* cs = (LAS float*)lds;
    for (int item = blockIdx.x; item < B * NH * NBLK; item += gridDim.x) {
        const size_t row0 = (size_t)(item >> 5) * L + (size_t)(item & 31) * 256 + 32 * wave;
        float c0 = 0.f, c1 = 0.f;
#pragma unroll 4
        for (int i = 0; i < 32; ++i) {
            unsigned* kp = (unsigned*)(Kb + (row0 + i) * HD) + lane; unsigned* qp = (unsigned*)(Qb + (row0 + i) * HD) + lane;
            const unsigned ku = *kp, qu = *qp;
            float k0 = bf_lo(ku), k1 = bf_hi(ku), q0 = bf_lo(qu), q1 = bf_hi(qu);
            const float rk = rsqrtf(wave_sum(k0 * k0 + k1 * k1) * (1.f / HD) + EPS), rq = rsqrtf(wave_sum(q0 * q0 + q1 * q1) * (1.f / HD) + EPS);
            k0 *= rk * kw.x; k1 *= rk * kw.y; q0 *= rq * qw.x; q1 *= rq * qw.y;
            c0 += k0; c1 += k1;
            kp[wofs / 2] = pk2(k0, k1); qp[(rep ? (WS_DUMMY + 64 * MiB - WS_Q2) / 4 : 0)] = pk2(q0, q1);
        }
        *(LAS f32x2*)(cs + wave * 128 + 2 * lane) = (f32x2){c0, c1};
        __syncthreads();
        if (threadIdx.x < 128) { float s = 0.f;
#pragma unroll
            for (int w8 = 0; w8 < 8; ++w8) s += cs[w8 * 128 + threadIdx.x];
            KM[(size_t)item * HD + threadIdx.x] = s * (1.f / 256.f); }
        __syncthreads();
    }
}
__device__ __forceinline__ void att_sel_phase(const Args& a, LAS unsigned char* lds, int rep, int wave, int lane) {
    const bf16_t* Qb = (const bf16_t*)(a.ws + WS_Q2); const float* KM = (const float*)(a.ws + WS_KM);
    unsigned short* LISTS = (unsigned short*)(a.ws + WS_SEL); int* CNTS = (int*)(a.ws + WS_SELCNT); unsigned* TOT = (unsigned*)(a.ws + WS_CTL) + CW_TOT + 1024 * rep; int* SELX = (int*)(a.ws + WS_SELX);
    LAS float* kms = (LAS float*)lds;
    LAS int* cnts = (LAS int*)(lds + 16384);
    const int tid = threadIdx.x;
    for (int item = blockIdx.x; item < B * NH * NBLK; item += gridDim.x) {
        const int bsel = (item >> 8) & 3, q0 = ((item & 31) + ((bsel & 2) ? 16 : 0)) & 31;
        const int bh = item >> 5, qb = (bsel & 1) ? 31 - q0 : q0, b = bh >> 3, h = bh & 7;
        for (int i = tid; i < qb * 128; i += 512) kms[i] = KM[(size_t)bh * NBLK * HD + i];
        if (tid < 32) cnts[tid] = 0;
        __syncthreads();
        if (tid < 256) {
            const size_t qrow = (size_t)bh * L + (size_t)qb * 256 + tid;
            u32x4 qv[16];
#pragma unroll
            for (int i = 0; i < 16; ++i) qv[i] = ((const GAS u32x4*)(Qb + qrow * HD))[i];
            float v0 = -INFINITY, v1 = -INFINITY, v2 = -INFINITY; int i0 = -1, i1 = -1, i2 = -1;
#pragma unroll 1
            for (int n = 0; n < qb; ++n) {
                const LAS f32x4* kp = (const LAS f32x4*)(kms + n * 128);
                float g = 0.f;
#pragma unroll
                for (int i = 0; i < 16; ++i) { const f32x4 ka = kp[2 * i], kb2 = kp[2 * i + 1];
                    g += bf_lo(qv[i].x) * ka.x + bf_hi(qv[i].x) * ka.y + bf_lo(qv[i].y) * ka.z + bf_hi(qv[i].y) * ka.w
                       + bf_lo(qv[i].z) * kb2.x + bf_hi(qv[i].z) * kb2.y + bf_lo(qv[i].w) * kb2.z + bf_hi(qv[i].w) * kb2.w; }
                if (g > v0) { v2 = v1; i2 = i1; v1 = v0; i1 = i0; v0 = g; i0 = n; }
                else if (g > v1) { v2 = v1; i2 = i1; v1 = g; i1 = n; }
                else if (g > v2) { v2 = g; i2 = n; }
            }
            const int sel[3] = {i0, i1, i2};
#pragma unroll
            for (int s = 0; s < 3; ++s) {
                const int j = sel[s];
                if (j >= 0) { const int p = __hip_atomic_fetch_add(&cnts[j], 1, __ATOMIC_RELAXED, __HIP_MEMORY_SCOPE_WORKGROUP); LISTS[((size_t)(bh * NBLK + j) * NBLK + qb) * 256 + p] = (unsigned short)(tid | (s << 8)); }
                SELX[((size_t)(b * L + qb * 256 + tid) * NH + h) * 3 + s] = j;
            }
        }
        __syncthreads();
        if (tid < qb) { const int c = cnts[tid]; CNTS[(size_t)(bh * NBLK + tid) * NBLK + qb] = c; if (c) __hip_atomic_fetch_add(TOT + bh * NBLK + tid, (unsigned)c, __ATOMIC_RELAXED, __HIP_MEMORY_SCOPE_AGENT); }
        __syncthreads();
    }
}

__device__ __forceinline__ unsigned off_a(unsigned row, unsigned ch) { return 2048u * (row >> 3) + 512u * (ch >> 2) + 64u * (row & 7) + 16u * ((ch & 3) ^ ((row >> 2) & 3)); }
__device__ __forceinline__ unsigned elem_off_a(unsigned row, unsigned col) { return off_a(row, col >> 3) + (col & 7) * 2; }
__device__ __forceinline__ unsigned rowa_base(unsigned lane) { return off_a(lane & 15, lane >> 4); }
__device__ __forceinline__ unsigned tra_base(unsigned lane, unsigned t, unsigned codd) { const unsigned g = lane >> 4, q = (lane & 15) >> 2, p = lane & 3; return off_a(8 * g + 4 * t + q, 2 * codd + (p >> 1)) + 8 * (p & 1); }
constexpr int AL_K = 0, AL_V = 32768, AL_P = 65536, AL_BT = 131072, AL_TAB = 135168;
struct QRow { int qpos; int valid; };
__device__ __forceinline__ void att_stage(LAS unsigned char* lds, const bf16_t* Kg, const bf16_t* Vg, int c, int buf, int wave) {
    const int tid = threadIdx.x;
#pragma unroll
    for (int i = 0; i < 2; ++i) { const int e = tid + 512 * i, row = 8 * (e >> 7) + ((e >> 2) & 7), ch = 4 * ((e >> 5) & 3) + ((e & 3) ^ ((row >> 2) & 3));
        const size_t o = (size_t)c * 64 * HD + (size_t)row * HD + ch * 8;
        __builtin_amdgcn_global_load_lds((const unsigned*)(Kg + o), (LAS unsigned*)(lds + AL_K + buf * 16384 + wave * 1024 + i * 8192), 16, 0, 0);
        __builtin_amdgcn_global_load_lds((const unsigned*)(Vg + o), (LAS unsigned*)(lds + AL_V + buf * 16384 + wave * 1024 + i * 8192), 16, 0, 0); }
}
template <bool OWN>
__device__ __forceinline__ void att_tile(LAS unsigned char* lds, const bf16_t* Kg, const bf16_t* Vg, const bf16_t* const (&qptr)[2], const QRow (&qr)[2], const int (&xblk)[2], int kbase,
                                         f32x4 (&O)[8][2], float (&lsum)[2], int wave, int lane) {
    const int fr = lane & 15, fq = lane >> 4;
    const unsigned lds0 = (unsigned)(size_t)lds;
    LAS unsigned char* Pw = lds + AL_P + wave * 8192;
    const LAS float* bt = (const LAS float*)(lds + AL_BT);
    const unsigned kbase_a = rowa_base(lane);
    const unsigned trb[2][2] = {{tra_base(lane, 0, 0), tra_base(lane, 0, 1)}, {tra_base(lane, 1, 0), tra_base(lane, 1, 1)}};
    const unsigned pwb[2] = {elem_off_a(fr, 4 * fq), elem_off_a(fr, 16 + 4 * fq)};
    bf16x8 qf[2][4];
#pragma unroll
    for (int x = 0; x < 2; ++x)
#pragma unroll
        for (int ks = 0; ks < 4; ++ks) qf[x][ks] = *(const GAS bf16x8*)(qptr[x] + 32 * ks + 8 * fq);
#pragma unroll
    for (int db = 0; db < 8; ++db)
#pragma unroll
        for (int x = 0; x < 2; ++x) O[db][x] = (f32x4){0.f, 0.f, 0.f, 0.f};
    lsum[0] = 0.f; lsum[1] = 0.f;
    __syncthreads();
    att_stage(lds, Kg, Vg, 0, 0, wave);
    asm volatile("s_waitcnt vmcnt(0)" ::: "memory");
    __syncthreads();
    for (int c = 0; c < 4; ++c) {
        const int buf = c & 1;
        if (c < 3) att_stage(lds, Kg, Vg, c + 1, buf ^ 1, wave);
        if (!OWN || 64 * c <= 16 * xblk[1] + 15) {
#pragma unroll 2
            for (int kb = 0; kb < 4; ++kb) {
                bf16x8 ka[4];
#pragma unroll
                for (int ks = 0; ks < 4; ++ks) ka[ks] = *(const LAS bf16x8*)(lds + AL_K + buf * 16384 + kbase_a + 4096 * kb + 512 * ks);
#pragma unroll
                for (int x = 0; x < 2; ++x) {
                    f32x4 s = (f32x4){0.f, 0.f, 0.f, 0.f};
#pragma unroll
                    for (int ks = 0; ks < 4; ++ks) s = __builtin_amdgcn_mfma_f32_16x16x32_bf16(ka[ks], qf[x][ks], s, 0, 0, 0);
                    const int key0 = kbase + 64 * c + 16 * kb + 4 * fq;
                    float p[4];
#pragma unroll
                    for (int r = 0; r < 4; ++r) { const int dist = qr[x].qpos - (key0 + r); const int idx = dist < 0 ? 0 : (dist > 1023 ? 1023 : dist);
                        const float e = __builtin_amdgcn_exp2f(s[r] * ATT_C1 + bt[idx]);
                        p[r] = (qr[x].valid && dist >= 0) ? e : 0.f; lsum[x] += p[r]; }
                    u32x2 o; o.x = cvt_pk_bf16(p[0], p[1]); o.y = cvt_pk_bf16(p[2], p[3]);
                    *(LAS u32x2*)(Pw + pwb[kb & 1] + 4096 * x + 512 * (kb >> 1)) = o;
                }
            }
            bf16x8 pb[2][2];
#pragma unroll
            for (int x = 0; x < 2; ++x)
#pragma unroll
                for (int ks = 0; ks < 2; ++ks) pb[x][ks] = *(const LAS bf16x8*)(Pw + kbase_a + 4096 * x + 512 * ks);
#pragma unroll
            for (int db = 0; db < 8; ++db) {
                bf16x8 vf[2];
                const unsigned vb = lds0 + AL_V + buf * 16384 + 512 * (db >> 1);
                tr_frag2(vb + trb[0][db & 1], vb + trb[1][db & 1], vb + trb[0][db & 1] + 8192, vb + trb[1][db & 1] + 8192, vf[0], vf[1]);
#pragma unroll
                for (int x = 0; x < 2; ++x)
#pragma unroll
                    for (int ks = 0; ks < 2; ++ks) O[db][x] = __builtin_amdgcn_mfma_f32_16x16x32_bf16(vf[ks], pb[x][ks], O[db][x], 0, 0, 0);
            }
        }
        asm volatile("s_waitcnt vmcnt(0)" ::: "memory");
        __syncthreads();
    }
#pragma unroll
    for (int x = 0; x < 2; ++x) { lsum[x] += __shfl_xor(lsum[x], 16); lsum[x] += __shfl_xor(lsum[x], 32); }
}
__device__ __forceinline__ void att_load_bias(const Args& a, LAS unsigned char* lds, int h) {
    LAS float* bt = (LAS float*)(lds + AL_BT); LAS float* red = (LAS float*)(lds + AL_TAB + 8192);
    const int tid = threadIdx.x;
    float m = 0.f;
    if (tid < 128) m = fabsf(a.in[11][tid]);
    else if (tid < 256) m = fabsf(a.in[9][tid - 128]);
    else m = fabsf(a.in[13][tid - 256]);
#pragma unroll
    for (int o = 1; o < 64; o <<= 1) m = fmaxf(m, __shfl_xor(m, o));
    if ((tid & 63) == 0) red[tid >> 6] = m;
    __syncthreads();
    const float mq = fmaxf(red[0], red[1]), mk = fmaxf(red[2], red[3]), mb = fmaxf(fmaxf(red[4], red[5]), fmaxf(red[6], red[7]));
    const float M = 128.f * 0.08838834764831845f * mq * mk * 1.02f + mb;
    const float* bias_tab = (const float*)(a.ws + WS_SMALL) + 2048 + h * 1024;
    for (int i = tid; i < 1024; i += 512) bt[i] = (bias_tab[i] - M) * 1.4426950408889634f;
    __syncthreads();
}
__device__ __forceinline__ void att_selatt_phase(const Args& a, LAS unsigned char* lds, int wave, int lane) {
    const bf16_t* Kb = (const bf16_t*)(a.ws + WS_K2); const bf16_t* Vb = (const bf16_t*)(a.ws + WS_V2); const bf16_t* Qb = (const bf16_t*)(a.ws + WS_Q2);
    const unsigned short* LISTS = (const unsigned short*)(a.ws + WS_SEL); const int* CNTS = (const int*)(a.ws + WS_SELCNT); const unsigned* TOT = (const unsigned*)(a.ws + WS_CTL) + CW_TOT;
    bf16_t* OP = (bf16_t*)(a.ws + WS_OP); float* LP = (float*)(a.ws + WS_LP);
    LAS int* pfx = (LAS int*)(lds + AL_TAB);
    LAS int* segs = (LAS int*)(lds + AL_TAB + 4352);
    const int fr = lane & 15, fq = lane >> 4;
    if (wave == 0) {
        int loc[16]; int s = 0;
#pragma unroll
        for (int i = 0; i < 16; ++i) { const unsigned t = __hip_atomic_load(TOT + lane * 16 + i, __ATOMIC_RELAXED, __HIP_MEMORY_SCOPE_AGENT); loc[i] = s; s += (int)((t + 255u) >> 8); }
        int inc = s;
#pragma unroll
        for (int o = 1; o < 64; o <<= 1) { const int v = __shfl_up(inc, o); if (lane >= o) inc += v; }
        const int excl = inc - s;
#pragma unroll
        for (int i = 0; i < 16; ++i) pfx[lane * 16 + i] = excl + loc[i];
        if (lane == 63) pfx[1024] = inc;
    }
    __syncthreads();
    const int ntiles = pfx[1024];
    const int vcu = (gridDim.x % 8 == 0) ? (int)((blockIdx.x % 8) * (gridDim.x / 8) + blockIdx.x / 8) : (int)blockIdx.x;
    const int g0 = (int)(((long)vcu * ntiles) / gridDim.x), g1 = (int)(((long)(vcu + 1) * ntiles) / gridDim.x);
    if (g0 >= g1) return;
    const unsigned lds0 = (unsigned)(size_t)lds;
    LAS unsigned char* Pw = lds + AL_P + wave * 8192;
    LAS float* lsw = (LAS float*)(lds + AL_TAB + 12288 + wave * 512); LAS unsigned* riw = (LAS unsigned*)(lsw + 32);
    const LAS float* bt = (const LAS float*)(lds + AL_BT);
    const unsigned kbase_a = rowa_base(lane);
    const unsigned trb[2][2] = {{tra_base(lane, 0, 0), tra_base(lane, 0, 1)}, {tra_base(lane, 1, 0), tra_base(lane, 1, 1)}};
    const unsigned pwb[2] = {elem_off_a(fr, 4 * fq), elem_off_a(fr, 16 + 4 * fq)};
#define SA_LOOKUP(g, lid_, ti_) do { int lo_ = 0, hi_ = 1024; while (hi_ - lo_ > 1) { const int mid_ = (lo_ + hi_) >> 1; if (pfx[mid_] <= (g)) lo_ = mid_; else hi_ = mid_; } lid_ = lo_; ti_ = (g) - pfx[lo_]; } while (0)
#define SA_BUILD_SEG(lid_, sb_) do { if (wave == 0) { const int j_ = (lid_) & 31; int cq_ = 0; if (lane < NBLK) { const int v_ = CNTS[(size_t)(lid_) * NBLK + lane]; cq_ = lane > j_ ? v_ : 0; } int inc_ = cq_; \
        _Pragma("unroll") for (int o_ = 1; o_ < 32; o_ <<= 1) { const int v_ = __shfl_up(inc_, o_); if (lane >= o_) inc_ += v_; } \
        if (lane < NBLK) segs[(sb_) * 64 + lane] = inc_ - cq_; if (lane == NBLK - 1) segs[(sb_) * 64 + NBLK] = inc_; } } while (0)
#define SA_ROWMETA(lid_, ti_, sb_, m_) do { const LAS int* sg_ = segs + (sb_) * 64; const int tot_ = sg_[NBLK], j_ = (lid_) & 31; \
        _Pragma("unroll") for (int x_ = 0; x_ < 2; ++x_) { const int R_ = (ti_) * 256 + 32 * wave + 16 * x_ + fr; m_[x_] = 0u; \
            if (R_ < tot_) { int lo_ = j_ + 1, hi_ = NBLK; while (hi_ - lo_ > 1) { const int mid_ = (lo_ + hi_) >> 1; if (sg_[mid_] <= R_) lo_ = mid_; else hi_ = mid_; } \
                const unsigned e_ = LISTS[((size_t)(lid_) * NBLK + lo_) * 256 + (R_ - sg_[lo_])]; m_[x_] = 0x80000000u | ((e_ >> 8) << 16) | (unsigned)(lo_ * 256 + (int)(e_ & 255u)); } } } while (0)
#define SA_QLOAD(lid_, m_) do { _Pragma("unroll") for (int x_ = 0; x_ < 2; ++x_) { const bf16_t* qp2_ = Qb + ((size_t)((lid_) >> 5) * L + (m_[x_] & 0xffffu)) * HD + 8 * fq; \
        _Pragma("unroll") for (int ks_ = 0; ks_ < 4; ++ks_) qf[x_][ks_] = *(const GAS bf16x8*)(qp2_ + 32 * ks_); } } while (0)
    int lid, ti, sb = 0, cur_h;
    SA_LOOKUP(g0, lid, ti);
    cur_h = (lid >> 5) & 7;
    att_load_bias(a, lds, cur_h);
    SA_BUILD_SEG(lid, sb);
    __syncthreads();
    unsigned mt[2];
    LAS unsigned* nmw = riw + 32;
    SA_ROWMETA(lid, ti, sb, mt);
    bf16x8 qf[2][4];
    SA_QLOAD(lid, mt);
    att_stage(lds, Kb + ((size_t)(lid >> 5) * L + (lid & 31) * 256) * HD, Vb + ((size_t)(lid >> 5) * L + (lid & 31) * 256) * HD, 0, 0, wave);
    asm volatile("s_waitcnt vmcnt(0)" ::: "memory");
    __syncthreads();
    for (int g = g0; g < g1; ++g) {
        const bool has_next = g + 1 < g1;
        int nlid = lid, nti = ti + 1;
        if (has_next) SA_LOOKUP(g + 1, nlid, nti);
        const bool new_list = has_next && nlid != lid;
        const int nsb = new_list ? (sb ^ 1) : sb;
        const int bh = lid >> 5, j = lid & 31, kbase = j * 256;
        const bf16_t* Kg = Kb + ((size_t)bh * L + kbase) * HD; const bf16_t* Vg = Vb + ((size_t)bh * L + kbase) * HD;
        bool far; { const LAS int* sg_ = segs + sb * 64; int lo_ = j + 1, hi_ = NBLK; while (hi_ - lo_ > 1) { const int mid_ = (lo_ + hi_) >> 1; if (sg_[mid_] <= ti * 256) lo_ = mid_; else hi_ = mid_; } far = lo_ - j >= 5; }
        const float bconst = bt[1023];
        f32x4 O[8][2]; float lsum[2] = {0.f, 0.f};
#pragma unroll
        for (int db = 0; db < 8; ++db)
#pragma unroll
            for (int x = 0; x < 2; ++x) O[db][x] = (f32x4){0.f, 0.f, 0.f, 0.f};
#pragma unroll 1
        for (int c = 0; c < 4; ++c) {
            const int buf = c & 1;
            if (c < 3) att_stage(lds, Kg, Vg, c + 1, buf ^ 1, wave);
            else if (has_next) att_stage(lds, Kb + ((size_t)(nlid >> 5) * L + (nlid & 31) * 256) * HD, Vb + ((size_t)(nlid >> 5) * L + (nlid & 31) * 256) * HD, 0, 0, wave);
            if (c == 0 && new_list) SA_BUILD_SEG(nlid, nsb);
            if (c == 1 && has_next) { unsigned nm[2]; SA_ROWMETA(nlid, nti, nsb, nm); if (fq == 0) { nmw[fr] = nm[0]; nmw[16 + fr] = nm[1]; } }
#pragma unroll 2
            for (int kb = 0; kb < 4; ++kb) {
                bf16x8 ka[4];
#pragma unroll
                for (int ks = 0; ks < 4; ++ks) ka[ks] = *(const LAS bf16x8*)(lds + AL_K + buf * 16384 + kbase_a + 4096 * kb + 512 * ks);
#pragma unroll
                for (int x = 0; x < 2; ++x) {
                    f32x4 s = (f32x4){0.f, 0.f, 0.f, 0.f};
#pragma unroll
                    for (int ks = 0; ks < 4; ++ks) s = __builtin_amdgcn_mfma_f32_16x16x32_bf16(ka[ks], qf[x][ks], s, 0, 0, 0);
                    float p[4];
                    if (far) {
#pragma unroll
                        for (int r = 0; r < 4; ++r) { const float ev = __builtin_amdgcn_exp2f(s[r] * ATT_C1 + bconst); p[r] = ((int)mt[x] < 0) ? ev : 0.f; lsum[x] += p[r]; }
                    } else {
                        const int key0 = kbase + 64 * c + 16 * kb + 4 * fq;
#pragma unroll
                        for (int r = 0; r < 4; ++r) { const int dist = (int)(mt[x] & 0xffffu) - (key0 + r); const int idx = dist < 0 ? 0 : (dist > 1023 ? 1023 : dist);
                            const float ev = __builtin_amdgcn_exp2f(s[r] * ATT_C1 + bt[idx]);
                            p[r] = ((int)mt[x] < 0 && dist >= 0) ? ev : 0.f; lsum[x] += p[r]; }
                    }
                    u32x2 o; o.x = cvt_pk_bf16(p[0], p[1]); o.y = cvt_pk_bf16(p[2], p[3]);
                    *(LAS u32x2*)(Pw + pwb[kb & 1] + 4096 * x + 512 * (kb >> 1)) = o;
                }
            }
            if (c == 3 && has_next) { unsigned nm[2] = {nmw[fr], nmw[16 + fr]}; SA_QLOAD(nlid, nm); }
            bf16x8 pb[2][2];
#pragma unroll
            for (int x = 0; x < 2; ++x)
#pragma unroll
                for (int ks = 0; ks < 2; ++ks) pb[x][ks] = *(const LAS bf16x8*)(Pw + kbase_a + 4096 * x + 512 * ks);
#pragma unroll
            for (int db = 0; db < 8; ++db) {
                bf16x8 vf[2];
                const unsigned vb = lds0 + AL_V + buf * 16384 + 512 * (db >> 1);
                tr_frag2(vb + trb[0][db & 1], vb + trb[1][db & 1], vb + trb[0][db & 1] + 8192, vb + trb[1][db & 1] + 8192, vf[0], vf[1]);
#pragma unroll
                for (int x = 0; x < 2; ++x)
#pragma unroll
                    for (int ks = 0; ks < 2; ++ks) O[db][x] = __builtin_amdgcn_mfma_f32_16x16x32_bf16(vf[ks], pb[x][ks], O[db][x], 0, 0, 0);
            }
            asm volatile("s_waitcnt vmcnt(0)" ::: "memory");
            __syncthreads();
        }
#pragma unroll
        for (int x = 0; x < 2; ++x) { lsum[x] += __shfl_xor(lsum[x], 16); lsum[x] += __shfl_xor(lsum[x], 32); }
#pragma unroll
        for (int x = 0; x < 2; ++x) {
#pragma unroll
            for (int db = 0; db < 8; ++db) { u32x2 o; o.x = pk2(O[db][x][0], O[db][x][1]); o.y = pk2(O[db][x][2], O[db][x][3]); *(LAS u32x2*)(Pw + elem_off(16 * x + fr, 16 * db + 4 * fq)) = o; }
            if (fq == 0) { lsw[16 * x + fr] = lsum[x]; riw[16 * x + fr] = mt[x]; }
        }
#pragma unroll
        for (int i = 0; i < 8; ++i) { const int row = 4 * i + fq, ch = fr;
            const unsigned ri = riw[row];
            if (ri & 0x80000000u) { const size_t ro = ((size_t)bh * L + (ri & 0xffffu)) * 3 + ((ri >> 16) & 3u);
                *(GAS u32x4*)(OP + ro * HD + ch * 8) = *(const LAS u32x4*)(Pw + off_b(row, ch));
                if (ch == 0) LP[ro] = lsw[row]; }
        }
        if (has_next) {
            const int nh = (nlid >> 5) & 7;
            if (nh != cur_h) { __syncthreads(); att_load_bias(a, lds, nh); cur_h = nh; }
            mt[0] = nmw[fr]; mt[1] = nmw[16 + fr];
            lid = nlid; ti = nti; sb = nsb;
        }
    }
#undef SA_LOOKUP
#undef SA_BUILD_SEG
#undef SA_ROWMETA
#undef SA_QLOAD
}
__device__ __forceinline__ void att_own_phase(const Args& a, LAS unsigned char* lds, int rep, int var, int wave, int lane) {
    const bf16_t* Kb = (const bf16_t*)(a.ws + WS_K2); const bf16_t* Vb = (const bf16_t*)(a.ws + WS_V2); const bf16_t* Qb = (const bf16_t*)(a.ws + WS_Q2);
    const bf16_t* OP = (const bf16_t*)(a.ws + WS_OP); const float* LP = (const float*)(a.ws + WS_LP); bf16_t* ATT = (bf16_t*)(a.ws + (rep ? WS_DUMMY : WS_ATT));
    const int fr = lane & 15, fq = lane >> 4;
    int cur_h = -1;
    for (int item = blockIdx.x; item < B * NH * NBLK; item += gridDim.x) {
        const int bh = item >> 5, qb = item & 31, b = bh >> 3, h = bh & 7;
        __syncthreads();
        if (h != cur_h) { att_load_bias(a, lds, h); cur_h = h; }
        const bf16_t* qptr[2]; QRow qr[2]; int xblk[2] = {wave, 15 - wave};
#pragma unroll
        for (int x = 0; x < 2; ++x) { qr[x].valid = 1; qr[x].qpos = qb * 256 + 16 * xblk[x] + fr; qptr[x] = Qb + ((size_t)bh * L + qr[x].qpos) * HD; }
        f32x4 O[8][2]; float lsum[2];
        att_tile<true>(lds, Kb + ((size_t)bh * L + qb * 256) * HD, Vb + ((size_t)bh * L + qb * 256) * HD, qptr, qr, xblk, qb * 256, O, lsum, wave, lane);
        const int nsel = qb < 3 ? qb : 3;
        LAS unsigned char* Pw = lds + AL_P + wave * 8192; LAS float* lsw = (LAS float*)(lds + AL_TAB + 12288 + wave * 256);
#pragma unroll
        for (int x = 0; x < 2; ++x) {
#pragma unroll
            for (int db = 0; db < 8; ++db) { u32x2 o; o.x = pk2(O[db][x][0], O[db][x][1]); o.y = pk2(O[db][x][2], O[db][x][3]); *(LAS u32x2*)(Pw + elem_off(16 * x + fr, 16 * db + 4 * fq)) = o; }
            if (fq == 0) lsw[16 * x + fr] = lsum[x];
        }
#pragma unroll 1
        for (int i = 0; i < 8; ++i) { const int row = 4 * i + fq, ch = fr, qpos = qb * 256 + 16 * (row < 16 ? wave : 15 - wave) + (row & 15);
            const size_t ro = ((size_t)bh * L + qpos) * 3;
            u32x4 pv[3]; float lp[3];
#pragma unroll
            for (int s = 0; s < 3; ++s) { pv[s] = (u32x4){0u, 0u, 0u, 0u}; lp[s] = 0.f; if (s < nsel) { pv[s] = *(const GAS u32x4*)(OP + (ro + s) * HD + ch * 8); lp[s] = LP[ro + s]; } }
            const u32x4 ov = *(const LAS u32x4*)(Pw + off_b(row, ch));
            const float inv = __builtin_amdgcn_rcpf(lsw[row] + lp[0] + lp[1] + lp[2]);
            const unsigned o0 = ov.x, o1 = ov.y, o2 = ov.z, o3 = ov.w;
            float f[8] = {bf_lo(o0), bf_hi(o0), bf_lo(o1), bf_hi(o1), bf_lo(o2), bf_hi(o2), bf_lo(o3), bf_hi(o3)};
#pragma unroll
            for (int s = 0; s < 3; ++s) { const unsigned p0 = pv[s].x, p1 = pv[s].y, p2 = pv[s].z, p3 = pv[s].w;
                f[0] += bf_lo(p0); f[1] += bf_hi(p0); f[2] += bf_lo(p1); f[3] += bf_hi(p1); f[4] += bf_lo(p2); f[5] += bf_hi(p2); f[6] += bf_lo(p3); f[7] += bf_hi(p3); }
            u32x4 w; w.x = pk2(f[0] * inv, f[1] * inv); w.y = pk2(f[2] * inv, f[3] * inv); w.z = pk2(f[4] * inv, f[5] * inv); w.w = pk2(f[6] * inv, f[7] * inv);
            *(GAS u32x4*)(ATT + ((size_t)b * L + qpos) * D + h * HD + ch * 8) = w;
        }
    }
}
enum Phase { PH_PROLOGUE = 0, PH_INPROJ, PH_GLA_A, PH_GLA_SCAN, PH_GLA_C, PH_OUTPROJ, PH_END_S1,
             PH_M0_ROUTE = PH_END_S1, PH_M0_G1, PH_M0_G2, PH_M0_COMB, PH_END_S2,
             PH_A_NORM = PH_END_S2, PH_A_KVQ, PH_A_POST, PH_A_SEL, PH_A_SELATT, PH_A_OWN, PH_A_OPROJ, PH_END_S3,
             PH_M1_ROUTE = PH_END_S3, PH_M1_G1, PH_M1_G2, PH_M1_COMB, PH_END_S4,
             PH_COUNT = PH_END_S4 };
#ifndef DUP_MASK
#define DUP_MASK 0ull
#endif
#ifndef TVAR
#define TVAR 0
#endif
#define REPS(k) ((((DUP_MASK) >> (k)) & 1ull) ? a.rep2 : 1)
#define PHASE(k) if (IN(k)) for (int rep = 0; rep < REPS(k); ++rep)
#ifndef ROUTE_FN
#define ROUTE_FN moe_route_phase
#endif
#define REPBAR() do { if (rep) xcd_barrier(bar); } while (0)
#define MOE_PHASES(base, layer) \
    PHASE(base) { REPBAR(); ROUTE_FN(a, lds, layer, (layer) + 2 * rep, a.xin, wave, lane); } \
    SEAM(base); \
    PHASE((base) + 1) { REPBAR(); moe_tables(a, lds, layer); MoeOrder1 S; S.tst = (const LAS int*)(lds + LDS_MOE_TAB); S.cn = S.tst + 64; S.list = (const u32x4*)(ws + WS_LIST); \
        S.A = (const bf16_t*)(ws + WS_XN); S.Bt = (const bf16_t*)(ws + WS_MWIN) + (size_t)(layer) * NEXP * 1024 * 1024; S.K = D; S.bstride = (size_t)1024 * 1024 * 2; S.G = gridDim.x; S.c = blockIdx.x; S.ntot = S.tst[NEXP]; \
        EpiAct E{(bf16_t*)(ws + WS_ACT), (const u32x4*)(ws + WS_LIST), S.cn}; gemm_phase<EpiAct, MoeOrder1>(lds, S, E); } \
    SEAM((base) + 1); \
    PHASE((base) + 2) { REPBAR(); moe_tables(a, lds, layer); MoeOrder2 S; S.tst = (const LAS int*)(lds + LDS_MOE_TAB); S.cn = S.tst + 64; S.list = (const u32x4*)(ws + WS_LIST); \
        S.A = (const bf16_t*)(ws + WS_ACT); S.Bt = (const bf16_t*)(ws + WS_MWOUT) + (size_t)(layer) * NEXP * 1024 * 512; S.K = FF; S.bstride = (size_t)1024 * 512 * 2; S.G = gridDim.x; S.c = blockIdx.x; S.ntot = S.tst[NEXP]; \
        EpiY E{(bf16_t*)(ws + WS_YB), (const u32x4*)(ws + WS_LIST), S.cn}; gemm_phase<EpiY, MoeOrder2>(lds, S, E); } \
    SEAM((base) + 2); \
    PHASE((base) + 3) { REPBAR(); moe_combine_phase<(layer) == 0>(a, a.xin, rep ? (float*)(ws + WS_DUMMY) : a.out, wave, lane); }

__global__ void __launch_bounds__(512, 2) fwd(Args a) {
    extern __shared__ __attribute__((aligned(16))) unsigned char smem[];
    LAS unsigned char* lds = (LAS unsigned char*)smem;
    const int tid = threadIdx.x, lane = tid & 63, wave = __builtin_amdgcn_readfirstlane(tid >> 6);
    volatile LAS unsigned* MISC = (volatile LAS unsigned*)(lds + LDS_MISC);
    if (tid < 4) MISC[tid] = 0u;
    __syncthreads();
    unsigned* ctl = (unsigned*)(a.ws + WS_CTL);
    XcdBarrier bar = xcd_barrier_post(ctl + CW_BAR, MISC);
    const int lo = a.ph_lo, hi = a.ph_hi;
    unsigned char* ws = a.ws;
#ifndef ENABLE_MASK
#define ENABLE_MASK (~0ull)
#endif
#define IN(k) ((((ENABLE_MASK) >> (k)) & 1ull) && lo <= (k) && (k) < hi)
#define SEAM(k) do { if (IN(k) && IN((k) + 1)) xcd_barrier(bar); } while (0)
    PHASE(PH_PROLOGUE) { REPBAR(); p0_prologue(a, lds, wave, lane); }
    SEAM(PH_PROLOGUE);
    PHASE(PH_INPROJ) { REPBAR();
        DenseOrder S; S.init((const bf16_t*)(ws + WS_XN), (const bf16_t*)(ws + WS_WIN), T, 4096, D, gridDim.x, blockIdx.x);
        EpiHG E{(bf16_t*)(ws + WS_Q), (const float*)(ws + WS_SMALL)};
        gemm_phase<EpiHG, DenseOrder>(lds, S, E);
    }
    SEAM(PH_INPROJ);
    PHASE(PH_GLA_A) { REPBAR(); gla_phase<0>(a, lds, wave, lane); }
    SEAM(PH_GLA_A);
    if (IN(PH_GLA_SCAN)) gla_scan(a);
    SEAM(PH_GLA_SCAN);
    PHASE(PH_GLA_C) { REPBAR(); gla_phase<1>(a, lds, wave, lane); }
    SEAM(PH_GLA_C);
    PHASE(PH_OUTPROJ) { REPBAR();
        DenseOrder S; S.init((const bf16_t*)(ws + WS_OG), (const bf16_t*)(ws + WS_WOUT), T, D, D, gridDim.x, blockIdx.x);
        EpiRes E{a.out, a.in[0], D};
        gemm_phase<EpiRes, DenseOrder>(lds, S, E);
    }
    SEAM(PH_OUTPROJ);
    MOE_PHASES(PH_M0_ROUTE, 0)
    SEAM(PH_M0_COMB);
    if (IN(PH_A_NORM) && !IN(PH_M0_COMB)) att_norm_phase(a, wave, lane);
    if (IN(PH_A_NORM) && !IN(PH_M0_COMB)) SEAM(PH_A_NORM);
    PHASE(PH_A_KVQ) { REPBAR();
        DenseOrder S; S.init((const bf16_t*)(ws + WS_XN), (const bf16_t*)(ws + WS_WKVQ), T, 3072, D, gridDim.x, blockIdx.x);
        EpiKVQ E{(bf16_t*)(ws + WS_K2), a.in[9], a.in[11], (float*)(ws + WS_KM), lds};
        gemm_phase<EpiKVQ, DenseOrder>(lds, S, E);
    }
    SEAM(PH_A_KVQ);
    PHASE(PH_A_SEL) { REPBAR(); att_sel_phase(a, lds, rep, wave, lane); }
    SEAM(PH_A_SEL);
    PHASE(PH_A_SELATT) { REPBAR(); att_selatt_phase(a, lds, wave, lane); }
    SEAM(PH_A_SELATT);
    PHASE(PH_A_OWN) { REPBAR(); att_own_phase(a, lds, rep, rep ? TVAR : 0, wave, lane); }
    SEAM(PH_A_OWN);
    PHASE(PH_A_OPROJ) { REPBAR();
        DenseOrder S; S.init((const bf16_t*)(ws + WS_ATT), (const bf16_t*)(ws + WS_WO), T, D, D, gridDim.x, blockIdx.x);
        EpiRes E{rep ? (float*)(ws + WS_DUMMY) : a.out, a.xin, D};
        gemm_phase<EpiRes, DenseOrder>(lds, S, E);
    }
    SEAM(PH_A_OPROJ);
    MOE_PHASES(PH_M1_ROUTE, 1)
#undef IN
#undef SEAM
}
}

static int g_grid = 0;
static void fast_launch(void* const* d_in, const float* xin, float* d_out, void* d_ws, hipStream_t stream, int lo, int hi, bool per_phase) {
    if (g_grid == 0) {
        int dev = 0, cus = 0;
        if (hipGetDevice(&dev) != hipSuccess || hipDeviceGetAttribute(&cus, hipDeviceAttributeMultiprocessorCount, dev) != hipSuccess) { fprintf(stderr, "kernel_launch: device query failed\n"); g_grid = -1; return; }
        if (hipFuncSetAttribute((const void*)fk::fwd, hipFuncAttributeMaxDynamicSharedMemorySize, fk::LDS_BYTES) != hipSuccess) { fprintf(stderr, "kernel_launch: hipFuncSetAttribute failed\n"); g_grid = -1; return; }
        int per_cu = 0;
        if (hipOccupancyMaxActiveBlocksPerMultiprocessor(&per_cu, (const void*)fk::fwd, 512, fk::LDS_BYTES) != hipSuccess || per_cu < 1) fprintf(stderr, "kernel_launch: occupancy query says %d\n", per_cu);
        (void)hipGetLastError();
        g_grid = cus;
    }
    if (g_grid < 0) return;
    fk::Args a{};
    for (int i = 0; i < 20; ++i) a.in[i] = (const float*)d_in[i];
    a.out = d_out; a.xin = xin; a.ws = (unsigned char*)d_ws; a.rep2 = 2;
    (void)hipMemsetAsync((char*)d_ws + fk::WS_CTL, 0, fk::CTL_ZERO_BYTES, stream);
    if (per_phase) {
        for (int p = lo; p < hi; ++p) { a.ph_lo = p; a.ph_hi = p + 1; hipLaunchKernelGGL(fk::fwd, dim3(g_grid), dim3(512), fk::LDS_BYTES, stream, a); }
    } else {
        a.ph_lo = lo; a.ph_hi = hi;
        hipLaunchKernelGGL(fk::fwd, dim3(g_grid), dim3(512), fk::LDS_BYTES, stream, a);
    }
    const hipError_t le = hipPeekAtLastError();
    if (le != hipSuccess) fprintf(stderr, "kernel_launch: launch failed: %s\n", hipGetErrorName(le));
}


extern "C" void kernel_launch(void* const* d_in, const int* in_sizes, int n_in, void* d_out, int out_size, void* d_ws, size_t ws_size, hipStream_t stream) {
    if (n_in != 20 || out_size != fk::T * fk::D || ws_size < fk::WS_END) { fprintf(stderr, "kernel_launch: unexpected shapes n_in %d out %d ws %zu\n", n_in, out_size, ws_size); return; }
    float* X = (float*)d_out; unsigned char* ws = (unsigned char*)d_ws;
    const size_t N = (size_t)fk::T * fk::D;
#if DBG_STAGE == 0
    fast_launch(d_in, X, X, d_ws, stream, fk::PH_PROLOGUE, fk::PH_END_S4, HYB_PER_PHASE);
#else
    float* TMP = (float*)(ws + 800 * fk::MiB); unsigned short* FB = (unsigned short*)(ws + 928 * fk::MiB); double* ACC = (double*)(ws + 1000 * fk::MiB);
    (void)hipMemsetAsync(ACC, 0, 64, stream);
#if DBG_STAGE == 1
    fast_launch(d_in, X, TMP, d_ws, stream, fk::PH_PROLOGUE, fk::PH_END_S1, HYB_PER_PHASE);
    hipLaunchKernelGGL(dbg::k_store, dim3(4096), dim3(256), 0, stream, (const float*)TMP, (const float*)d_in[0], FB, N);
    slow::stage1(d_in, X, ws, stream);
    hipLaunchKernelGGL(dbg::k_cmp, dim3(4096), dim3(256), 0, stream, (const unsigned short*)FB, (const float*)X, (const float*)d_in[0], 0, ACC, N);
    slow::stage_moe(d_in, X, ws, stream, 0);
    slow::stage3(d_in, X, ws, stream);
    slow::stage_moe(d_in, X, ws, stream, 1);
#elif DBG_STAGE == 2
    slow::stage1(d_in, X, ws, stream);
    fast_launch(d_in, X, TMP, d_ws, stream, fk::PH_PROLOGUE, fk::PH_PROLOGUE + 1, HYB_PER_PHASE);
    fast_launch(d_in, X, TMP, d_ws, stream, fk::PH_M0_ROUTE, fk::PH_END_S2, HYB_PER_PHASE);
    hipLaunchKernelGGL(dbg::k_store, dim3(4096), dim3(256), 0, stream, (const float*)TMP, (const float*)X, FB, N);
    slow::stage_moe(d_in, X, ws, stream, 0);
    hipLaunchKernelGGL(dbg::k_cmp, dim3(4096), dim3(256), 0, stream, (const unsigned short*)FB, (const float*)(ws + 672 * fk::MiB), (const float*)nullptr, 1, ACC, N);
    slow::stage3(d_in, X, ws, stream);
    slow::stage_moe(d_in, X, ws, stream, 1);
#elif DBG_STAGE == 3
    slow::stage1(d_in, X, ws, stream);
    slow::stage_moe(d_in, X, ws, stream, 0);
    fast_launch(d_in, X, TMP, d_ws, stream, fk::PH_PROLOGUE, fk::PH_PROLOGUE + 1, HYB_PER_PHASE);
    fast_launch(d_in, X, TMP, d_ws, stream, fk::PH_A_NORM, fk::PH_END_S3, HYB_PER_PHASE);
    hipLaunchKernelGGL(dbg::k_store, dim3(4096), dim3(256), 0, stream, (const float*)TMP, (const float*)X, FB, N);
    slow::stage3(d_in, X, ws, stream, (const int*)(ws + fk::WS_SELX), (float*)(ws + 672 * fk::MiB));
    hipLaunchKernelGGL(dbg::k_cmp, dim3(4096), dim3(256), 0, stream, (const unsigned short*)FB, (const float*)(ws + 672 * fk::MiB), (const float*)nullptr, 2, ACC, N);
    slow::stage_moe(d_in, X, ws, stream, 1);
#endif
    hipLaunchKernelGGL(dbg::k_scale, dim3(4096), dim3(256), 0, stream, X, (const double*)ACC, N);
#endif
}
```

```cpp
#include <hip/hip_runtime.h>
#include <cstdio>
#include <cstdint>
#include <cmath>
#ifndef HYB_PER_PHASE
#define HYB_PER_PHASE false
#endif
#ifndef DBG_STAGE
#define DBG_STAGE 0
#endif
namespace slow {
constexpr int B = 4, L = 8192, D = 1024, T = B * L, NH = 8, HD = 128, NEXP = 32, FF = 512, NBLK = 32, BLK = 256;
constexpr int CAP = T * 2 + NEXP * 256;
constexpr float EPS = 1e-6f;

__device__ __forceinline__ float wsum(float v) {
#pragma unroll
    for (int o = 1; o < 64; o <<= 1) v += __shfl_xor(v, o);
    return v;
}
__device__ __forceinline__ float wmax(float v) {
#pragma unroll
    for (int o = 1; o < 64; o <<= 1) v = fmaxf(v, __shfl_xor(v, o));
    return v;
}
__device__ __forceinline__ int t5_bucket(int n) {
    if (n < 16) return n;
    const float lr = logf((float)n / 16.0f) / 4.1588830833596715f;
    int large = 16 + (int)(lr * 16.0f);
    return large < 31 ? large : 31;
}
__global__ void k_prep(const float* __restrict__ hg_lb, const float* __restrict__ rel_bias, float* lb, float* bias_tab) {
    const int i = blockIdx.x * blockDim.x + threadIdx.x;
    if (i < 1024) { const float a = hg_lb[i], b = hg_lb[1024 + i], m = fmaxf(a, b), ea = expf(a - m), eb = expf(b - m); lb[i] = ea / (ea + eb); }
    if (i < 8 * 1024) { const int h = i >> 10, d = i & 1023; bias_tab[i] = rel_bias[t5_bucket(d) * 8 + h]; }
}
template <int N> __global__ void k_rmsnorm(const float* __restrict__ x, const float* __restrict__ w, float* __restrict__ y, int rows) {
    const int row = blockIdx.x * (blockDim.x >> 6) + (threadIdx.x >> 6), lane = threadIdx.x & 63;
    if (row >= rows) return;
    const float* xr = x + (size_t)row * N; float* yr = y + (size_t)row * N;
    float s = 0.f;
    for (int i = lane; i < N; i += 64) { const float v = xr[i]; s += v * v; }
    s = wsum(s);
    const float r = rsqrtf(s * (1.0f / N) + EPS);
    for (int i = lane; i < N; i += 64) yr[i] = xr[i] * r * w[i];
}
__global__ void k_headnorm(const float* __restrict__ x, int ld, int col0, const float* __restrict__ w, float* __restrict__ y, int ldy) {
    const int gw = blockIdx.x * (blockDim.x >> 6) + (threadIdx.x >> 6), lane = threadIdx.x & 63;
    if (gw >= T * NH) return;
    const int t = gw >> 3, h = gw & 7;
    const float* xr = x + (size_t)t * ld + col0 + h * HD;
    const float a = xr[lane], b = xr[lane + 64];
    const float s = wsum(a * a + b * b);
    const float r = rsqrtf(s * (1.0f / HD) + EPS);
    float* yr = y + (size_t)t * ldy + h * HD;
    yr[lane] = a * r * w[lane]; yr[lane + 64] = b * r * w[lane + 64];
}
struct GemmP {
    const float* A; int lda; const int* arow;
    const float* W; int ldw; size_t wstride; const int* tile_e;
    float* C; int ldc; const int* crow; const float* cscale; const float* R;
    int M, N, K, pad;
};
__global__ __launch_bounds__(256) void k_gemm(GemmP p) {
    __shared__ float As[16][68];
    __shared__ float Ws[16][68];
    const int tm = blockIdx.y, tn = blockIdx.x, tid = threadIdx.x;
    int e = 0;
    if (p.tile_e) { e = p.tile_e[tm]; if (e < 0) return; }
    const float* W = p.W + (size_t)e * p.wstride;
    const int ar = tid >> 2, ak = (tid & 3) * 4;
    const int wk = tid >> 4, wn = (tid & 15) * 4;
    const int m0 = tm * 64, n0 = tn * 64;
    int arow = m0 + ar; if (p.arow) { arow = p.arow[m0 + ar]; if (arow < 0) arow = 0; }
    const float* Ap = p.A + (size_t)arow * p.lda + ak;
    const float* Wp = W + (size_t)wk * p.ldw + n0 + wn;
    const int ty = tid >> 4, tx = tid & 15;
    float acc[4][4];
#pragma unroll
    for (int i = 0; i < 4; ++i)
#pragma unroll
        for (int j = 0; j < 4; ++j) acc[i][j] = 0.f;
    for (int k0 = 0; k0 < p.K; k0 += 16) {
        const float4 av = *(const float4*)(Ap + k0);
        const float4 wv = *(const float4*)(Wp + (size_t)k0 * p.ldw);
        __syncthreads();
        As[ak + 0][ar] = av.x; As[ak + 1][ar] = av.y; As[ak + 2][ar] = av.z; As[ak + 3][ar] = av.w;
        *(float4*)&Ws[wk][wn] = wv;
        __syncthreads();
#pragma unroll
        for (int kk = 0; kk < 16; ++kk) {
            const float4 a = *(const float4*)&As[kk][ty * 4];
            const float4 b = *(const float4*)&Ws[kk][tx * 4];
            const float aa[4] = {a.x, a.y, a.z, a.w}, bb[4] = {b.x, b.y, b.z, b.w};
#pragma unroll
            for (int i = 0; i < 4; ++i)
#pragma unroll
                for (int j = 0; j < 4; ++j) acc[i][j] += aa[i] * bb[j];
        }
    }
#pragma unroll
    for (int i = 0; i < 4; ++i) {
        const int m = m0 + ty * 4 + i;
        int cr = m; float sc = 1.f;
        if (p.crow) { cr = p.crow[m]; if (cr < 0) continue; }
        if (p.cscale) sc = p.cscale[cr];
        float* Cp = p.C + (size_t)cr * p.ldc + n0 + tx * 4;
        float4 o = make_float4(acc[i][0] * sc, acc[i][1] * sc, acc[i][2] * sc, acc[i][3] * sc);
        if (p.R) { const float4 r = *(const float4*)(p.R + (size_t)cr * p.ldc + n0 + tx * 4); o.x += r.x; o.y += r.y; o.z += r.z; o.w += r.w; }
        *(float4*)Cp = o;
    }
}
__global__ void k_hg_gates(float* proj, const float* __restrict__ lb) {
    const size_t i = (size_t)blockIdx.x * blockDim.x + threadIdx.x;
    if (i >= (size_t)T * 1024) return;
    const size_t t = i >> 10; const int c = (int)(i & 1023);
    float* row = proj + t * 4096;
    row[c] *= 0.08838834764831845f;
    const float l = lb[c], z = row[1024 + c];
    row[1024 + c] = l + (1.f - l) * (1.f / (1.f + expf(-z)));
}
__global__ __launch_bounds__(128) void k_gla(const float* __restrict__ proj, float* __restrict__ o) {
    const int bh = blockIdx.x, b = bh >> 3, h = bh & 7, dv = threadIdx.x;
    float S[128];
#pragma unroll
    for (int d = 0; d < 128; ++d) S[d] = 0.f;
    const float* base = proj + (size_t)b * L * 4096 + h * 128;
    for (int t = 0; t < L; ++t) {
        const float* row = base + (size_t)t * 4096;
        const float v = row[2048 + dv];
        float acc = 0.f;
#pragma unroll
        for (int d = 0; d < 128; ++d) { const float f = row[1024 + d], q = row[d]; S[d] = f * S[d] + (1.f - f) * v; acc += q * S[d]; }
        o[((size_t)b * L + t) * 1024 + h * 128 + dv] = acc;
    }
}
__global__ void k_onorm_gate(const float* __restrict__ o, const float* __restrict__ proj, const float* __restrict__ w, float* __restrict__ og) {
    const int gw = blockIdx.x * (blockDim.x >> 6) + (threadIdx.x >> 6), lane = threadIdx.x & 63;
    if (gw >= T * NH) return;
    const int t = gw >> 3, h = gw & 7;
    const float* xr = o + (size_t)t * 1024 + h * HD;
    const float a = xr[lane], b = xr[lane + 64];
    const float r = rsqrtf(wsum(a * a + b * b) * (1.0f / HD) + EPS);
    const float* g = proj + (size_t)t * 4096 + 3072 + h * HD;
    const float g0 = g[lane], g1 = g[lane + 64];
    float* yr = og + (size_t)t * 1024 + h * HD;
    yr[lane] = a * r * w[lane] * (g0 / (1.f + expf(-g0)));
    yr[lane + 64] = b * r * w[lane + 64] * (g1 / (1.f + expf(-g1)));
}
__global__ void k_route(const float* __restrict__ h2, const float* __restrict__ wg, const float* __restrict__ bg, const float* __restrict__ we, const float* __restrict__ be,
                        int* cnt, int* list, float* wgt) {
    const int t = blockIdx.x * (blockDim.x >> 6) + (threadIdx.x >> 6), lane = threadIdx.x & 63;
    if (t >= T) return;
    const float* xr = h2 + (size_t)t * D;
    float acc = 0.f;
    const bool isg = lane < 4, ise = lane >= 32;
    for (int k = 0; k < D; ++k) {
        const float xv = xr[k];
        float w = 0.f;
        if (isg) w = wg[k * 4 + lane]; else if (ise) w = we[k * 32 + (lane - 32)];
        acc += xv * w;
    }
    if (isg) acc += bg[lane]; else if (ise) acc += be[lane - 32];
    float gl[4];
#pragma unroll
    for (int i = 0; i < 4; ++i) gl[i] = __shfl(acc, i);
    int gi = 0; float gm = gl[0];
#pragma unroll
    for (int i = 1; i < 4; ++i) if (gl[i] > gm) { gm = gl[i]; gi = i; }
    float gs = 0.f;
#pragma unroll
    for (int i = 0; i < 4; ++i) gs += expf(gl[i] - gm);
    const float gw_ = 1.0f / gs;
    float el[8];
#pragma unroll
    for (int i = 0; i < 8; ++i) el[i] = __shfl(acc, 32 + gi * 8 + i);
    int i0 = 0; float m0 = el[0];
#pragma unroll
    for (int i = 1; i < 8; ++i) if (el[i] > m0) { m0 = el[i]; i0 = i; }
    int i1 = -1; float m1 = -INFINITY;
#pragma unroll
    for (int i = 0; i < 8; ++i) if (i != i0 && el[i] > m1) { m1 = el[i]; i1 = i; }
    const float p1 = expf(m1 - m0);
    const float w0 = gw_ / (1.f + p1), w1 = gw_ * p1 / (1.f + p1);
    if (lane == 0) {
        const int e0 = gi * 8 + i0, e1 = gi * 8 + i1;
        const int r0 = atomicAdd(&cnt[e0], 1); list[(size_t)e0 * (2 * T) + r0] = t * 2;     wgt[t * 2] = w0;
        const int r1 = atomicAdd(&cnt[e1], 1); list[(size_t)e1 * (2 * T) + r1] = t * 2 + 1; wgt[t * 2 + 1] = w1;
    }
}
__global__ void k_moe_rows(const int* __restrict__ cnt, const int* __restrict__ list, int* row_src, int* row_dst, int* tile_e) {
    const int r = blockIdx.x * blockDim.x + threadIdx.x;
    if (r >= CAP) return;
    int start = 0, e = -1, rank = 0;
    for (int i = 0; i < NEXP; ++i) { const int c = cnt[i], pc = (c + 255) & ~255; if (r >= start && r < start + pc) { e = i; rank = r - start; } start += pc; }
    int src = -1, dst = -1;
    if (e >= 0 && rank < cnt[e]) { dst = list[(size_t)e * (2 * T) + rank]; src = dst >> 1; }
    row_src[r] = src; row_dst[r] = dst;
    if ((r & 63) == 0) tile_e[r >> 6] = e;
}
__global__ void k_silu_mul(const float* __restrict__ hu, float* __restrict__ act) {
    const size_t i = (size_t)blockIdx.x * blockDim.x + threadIdx.x;
    if (i >= (size_t)CAP * FF) return;
    const size_t r = i / FF; const int c = (int)(i % FF);
    const float a = hu[r * 1024 + c], b = hu[r * 1024 + 512 + c];
    act[i] = a / (1.f + expf(-a)) * b;
}
__global__ void k_combine(float* x, const float* __restrict__ ybuf) {
    const size_t i = (size_t)blockIdx.x * blockDim.x + threadIdx.x;
    if (i >= (size_t)T * D) return;
    const size_t t = i >> 10; const int c = (int)(i & 1023);
    x[i] += ybuf[(t * 2) * D + c] + ybuf[(t * 2 + 1) * D + c];
}
__global__ void k_kv_split(const float* __restrict__ kv, const float* __restrict__ knw, float* __restrict__ K, float* __restrict__ V) {
    const int gw = blockIdx.x * (blockDim.x >> 6) + (threadIdx.x >> 6), lane = threadIdx.x & 63;
    if (gw >= T * NH) return;
    const int t = gw >> 3, h = gw & 7, b = t / L, pos = t % L;
    const float* kr = kv + (size_t)t * 2048 + h * HD;
    const float a = kr[lane], c = kr[lane + 64];
    const float r = rsqrtf(wsum(a * a + c * c) * (1.0f / HD) + EPS);
    const size_t o = (((size_t)b * NH + h) * L + pos) * HD;
    K[o + lane] = a * r * knw[lane]; K[o + lane + 64] = c * r * knw[lane + 64];
    V[o + lane] = kr[1024 + lane]; V[o + lane + 64] = kr[1024 + lane + 64];
}
__global__ void k_kmean(const float* __restrict__ K, float* __restrict__ km) {
    const int bhn = blockIdx.x, d = threadIdx.x;
    const float* p = K + (size_t)bhn * BLK * HD + d;
    float s = 0.f;
    for (int j = 0; j < BLK; ++j) s += p[(size_t)j * HD];
    km[(size_t)bhn * HD + d] = s * (1.0f / BLK);
}
__global__ __launch_bounds__(256) void k_moba(const float* __restrict__ q, const float* __restrict__ K, const float* __restrict__ V, const float* __restrict__ km,
                                              const float* __restrict__ bias_tab, float* __restrict__ att, int* __restrict__ sel_out, const int* __restrict__ sel_in) {
    __shared__ float qs[128];
    __shared__ float gate[32];
    __shared__ int selb[4];
    __shared__ float lg[4][256];
    __shared__ float red[8];
    __shared__ float osum[128];
    const int bid = blockIdx.x, t = bid >> 3, h = bid & 7, b = t / L, pos = t % L, blk = pos >> 8, tid = threadIdx.x, lane = tid & 63, wv = tid >> 6;
    if (tid < 128) qs[tid] = q[(size_t)t * 1024 + h * HD + tid];
    __syncthreads();
    const size_t bh = (size_t)b * NH + h;
    if (tid < 32) {
        float g = -INFINITY;
        if (tid < blk) { const float* kp = km + (bh * NBLK + tid) * HD; float s = 0.f; for (int d = 0; d < HD; ++d) s += qs[d] * kp[d]; g = s; }
        gate[tid] = g;
    }
    __syncthreads();
    const int nsel = blk < 3 ? blk : 3;
    if (tid == 0 && sel_in) { selb[0] = sel_in[(size_t)bid * 3 + 0]; selb[1] = sel_in[(size_t)bid * 3 + 1]; selb[2] = sel_in[(size_t)bid * 3 + 2]; selb[3] = blk; }
    if (tid == 0 && !sel_in) {
        int u0 = -1, u1 = -1;
        for (int s = 0; s < 3; ++s) {
            int bi = -1; float bv = -INFINITY;
            for (int n = 0; n < blk; ++n) { if (n == u0 || n == u1) continue; if (bi < 0 || gate[n] > bv) { bv = gate[n]; bi = n; } }
            selb[s] = bi; if (s == 0) u0 = bi; else if (s == 1) u1 = bi;
        }
        selb[3] = blk;
        if (sel_out) { sel_out[(size_t)bid * 3 + 0] = selb[0]; sel_out[(size_t)bid * 3 + 1] = selb[1]; sel_out[(size_t)bid * 3 + 2] = selb[2]; }
    }
    __syncthreads();
    const float scale = 0.08838834764831845f;
    float mx = -INFINITY;
    for (int s = 0; s < 4; ++s) {
        float l = -INFINITY;
        const bool on = (s == 3) || (s < nsel);
        if (on) {
            const int kb = selb[s], kpos = kb * BLK + tid, dist = pos - kpos;
            if (dist >= 0) {
                const float* kp = K + (bh * L + kpos) * HD; float a = 0.f;
                for (int d = 0; d < HD; ++d) a += qs[d] * kp[d];
                l = a * scale + bias_tab[h * 1024 + (dist < 1023 ? dist : 1023)];
            }
        }
        lg[s][tid] = l; mx = fmaxf(mx, l);
    }
    mx = wmax(mx); if (lane == 0) red[wv] = mx; __syncthreads();
    mx = fmaxf(fmaxf(red[0], red[1]), fmaxf(red[2], red[3])); __syncthreads();
    float sm = 0.f;
    for (int s = 0; s < 4; ++s) { const float l = lg[s][tid]; const float p = (l == -INFINITY) ? 0.f : expf(l - mx); lg[s][tid] = p; sm += p; }
    sm = wsum(sm); if (lane == 0) red[4 + wv] = sm; __syncthreads();
    sm = red[4] + red[5] + red[6] + red[7];
    const int d = tid & 127, half = tid >> 7;
    float o = 0.f;
    for (int s = 0; s < 4; ++s) {
        const bool on = (s == 3) || (s < nsel);
        if (!on) continue;
        const float* vp = V + (bh * L + (size_t)selb[s] * BLK + half * 128) * HD + d;
        for (int j = 0; j < 128; ++j) o += lg[s][half * 128 + j] * vp[(size_t)j * HD];
    }
    if (half == 1) osum[d] = o;
    __syncthreads();
    if (half == 0) att[(size_t)t * 1024 + h * HD + d] = (o + osum[d]) / sm;
}

struct Bufs {
    float *lb, *bias_tab, *wgt, *km; int *cnt, *list, *row_src, *row_dst, *tile_e, *sel;
    float *HN, *BIG, *O;
};
constexpr size_t MiB = 1u << 20;
static void launch_gemm(hipStream_t s, GemmP p) { dim3 g(p.N / 64, p.M / 64); hipLaunchKernelGGL(k_gemm, g, dim3(256), 0, s, p); }

static void moe_layer(hipStream_t s, const Bufs& bf, float* X, int layer, void* const* d_in) {
    const float* ffn_norm = (const float*)d_in[2] + layer * D;
    const float* wg = (const float*)d_in[14] + (size_t)layer * D * 4;  const float* bg = (const float*)d_in[15] + layer * 4;
    const float* we = (const float*)d_in[16] + (size_t)layer * D * 32; const float* be = (const float*)d_in[17] + layer * 32;
    const float* win = (const float*)d_in[18] + (size_t)layer * NEXP * D * 1024;
    const float* wout = (const float*)d_in[19] + (size_t)layer * NEXP * FF * D;
    float* HU = bf.BIG;
    float* ACT = bf.BIG + (size_t)CAP * 1024;
    float* YB = bf.O;
    hipLaunchKernelGGL(k_rmsnorm<1024>, dim3(T / 4), dim3(256), 0, s, X, ffn_norm, bf.HN, T);
    (void)hipMemsetAsync(bf.cnt, 0, 32 * sizeof(int), s);
    hipLaunchKernelGGL(k_route, dim3(T / 4), dim3(256), 0, s, bf.HN, wg, bg, we, be, bf.cnt, bf.list, bf.wgt);
    hipLaunchKernelGGL(k_moe_rows, dim3((CAP + 255) / 256), dim3(256), 0, s, bf.cnt, bf.list, bf.row_src, bf.row_dst, bf.tile_e);
    GemmP p1{}; p1.A = bf.HN; p1.lda = D; p1.arow = bf.row_src; p1.W = win; p1.ldw = 1024; p1.wstride = (size_t)D * 1024; p1.tile_e = bf.tile_e;
    p1.C = HU; p1.ldc = 1024; p1.M = CAP; p1.N = 1024; p1.K = D; launch_gemm(s, p1);
    hipLaunchKernelGGL(k_silu_mul, dim3((unsigned)(((size_t)CAP * FF + 255) / 256)), dim3(256), 0, s, HU, ACT);
    GemmP p2{}; p2.A = ACT; p2.lda = FF; p2.W = wout; p2.ldw = D; p2.wstride = (size_t)FF * D; p2.tile_e = bf.tile_e;
    p2.C = YB; p2.ldc = D; p2.crow = bf.row_dst; p2.cscale = bf.wgt; p2.M = CAP; p2.N = D; p2.K = FF; launch_gemm(s, p2);
    hipLaunchKernelGGL(k_combine, dim3((unsigned)(((size_t)T * D + 255) / 256)), dim3(256), 0, s, X, YB);
}

static Bufs make_bufs(unsigned char* ws) {
    Bufs bf;
    bf.cnt = (int*)(ws + 0); bf.lb = (float*)(ws + 4096); bf.bias_tab = (float*)(ws + 8192);
    bf.wgt = (float*)(ws + 1 * MiB); bf.km = (float*)(ws + 2 * MiB);
    bf.row_src = (int*)(ws + 3 * MiB); bf.row_dst = (int*)(ws + 4 * MiB); bf.tile_e = (int*)(ws + 5 * MiB);
    bf.sel = (int*)(ws + 6 * MiB);
    bf.list = (int*)(ws + 16 * MiB);
    bf.HN = (float*)(ws + 32 * MiB);
    bf.BIG = (float*)(ws + 160 * MiB);
    bf.O = (float*)(ws + 672 * MiB);
    return bf;
}
static void stage1(void* const* d_in, float* X, unsigned char* ws, hipStream_t s) {
    Bufs bf = make_bufs(ws);
    const float* x = (const float*)d_in[0]; const float* mix_norm = (const float*)d_in[1];
    const float* hg_w_in = (const float*)d_in[3]; const float* hg_lb = (const float*)d_in[4]; const float* hg_o_norm = (const float*)d_in[5]; const float* hg_w_out = (const float*)d_in[6];
    hipLaunchKernelGGL(k_prep, dim3(32), dim3(256), 0, s, hg_lb, (const float*)d_in[13], bf.lb, bf.bias_tab);
    hipLaunchKernelGGL(k_rmsnorm<1024>, dim3(T / 4), dim3(256), 0, s, x, mix_norm, bf.HN, T);
    float* PROJ = bf.BIG;
    { GemmP p{}; p.A = bf.HN; p.lda = D; p.W = hg_w_in; p.ldw = 4096; p.C = PROJ; p.ldc = 4096; p.M = T; p.N = 4096; p.K = D; launch_gemm(s, p); }
    hipLaunchKernelGGL(k_hg_gates, dim3((unsigned)(((size_t)T * 1024 + 255) / 256)), dim3(256), 0, s, PROJ, bf.lb);
    hipLaunchKernelGGL(k_gla, dim3(B * NH), dim3(128), 0, s, PROJ, bf.O);
    hipLaunchKernelGGL(k_onorm_gate, dim3(T * NH / 4), dim3(256), 0, s, bf.O, PROJ, hg_o_norm, bf.HN);
    { GemmP p{}; p.A = bf.HN; p.lda = D; p.W = hg_w_out; p.ldw = D; p.C = X; p.ldc = D; p.R = x; p.M = T; p.N = D; p.K = D; launch_gemm(s, p); }
}
static void stage_moe(void* const* d_in, float* X, unsigned char* ws, hipStream_t s, int layer) { Bufs bf = make_bufs(ws); moe_layer(s, bf, X, layer, d_in); }
__global__ void k_add(float* x, const float* __restrict__ y, size_t n) { for (size_t i = (size_t)blockIdx.x * blockDim.x + threadIdx.x; i < n; i += (size_t)gridDim.x * blockDim.x) x[i] += y[i]; }
static void stage3(void* const* d_in, float* X, unsigned char* ws, hipStream_t s, const int* sel_in = nullptr, float* branch_out = nullptr) {
    Bufs bf = make_bufs(ws);
    const float* mix_norm = (const float*)d_in[1];
    const float* kv_norm = (const float*)d_in[7]; const float* w_kv = (const float*)d_in[8]; const float* k_norm = (const float*)d_in[9];
    const float* att_w_q = (const float*)d_in[10]; const float* q_norm = (const float*)d_in[11]; const float* att_w_o = (const float*)d_in[12]; const float* rel_bias = (const float*)d_in[13];
    hipLaunchKernelGGL(k_prep, dim3(32), dim3(256), 0, s, (const float*)d_in[4], rel_bias, bf.lb, bf.bias_tab);
    hipLaunchKernelGGL(k_rmsnorm<1024>, dim3(T / 4), dim3(256), 0, s, X, kv_norm, bf.HN, T);
    float* KV = bf.BIG; float* Kb = bf.BIG + (size_t)T * 2048; float* Vb = Kb + (size_t)T * 1024;
    { GemmP p{}; p.A = bf.HN; p.lda = D; p.W = w_kv; p.ldw = 2048; p.C = KV; p.ldc = 2048; p.M = T; p.N = 2048; p.K = D; launch_gemm(s, p); }
    hipLaunchKernelGGL(k_kv_split, dim3(T * NH / 4), dim3(256), 0, s, KV, k_norm, Kb, Vb);
    hipLaunchKernelGGL(k_kmean, dim3(B * NH * NBLK), dim3(128), 0, s, Kb, bf.km);
    hipLaunchKernelGGL(k_rmsnorm<1024>, dim3(T / 4), dim3(256), 0, s, X, mix_norm + D, bf.HN, T);
    float* Q = bf.BIG; float* ATT = bf.BIG + (size_t)T * 1024;
    { GemmP p{}; p.A = bf.HN; p.lda = D; p.W = att_w_q; p.ldw = D; p.C = Q; p.ldc = D; p.M = T; p.N = D; p.K = D; launch_gemm(s, p); }
    hipLaunchKernelGGL(k_headnorm, dim3(T * NH / 4), dim3(256), 0, s, Q, D, 0, q_norm, Q, D);
    hipLaunchKernelGGL(k_moba, dim3(T * NH), dim3(256), 0, s, Q, Kb, Vb, bf.km, bf.bias_tab, ATT, bf.sel, sel_in);
    if (branch_out) { GemmP p{}; p.A = ATT; p.lda = D; p.W = att_w_o; p.ldw = D; p.C = branch_out; p.ldc = D; p.M = T; p.N = D; p.K = D; launch_gemm(s, p);
        hipLaunchKernelGGL(k_add, dim3(4096), dim3(256), 0, s, X, (const float*)branch_out, (size_t)T * D); }
    else { GemmP p{}; p.A = ATT; p.lda = D; p.W = att_w_o; p.ldw = D; p.C = X; p.ldc = D; p.R = X; p.M = T; p.N = D; p.K = D; launch_gemm(s, p); }
}
}
namespace dbg {
__device__ __forceinline__ unsigned f2bf(float f) { unsigned u = __builtin_bit_cast(unsigned, f); return (u + 0x7fffu + ((u >> 16) & 1u)) >> 16; }
__global__ void k_store(const float* __restrict__ a, const float* __restrict__ b, unsigned short* __restrict__ out, size_t n) {
    for (size_t i = (size_t)blockIdx.x * blockDim.x + threadIdx.x; i < n; i += (size_t)gridDim.x * blockDim.x) out[i] = (unsigned short)f2bf(a[i] - b[i]);
}
__global__ void k_cmp(const unsigned short* __restrict__ fb, const float* __restrict__ s1, const float* __restrict__ s2, int mode, double* acc, size_t n) {
    double num = 0.0, den = 0.0;
    for (size_t i = (size_t)blockIdx.x * blockDim.x + threadIdx.x; i < n; i += (size_t)gridDim.x * blockDim.x) {
        float sl;
        if (mode == 0) sl = s1[i] - s2[i];
        else if (mode == 1) { const size_t t = i >> 10, c = i & 1023; sl = s1[(2 * t) * 1024 + c] + s1[(2 * t + 1) * 1024 + c]; }
        else sl = s1[i];
        const float f = __builtin_bit_cast(float, (unsigned)fb[i] << 16);
        const double d = (double)f - (double)sl; num += d * d; den += (double)sl * (double)sl;
    }
    for (int o = 32; o >= 1; o >>= 1) { num += __shfl_xor(num, o); den += __shfl_xor(den, o); }
    if ((threadIdx.x & 63) == 0) { atomicAdd(acc, num); atomicAdd(acc + 1, den); }
}
__global__ void k_scale(float* out, const double* acc, size_t n) {
    const float f = 1.0f + (float)sqrt(acc[0] / acc[1]);
    for (size_t i = (size_t)blockIdx.x * blockDim.x + threadIdx.x; i < n; i += (size_t)gridDim.x * blockDim.x) out[i] *= f;
}
}
namespace fk {
constexpr int B = 4, L = 8192, D = 1024, T = B * L, NH = 8, HD = 128, NEXP = 32, FF = 512, NBLK = 32, BLK = 256;
constexpr float EPS = 1e-6f;
#define LAS __attribute__((address_space(3)))
#define GAS __attribute__((address_space(1)))
typedef unsigned short bf16_t;
typedef short bf16x8 __attribute__((ext_vector_type(8)));
typedef short bf16x4 __attribute__((ext_vector_type(4)));
typedef float f32x4 __attribute__((ext_vector_type(4)));
typedef float f32x2 __attribute__((ext_vector_type(2)));
typedef unsigned u32x4 __attribute__((ext_vector_type(4)));
typedef unsigned u32x2 __attribute__((ext_vector_type(2)));
#define LDS_WAIT() asm volatile("s_waitcnt lgkmcnt(0)" ::: "memory")
#define VM_WAIT() asm volatile("s_waitcnt vmcnt(0)" ::: "memory")
__device__ __forceinline__ unsigned f2bf(float f) { unsigned u = __builtin_bit_cast(unsigned, f); return (u + 0x7fffu + ((u >> 16) & 1u)) >> 16; }
typedef __bf16 hwbf2 __attribute__((ext_vector_type(2)));
__device__ __forceinline__ unsigned pk2(float lo, float hi) { hwbf2 v; v[0] = (__bf16)lo; v[1] = (__bf16)hi; return __builtin_bit_cast(unsigned, v); }
__device__ __forceinline__ float as_f(unsigned u) { return __builtin_bit_cast(float, u); }
__device__ __forceinline__ unsigned as_u(float f) { return __builtin_bit_cast(unsigned, f); }
__device__ __forceinline__ float bf_lo(unsigned u) { return __builtin_bit_cast(float, u << 16); }
__device__ __forceinline__ float bf_hi(unsigned u) { return __builtin_bit_cast(float, u & 0xffff0000u); }
__device__ __forceinline__ float wave_sum(float v) {
#pragma unroll
    for (int o = 1; o < 64; o <<= 1) v += __shfl_xor(v, o);
    return v;
}
__device__ __forceinline__ float sigmoidf_(float z) { return __builtin_amdgcn_rcpf(1.0f + __expf(-z)); }

#define XB_TMO      128
#define XB_XCNT(j)  (256  + 64 * (j))
#define XB_XSUB(j)  (1280 + 64 * (j))
#define XB_XGEN(j)  (2304 + 64 * (j))
#define XB_TOP      3328
#define XB_TOPGEN   3392
#define XCD_BAR_WORDS 3456
#define XB_SPIN_CAP (1u << 18)
__device__ __forceinline__ unsigned xb_ld(unsigned* p)              { return __hip_atomic_load(p, __ATOMIC_RELAXED, __HIP_MEMORY_SCOPE_AGENT); }
__device__ __forceinline__ unsigned xb_add(unsigned* p, unsigned v) { return __hip_atomic_fetch_add(p, v, __ATOMIC_RELAXED, __HIP_MEMORY_SCOPE_AGENT); }
__device__ __forceinline__ unsigned xb_xcc_id() { return (unsigned)__builtin_amdgcn_s_getreg((3 << 11) | 20) & 0xFu; }
#define XB_SPIN(cond, bar) do { unsigned _sp = 0; while (cond) { __builtin_amdgcn_s_sleep(1); \
    if ((++_sp & 255u) == 0u) { if (xb_ld(&(bar)[XB_TMO])) break; if (_sp > XB_SPIN_CAP) { atomicAdd(&(bar)[XB_TMO], 1u); break; } } } } while (0)
struct XcdBarrier { unsigned* bar; unsigned x; volatile LAS unsigned* st; };
__device__ __forceinline__ XcdBarrier xcd_barrier_post(unsigned* bar, volatile LAS unsigned* st) {
    XcdBarrier b; b.bar = bar; b.x = xb_xcc_id(); b.st = st;
    if (threadIdx.x == 0) (void)xb_add(&bar[XB_XCNT(b.x)], 1u);
    return b;
}
__device__ __forceinline__ void xcd_barrier_complete(unsigned* bar, unsigned x, unsigned& nloc, unsigned& nx) {
    const unsigned G = gridDim.x * gridDim.y * gridDim.z;
    unsigned sum, cnt, mine, sp = 0u;
    for (;;) {
        sum = 0u; cnt = 0u; mine = 0u;
#pragma unroll
        for (unsigned j = 0; j < 16; ++j) { const unsigned c = xb_ld(&bar[XB_XCNT(j)]); sum += c; cnt += (c > 0u) ? 1u : 0u; mine = (j == x) ? c : mine; }
        if (sum == G) break;
        __builtin_amdgcn_s_sleep(1);
        if ((++sp & 255u) == 0u) { if (xb_ld(&bar[XB_TMO])) break; if (sp > XB_SPIN_CAP) { atomicAdd(&bar[XB_TMO], 1u); break; } }
    }
    nloc = mine > 0u ? mine : 1u; nx = cnt > 0u ? cnt : 1u;
}
__device__ __forceinline__ void xcd_barrier(const XcdBarrier& b) {
    asm volatile("s_waitcnt vmcnt(0)" ::: "memory");
    __syncthreads();
    if (threadIdx.x == 0) {
        unsigned* bar = b.bar;
        __builtin_amdgcn_s_waitcnt(0);
        unsigned nloc = b.st[0], nx = b.st[1];
        if (nloc == 0u) { xcd_barrier_complete(bar, b.x, nloc, nx); b.st[0] = nloc; b.st[1] = nx; }
        const unsigned old = xb_add(&bar[XB_XSUB(b.x)], 1u);
        const unsigned gen = old / nloc;
        if (old + 1u == (gen + 1u) * nloc) {
            __builtin_amdgcn_fence(__ATOMIC_RELEASE, "agent");
            asm volatile("s_waitcnt vmcnt(0)" ::: "memory");
            const unsigned og = xb_add(&bar[XB_TOP], 1u);
            const unsigned tg = og / nx;
            if (og + 1u == (tg + 1u) * nx) xb_add(&bar[XB_TOPGEN], 1u);
            else XB_SPIN(xb_ld(&bar[XB_TOPGEN]) == tg, bar);
            __builtin_amdgcn_fence(__ATOMIC_ACQUIRE, "agent");
            xb_add(&bar[XB_XGEN(b.x)], 1u);
            asm volatile("s_waitcnt vmcnt(0)" ::: "memory");
        } else {
            XB_SPIN(xb_ld(&bar[XB_XGEN(b.x)]) == gen, bar);
            __builtin_amdgcn_fence(__ATOMIC_ACQUIRE, "agent");
            asm volatile("s_waitcnt vmcnt(0)" ::: "memory");
        }
    }
    __syncthreads();
}

constexpr int BM = 256, BK = 64, HALF = 128, HTB = HALF * BK * 2, STAGE_BYTES = 8 * HTB, NXCD = 8, WGM = 8;
__host__ __device__ __forceinline__ int lds_byte(int r, int c) { const int st = (r >> 4) * 2 + (c >> 5), rr = r & 15, cc = c & 31, ob = rr * 64 + cc * 2; return st * 1024 + (ob ^ (((ob >> 9) & 1) << 5)); }
__host__ __device__ __forceinline__ void stage_rc(int b, int& R, int& C) { const int st = b / 1024, sb = b % 1024, swz = sb ^ (((sb >> 9) & 1) << 5); R = (st >> 1) * 16 + swz / 64; C = (st & 1) * 32 + (swz % 64) / 2; }
__host__ __device__ __forceinline__ int perm32(int rho) { const int n = rho >> 4, i = rho & 15; return 8 * (i >> 2) + 4 * n + (i & 3); }
struct Unit { int pm, pn, e, aux; };
__device__ __forceinline__ unsigned cvt_pk_bf16(float lo, float hi) { return pk2(lo, hi); }

struct DenseOrder {
    static constexpr bool GATHER = false;
    const bf16_t* A; const bf16_t* Bt; int K;
    int nM, nN, nwg, G, c;
    __device__ void init(const bf16_t* A_, const bf16_t* Bt_, int M, int N, int K_, int G_, int c_) { A = A_; Bt = Bt_; K = K_; nM = M / BM; nN = N / BM; nwg = nM * nN; G = G_; c = c_; }
    __device__ bool next(int i, Unit& u) const {
        const long Lx = (long)i * G + c; if (Lx >= nwg) return false;
        int wgid = (int)Lx; { const int q = nwg / NXCD, r = nwg % NXCD, xcd = wgid % NXCD, off = wgid / NXCD; wgid = (xcd < r ? xcd * (q + 1) : r * (q + 1) + (xcd - r) * q) + off; }
        const int nig = WGM * nN, gid = wgid / nig, fm = gid * WGM, gsz = (nM - fm) < WGM ? (nM - fm) : WGM;
        u.pm = fm + ((wgid % nig) % gsz); u.pn = (wgid % nig) / gsz; u.e = 0; u.aux = 0; return true;
    }
    __device__ __forceinline__ const char* a_base(const Unit& u) const { return (const char*)A + (size_t)u.pm * 256 * K * 2; }
    __device__ __forceinline__ const char* b_base(const Unit& u) const { return (const char*)Bt + (size_t)u.pn * 256 * K * 2; }
    __device__ __forceinline__ void a_offs(const Unit&, const int (&)[2], const int (&)[2], unsigned (&)[2][2]) const {}
};

template <class Epi, class Sched>
__device__ __forceinline__ void gemm_phase(LAS unsigned char* lds, const Sched& S, const Epi& E) {
    const int tid = threadIdx.x, wid = __builtin_amdgcn_readfirstlane(tid >> 6), lane = tid & 63, wr = wid >> 2, wc = wid & 3, fr = lane & 15, fq = lane >> 4;
    const int K = S.K, nt = K / BK;
    unsigned voffA[2], voffB[2]; int RR[2], CC[2];
#pragma unroll
    for (int i = 0; i < 2; ++i) { int R, C; stage_rc(tid * 16 + i * 8192, R, C); const int Rb = Epi::PERM ? ((R & ~31) + perm32(R & 31)) : R; RR[i] = R; CC[i] = C;
        voffA[i] = (unsigned)(R * K + C) * 2u; voffB[i] = (unsigned)(Rb * K + C) * 2u; }
    const size_t kstep = (size_t)(BK * 2);
    const size_t hstep = (size_t)HALF * K * 2;
    const unsigned ldsw = (unsigned)wid * 1024u;
    const int aoff = lds_byte(wr * 64 + fr, fq * 8), boff = lds_byte(wc * 32 + fr, fq * 8);
#define PG8_SA(b, h) (((b) * 2 + (h)) * HTB)
#define PG8_SB(b, h) ((4 + (b) * 2 + (h)) * HTB)
#define PG8_STAGE(bufoff, gbase, voff) do { _Pragma("unroll") for (int _i = 0; _i < 2; ++_i) \
        __builtin_amdgcn_global_load_lds((const unsigned*)((const char*)(gbase) + (voff)[_i]), (LAS unsigned*)(lds + (bufoff) + ldsw + _i * 8192), 16, 0, 0); } while (0)
#define PG8_STAGE_A(bufoff, ap, h, go) do { if constexpr (Sched::GATHER) { PG8_STAGE(bufoff, ap, (go)[h]); } else { PG8_STAGE(bufoff, (ap) + (h) * hstep, voffA); } } while (0)
#define PG8_LDA(dst, b, h) do { _Pragma("unroll") for (int m = 0; m < 4; ++m) _Pragma("unroll") for (int k = 0; k < 2; ++k) dst[m][k] = *(const LAS bf16x8*)(lds + PG8_SA(b, h) + aoff + m * 2048 + k * 1024); } while (0)
#define PG8_LDB(dst, b, h) do { _Pragma("unroll") for (int n = 0; n < 2; ++n) _Pragma("unroll") for (int k = 0; k < 2; ++k) dst[n][k] = *(const LAS bf16x8*)(lds + PG8_SB(b, h) + boff + n * 2048 + k * 1024); } while (0)
#define PG8_MMA(ai, bj, At, Bt) do { __builtin_amdgcn_s_setprio(1); _Pragma("unroll") for (int m = 0; m < 4; ++m) _Pragma("unroll") for (int n = 0; n < 2; ++n) _Pragma("unroll") for (int k = 0; k < 2; ++k) \
        acc[ai][bj][m][n] = __builtin_amdgcn_mfma_f32_16x16x32_bf16(Bt[n][k], At[m][k], acc[ai][bj][m][n], 0, 0, 0); __builtin_amdgcn_s_setprio(0); } while (0)
#define PG8_WAIT_V(n) asm volatile("s_waitcnt vmcnt(" #n ")" ::: "memory")
#define PG8_WAIT_L(n) asm volatile("s_waitcnt lgkmcnt(" #n ")" ::: "memory")
#define PG8_BAR __builtin_amdgcn_s_barrier()
#define PG8_SCHED __builtin_amdgcn_sched_barrier(0)
    Unit cur, nxt; int ui = 0;
    if (!S.next(0, cur)) return;
    f32x4 acc[2][2][4][2];
#pragma unroll
    for (int a = 0; a < 2; ++a)
#pragma unroll
        for (int b = 0; b < 2; ++b)
#pragma unroll
            for (int m = 0; m < 4; ++m)
#pragma unroll
                for (int n = 0; n < 2; ++n) acc[a][b][m][n] = (f32x4){0.f, 0.f, 0.f, 0.f};
    bf16x8 At[4][2], B0[2][2], B1[2][2];
    const char* cA = S.a_base(cur); const char* cB = S.b_base(cur);
    unsigned ca[2][2] = {{0u, 0u}, {0u, 0u}}, na[2][2] = {{0u, 0u}, {0u, 0u}};
    if constexpr (Sched::GATHER) S.a_offs(cur, RR, CC, ca);
    PG8_STAGE(PG8_SB(0, 0), cB, voffB); PG8_STAGE(PG8_SB(0, 1), cB + hstep, voffB); PG8_STAGE_A(PG8_SA(0, 0), cA, 0, ca); PG8_STAGE_A(PG8_SA(0, 1), cA, 1, ca);
    if (wr == 1) PG8_BAR;
    PG8_WAIT_V(2); PG8_BAR;
    PG8_STAGE(PG8_SB(1, 0), cB + kstep, voffB); PG8_STAGE_A(PG8_SA(1, 0), cA + kstep, 0, ca); PG8_STAGE(PG8_SB(1, 1), cB + hstep + kstep, voffB);
    PG8_WAIT_V(6); PG8_BAR;
    for (;;) {
        const bool has_next = S.next(ui + 1, nxt);
        const char* nA = has_next ? S.a_base(nxt) : cA; const char* nB = has_next ? S.b_base(nxt) : cB;
        if constexpr (Sched::GATHER) { if (has_next) S.a_offs(nxt, RR, CC, na); else {
#pragma unroll
            for (int h = 0; h < 2; ++h)
#pragma unroll
                for (int i = 0; i < 2; ++i) na[h][i] = ca[h][i]; } }
        for (int t = 0; t < nt; t += 2) {
            const bool last = (t == nt - 2);
            const char* a1 = cA + (size_t)(t + 1) * kstep;
            const char* a2 = last ? nA : cA + (size_t)(t + 2) * kstep; const char* b2 = last ? nB : cB + (size_t)(t + 2) * kstep;
            const char* a3 = a2 + kstep; const char* b3 = b2 + kstep;
            unsigned o2[2][2];
#pragma unroll
            for (int h = 0; h < 2; ++h)
#pragma unroll
                for (int i = 0; i < 2; ++i) o2[h][i] = last ? na[h][i] : ca[h][i];
            PG8_LDB(B0, 0, 0); PG8_LDB(B1, 0, 1); PG8_SCHED; PG8_LDA(At, 0, 0); PG8_STAGE_A(PG8_SA(1, 1), a1, 1, ca);
            PG8_WAIT_V(8); PG8_WAIT_L(0); PG8_BAR; PG8_MMA(0, 0, At, B0); PG8_MMA(0, 1, At, B1); PG8_BAR; PG8_SCHED;
            PG8_LDA(At, 0, 1); PG8_STAGE(PG8_SB(0, 0), b2, voffB); PG8_STAGE(PG8_SB(0, 1), b2 + hstep, voffB); PG8_STAGE_A(PG8_SA(0, 0), a2, 0, o2);
            PG8_WAIT_V(8); PG8_WAIT_L(0); PG8_BAR; PG8_MMA(1, 0, At, B0); PG8_MMA(1, 1, At, B1); PG8_BAR; PG8_SCHED;
            PG8_LDB(B0, 1, 0); PG8_LDB(B1, 1, 1); PG8_SCHED; PG8_LDA(At, 1, 0); PG8_STAGE_A(PG8_SA(0, 1), a2, 1, o2);
            PG8_WAIT_V(8); PG8_WAIT_L(0); PG8_BAR; PG8_MMA(0, 0, At, B0); PG8_MMA(0, 1, At, B1); PG8_BAR; PG8_SCHED;
            PG8_LDA(At, 1, 1); PG8_STAGE(PG8_SB(1, 0), b3, voffB); PG8_STAGE(PG8_SB(1, 1), b3 + hstep, voffB); PG8_STAGE_A(PG8_SA(1, 0), a3, 0, o2);
            PG8_WAIT_V(8); PG8_WAIT_L(0); PG8_BAR; PG8_MMA(1, 0, At, B0); PG8_MMA(1, 1, At, B1); PG8_BAR; PG8_SCHED;
        }
        if (wr == 0) PG8_BAR;
        E(acc, cur, wr, wc, fr, fq);
        if (!has_next) break;
#pragma unroll
        for (int a = 0; a < 2; ++a)
#pragma unroll
            for (int b = 0; b < 2; ++b)
#pragma unroll
                for (int m = 0; m < 4; ++m)
#pragma unroll
                    for (int n = 0; n < 2; ++n) acc[a][b][m][n] = (f32x4){0.f, 0.f, 0.f, 0.f};
        cur = nxt; cA = nA; cB = nB; ++ui;
#pragma unroll
        for (int h = 0; h < 2; ++h)
#pragma unroll
            for (int i = 0; i < 2; ++i) ca[h][i] = na[h][i];
        if (wr == 1) PG8_BAR;
    }
    PG8_WAIT_V(0);
    PG8_BAR;
#undef PG8_SA
#undef PG8_SB
#undef PG8_STAGE
#undef PG8_STAGE_A
#undef PG8_LDA
#undef PG8_LDB
#undef PG8_MMA
#undef PG8_WAIT_V
#undef PG8_WAIT_L
#undef PG8_BAR
#undef PG8_SCHED
}
constexpr size_t MiB = 1u << 20;
constexpr size_t WS_CTL = 0, CTL_ZERO_BYTES = 256 * 1024;
constexpr size_t WS_SMALL = 1 * MiB;
constexpr size_t WS_DEC = 2 * MiB;
constexpr size_t WS_KM = 3 * MiB;
constexpr size_t WS_LIST = 520 * MiB;
constexpr size_t WS_WGT = 12 * MiB;
constexpr size_t WS_SELCNT = 13 * MiB;
constexpr size_t WS_SEL = 16 * MiB;
constexpr size_t WS_WIN = 40 * MiB, WS_WOUT = 48 * MiB, WS_WKVQ = 50 * MiB, WS_WO = 56 * MiB;
constexpr size_t WS_MWIN = 64 * MiB, WS_MWOUT = 192 * MiB;
constexpr size_t WS_XN = 256 * MiB;
constexpr size_t WS_Q = 320 * MiB, WS_LF = 384 * MiB, WS_V = 448 * MiB, WS_G = 512 * MiB;
constexpr size_t WS_STATE = 576 * MiB;
constexpr size_t WS_OG = 640 * MiB;
constexpr size_t WS_ACT = 320 * MiB;
constexpr size_t WS_YB = 392 * MiB;
constexpr size_t WS_DUMMY = 800 * MiB;
constexpr size_t WS_END = 1024 * MiB;
constexpr int CW_BAR = 1024;
constexpr int CW_CNT = 8192;
constexpr int LDS_BYTES = 163840;
constexpr int LDS_MISC = LDS_BYTES - 64;

struct Args {
    const float* in[20]; const float* xin; float* out; unsigned char* ws; int ph_lo, ph_hi, rep2, pad;
};

constexpr int P0_PITCH = 512;
template <int MODE>
__device__ __forceinline__ void p0_block_item(const float* W, int K, int N, bf16_t* WT, int dst_row0, const float* kscale, LAS float* scr, int k0, int n0, int wave, int lane) {
    f32x4 wv[16];
#pragma unroll
    for (int r = 0; r < 8; ++r)
#pragma unroll
        for (int q = 0; q < 2; ++q) wv[2 * r + q] = *(const GAS f32x4*)(W + (size_t)(k0 + 8 * wave + r) * N + n0 + 4 * (lane + 64 * q));
    if (kscale) {
#pragma unroll
        for (int r = 0; r < 8; ++r) { const float s = kscale[k0 + 8 * wave + r]; wv[2 * r] = wv[2 * r] * s; wv[2 * r + 1] = wv[2 * r + 1] * s; } }
#pragma unroll
    for (int r = 0; r < 8; ++r)
#pragma unroll
        for (int q = 0; q < 2; ++q) *(LAS f32x4*)(scr + (8 * wave + r) * P0_PITCH + 4 * ((lane + 64 * q) ^ (wave & 7))) = wv[2 * r + q];
    __syncthreads();
    const int c = lane & 7;
#pragma unroll
    for (int j = 0; j < 8; ++j) { const int n = 64 * wave + (lane >> 3) + 8 * j; const LAS float* s = scr + (8 * c) * P0_PITCH + 4 * ((n >> 2) ^ c) + (n & 3);
        u32x4 o; o.x = pk2(s[0 * P0_PITCH], s[1 * P0_PITCH]); o.y = pk2(s[2 * P0_PITCH], s[3 * P0_PITCH]); o.z = pk2(s[4 * P0_PITCH], s[5 * P0_PITCH]); o.w = pk2(s[6 * P0_PITCH], s[7 * P0_PITCH]);
        int drow;
        if (MODE == 0) drow = dst_row0 + n;
        else { const int ns = n0 + n; drow = (ns < 512) ? ((ns >> 7) * 256 + (ns & 127)) : ((((ns - 512) >> 7) * 256) + 128 + ((ns - 512) & 127)); }
        *(GAS u32x4*)(WT + (size_t)drow * K + k0 + 8 * c) = o; }
    __syncthreads();
}
__device__ __forceinline__ int t5_bucket(int n) {
    if (n < 16) return n;
    const float lr = logf((float)n / 16.0f) / 4.1588830833596715f;
    int large = 16 + (int)(lr * 16.0f);
    return large < 31 ? large : 31;
}
__device__ __forceinline__ void norm_row_bf16(const float* xrow, const float* w, bf16_t* orow, int lane) {
    const GAS f32x4* xr = (const GAS f32x4*)xrow + lane;
    f32x4 v[4]; float s = 0.f;
#pragma unroll
    for (int j = 0; j < 4; ++j) { v[j] = xr[64 * j]; s += (v[j].x * v[j].x + v[j].y * v[j].y) + (v[j].z * v[j].z + v[j].w * v[j].w); }
    const float r = rsqrtf(wave_sum(s) * (1.f / D) + EPS);
    GAS u32x2* o8 = (GAS u32x2*)orow + lane;
#pragma unroll
    for (int j = 0; j < 4; ++j) { f32x4 ww = (f32x4){1.f, 1.f, 1.f, 1.f}; if (w) ww = ((const GAS f32x4*)w)[lane + 64 * j];
        u32x2 o; o.x = pk2(v[j].x * r * ww.x, v[j].y * r * ww.y); o.y = pk2(v[j].z * r * ww.z, v[j].w * r * ww.w); o8[64 * j] = o; }
}
__device__ __forceinline__ void p0_prologue(const Args& a, LAS unsigned char* lds, int wave, int lane) {
    LAS float* scr = (LAS float*)lds;
    const int gw = blockIdx.x * 8 + wave, NGW = gridDim.x * 8;
    unsigned char* ws = a.ws;
    constexpr int J0 = 16 * 8, J1 = J0 + 16 * 2, J2 = J1 + 16 * 4, J3 = J2 + 16 * 2, J4 = J3 + 16 * 2, J5 = J4 + 64 * 16 * 2, J6 = J5 + 64 * 8 * 2;
    for (int it = blockIdx.x; it < J6; it += gridDim.x) {
        if (it < J0) { const int r = it, kb = r / 8, nb = r % 8; p0_block_item<0>(a.in[3], 1024, 4096, (bf16_t*)(ws + WS_WIN), 512 * nb, nullptr, scr, 64 * kb, 512 * nb, wave, lane); }
        else if (it < J1) { const int r = it - J0, kb = r / 2, nb = r % 2; p0_block_item<0>(a.in[6], 1024, 1024, (bf16_t*)(ws + WS_WOUT), 512 * nb, nullptr, scr, 64 * kb, 512 * nb, wave, lane); }
        else if (it < J2) { const int r = it - J1, kb = r / 4, nb = r % 4; p0_block_item<0>(a.in[8], 1024, 2048, (bf16_t*)(ws + WS_WKVQ), 512 * nb, a.in[7], scr, 64 * kb, 512 * nb, wave, lane); }
        else if (it < J3) { const int r = it - J2, kb = r / 2, nb = r % 2; p0_block_item<0>(a.in[10], 1024, 1024, (bf16_t*)(ws + WS_WKVQ), 2048 + 512 * nb, a.in[1] + D, scr, 64 * kb, 512 * nb, wave, lane); }
        else if (it < J4) { const int r = it - J3, kb = r / 2, nb = r % 2; p0_block_item<0>(a.in[12], 1024, 1024, (bf16_t*)(ws + WS_WO), 512 * nb, nullptr, scr, 64 * kb, 512 * nb, wave, lane); }
        else if (it < J5) { const int r = it - J4, mat = r / 32, q = r % 32, kb = q / 2, nb = q % 2;
            p0_block_item<1>(a.in[18] + (size_t)mat * 1024 * 1024, 1024, 1024, (bf16_t*)(ws + WS_MWIN) + (size_t)mat * 1024 * 1024, 0, a.in[2] + (mat >> 5) * D, scr, 64 * kb, 512 * nb, wave, lane); }
        else { const int r = it - J5, mat = r / 16, q = r % 16, kb = q / 2, nb = q % 2;
            p0_block_item<0>(a.in[19] + (size_t)mat * 512 * 1024, 512, 1024, (bf16_t*)(ws + WS_MWOUT) + (size_t)mat * 1024 * 512, 512 * nb, nullptr, scr, 64 * kb, 512 * nb, wave, lane); }
    }
    for (int m = gw; m < T; m += NGW) norm_row_bf16(a.in[0] + (size_t)m * D, a.in[1], (bf16_t*)(ws + WS_XN) + (size_t)m * D, lane);
    if (blockIdx.x == 0) {
        float* lb = (float*)(ws + WS_SMALL); float* bt = lb + 2048;
        for (int i = threadIdx.x; i < 1024; i += 512) { const float x0 = a.in[4][i], x1 = a.in[4][1024 + i], m = fmaxf(x0, x1), e0 = expf(x0 - m), e1 = expf(x1 - m); lb[i] = e0 / (e0 + e1); }
        for (int i = threadIdx.x; i < 8192; i += 512) { const int h = i >> 10, d = i & 1023; bt[i] = a.in[13][t5_bucket(d) * 8 + h]; }
    }
}

struct EpiHG {
    static constexpr bool PERM = true;
    bf16_t* Qo; const float* lb;
    __device__ __forceinline__ void operator()(const f32x4 (&acc)[2][2][4][2], const Unit& u, int wr, int wc, int fr, int fq) const {
        const int quarter = u.pn >> 2, colq = (u.pn & 3) * 256 + wc * 32 + 8 * fq;
        bf16_t* base = Qo + (size_t)quarter * (64 * MiB / 2);
        const int row0 = u.pm * BM + wr * 64 + fr;
        f32x4 l0[2], l1[2];
#pragma unroll
        for (int bj = 0; bj < 2; ++bj) { l0[bj] = *(const f32x4*)(lb + colq + bj * HALF); l1[bj] = *(const f32x4*)(lb + colq + bj * HALF + 4); }
#pragma unroll
        for (int ai = 0; ai < 2; ++ai)
#pragma unroll
            for (int m = 0; m < 4; ++m) { bf16_t* rowp = base + (size_t)(row0 + ai * HALF + m * 16) * 1024 + colq;
#pragma unroll
                for (int bj = 0; bj < 2; ++bj) { f32x4 v0 = acc[ai][bj][m][0], v1 = acc[ai][bj][m][1];
                    if (quarter == 0) { v0 = v0 * 0.08838834764831845f; v1 = v1 * 0.08838834764831845f; }
                    else if (quarter == 1) {
#pragma unroll
                        for (int j = 0; j < 4; ++j) { v0[j] = __logf(l0[bj][j] + (1.f - l0[bj][j]) * sigmoidf_(v0[j])); v1[j] = __logf(l1[bj][j] + (1.f - l1[bj][j]) * sigmoidf_(v1[j])); } }
                    else if (quarter == 3) {
#pragma unroll
                        for (int j = 0; j < 4; ++j) { v0[j] = v0[j] * sigmoidf_(v0[j]); v1[j] = v1[j] * sigmoidf_(v1[j]); } }
                    u32x4 w; w.x = cvt_pk_bf16(v0[0], v0[1]); w.y = cvt_pk_bf16(v0[2], v0[3]); w.z = cvt_pk_bf16(v1[0], v1[1]); w.w = cvt_pk_bf16(v1[2], v1[3]);
                    *(u32x4*)(rowp + bj * HALF) = w; } }
    }
};
struct EpiRes {
    static constexpr bool PERM = false;
    float* C; const float* R; int ldc;
    __device__ __forceinline__ void operator()(const f32x4 (&acc)[2][2][4][2], const Unit& u, int wr, int wc, int fr, int fq) const {
        const int row0 = u.pm * BM + wr * 64 + fr, col0 = u.pn * BM + wc * 32 + 4 * fq;
#pragma unroll
        for (int ai = 0; ai < 2; ++ai)
#pragma unroll
            for (int m = 0; m < 4; ++m) { const size_t off = (size_t)(row0 + ai * HALF + m * 16) * ldc + col0;
#pragma unroll
                for (int bj = 0; bj < 2; ++bj)
#pragma unroll
                    for (int n = 0; n < 2; ++n) { const f32x4 r = *(const f32x4*)(R + off + bj * HALF + n * 16); *(f32x4*)(C + off + bj * HALF + n * 16) = r + acc[ai][bj][m][n]; }
                asm volatile("" ::: "memory"); }
    }
};

__device__ __forceinline__ unsigned off_b(unsigned row, unsigned ch) { return 256u * row + 16u * (ch ^ (((row & 3) << 2) | ((row >> 2) & 3))); }
__device__ __forceinline__ unsigned row_rd16(unsigned lane, unsigned rb, unsigned s) { return off_b((lane & 15) + 16 * rb, 4 * s + (lane >> 4)); }
__device__ __forceinline__ unsigned tr_rd16(unsigned lane, unsigned c, unsigned ks, unsigned t) { const unsigned g = lane >> 4, q = (lane & 15) >> 2, p = lane & 3; return off_b(32 * ks + 8 * g + 4 * t + q, 2 * c + (p >> 1)) + 8 * (p & 1); }
__device__ __forceinline__ unsigned elem_off(unsigned row, unsigned col) { return off_b(row, col >> 3) + (col & 7) * 2; }
__device__ __forceinline__ bf16x8 tr_frag(unsigned a0, unsigned a1) {
    bf16x4 lo, hi;
    asm volatile("ds_read_b64_tr_b16 %0, %2\n\tds_read_b64_tr_b16 %1, %3\n\ts_waitcnt lgkmcnt(0)" : "=&v"(lo), "=&v"(hi) : "v"(a0), "v"(a1) : "memory");
    bf16x8 r; r[0] = lo[0]; r[1] = lo[1]; r[2] = lo[2]; r[3] = lo[3]; r[4] = hi[0]; r[5] = hi[1]; r[6] = hi[2]; r[7] = hi[3]; return r;
}
__device__ __forceinline__ void tr_frag2(unsigned a0, unsigned a1, unsigned b0, unsigned b1, bf16x8& fa, bf16x8& fb) {
    bf16x4 l0, h0, l1, h1;
    asm volatile("ds_read_b64_tr_b16 %0, %4\n\tds_read_b64_tr_b16 %1, %5\n\tds_read_b64_tr_b16 %2, %6\n\tds_read_b64_tr_b16 %3, %7\n\ts_waitcnt lgkmcnt(0)"
                 : "=&v"(l0), "=&v"(h0), "=&v"(l1), "=&v"(h1) : "v"(a0), "v"(a1), "v"(b0), "v"(b1) : "memory");
    fa[0] = l0[0]; fa[1] = l0[1]; fa[2] = l0[2]; fa[3] = l0[3]; fa[4] = h0[0]; fa[5] = h0[1]; fa[6] = h0[2]; fa[7] = h0[3];
    fb[0] = l1[0]; fb[1] = l1[1]; fb[2] = l1[2]; fb[3] = l1[3]; fb[4] = h1[0]; fb[5] = h1[1]; fb[6] = h1[2]; fb[7] = h1[3];
}
#define TR_ISSUE(lo, hi, a0, a1) asm volatile("ds_read_b64_tr_b16 %0, %2\n\tds_read_b64_tr_b16 %1, %3" : "=&v"(lo), "=&v"(hi) : "v"(a0), "v"(a1) : "memory")
#define TR_WAIT2(n, l0, h0, l1, h1) asm volatile("s_waitcnt lgkmcnt(" #n ")" : "+v"(l0), "+v"(h0), "+v"(l1), "+v"(h1) :: "memory")
__device__ __forceinline__ bf16x8 tr_join(bf16x4 lo, bf16x4 hi) { bf16x8 r; r[0] = lo[0]; r[1] = lo[1]; r[2] = lo[2]; r[3] = lo[3]; r[4] = hi[0]; r[5] = hi[1]; r[6] = hi[2]; r[7] = hi[3]; return r; }
constexpr int GI_Q = 0, GI_K = 16384, GI_KH = 32768, GI_V = 49152, GI_A = 65536, GI_ST = 81920, GI_O = 114688, GI_GTOT = 148480, GI_EBT = 152576;
constexpr int O_PITCH = 132;

template <bool WITH_Q>
__device__ __forceinline__ void gla_prep(LAS unsigned char* lds, const unsigned (&lfw)[8], const unsigned (&qw)[8], const unsigned (&vw)[8], int g, int lane, float& totsum0, float& totsum1) {
    float b0[8], b1[8]; float s0 = 0.f, s1 = 0.f;
#pragma unroll
    for (int i = 0; i < 8; ++i) { s0 += bf_lo(lfw[i]); s1 += bf_hi(lfw[i]); b0[i] = s0; b1[i] = s1; }
    LAS float* gtot = (LAS float*)(lds + GI_GTOT);
    *(LAS f32x2*)(gtot + g * 128 + 2 * lane) = (f32x2){s0, s1};
    __syncthreads();
    float pre0 = 0.f, pre1 = 0.f, tot0 = 0.f, tot1 = 0.f;
#pragma unroll
    for (int gg = 0; gg < 8; ++gg) { const f32x2 v = *(LAS f32x2*)(gtot + gg * 128 + 2 * lane); tot0 += v.x; tot1 += v.y; if (gg < g) { pre0 += v.x; pre1 += v.y; } }
    totsum0 += tot0; totsum1 += tot1;
    if (g == 0) *(LAS f32x2*)((LAS float*)(lds + GI_EBT) + 2 * lane) = (f32x2){__expf(tot0), __expf(tot1)};
    const unsigned d = 2 * lane;
#pragma unroll
    for (int i = 0; i < 8; ++i) {
        const unsigned t = 8 * g + i, eo = elem_off(t, d);
        const float B0 = b0[i] + pre0, B1 = b1[i] + pre1;
        const float k0 = 1.f - __expf(bf_lo(lfw[i])), k1 = 1.f - __expf(bf_hi(lfw[i]));
        *(LAS unsigned*)(lds + GI_KH + eo) = cvt_pk_bf16(k0 * __expf(tot0 - B0), k1 * __expf(tot1 - B1));
        *(LAS unsigned*)(lds + GI_V + eo) = vw[i];
        if (WITH_Q) {
            *(LAS unsigned*)(lds + GI_Q + eo) = cvt_pk_bf16(bf_lo(qw[i]) * __expf(B0), bf_hi(qw[i]) * __expf(B1));
            *(LAS unsigned*)(lds + GI_K + eo) = cvt_pk_bf16(k0 * __expf(fminf(-B0, 80.f)), k1 * __expf(fminf(-B1, 80.f)));
        }
    }
}
__device__ __forceinline__ void gla_state_update(LAS unsigned char* lds, unsigned lds0, f32x4 (&S)[8], const bf16x8 (&vf)[2], int w, int lane) {
    const int fr = lane & 15, fq = lane >> 4;
#pragma unroll
    for (int mb = 0; mb < 8; ++mb) {
        const f32x4 e4 = *(LAS f32x4*)((LAS float*)(lds + GI_EBT) + 16 * mb + 4 * fq);
        f32x4 s = S[mb] * e4;
        bf16x8 kh0, kh1;
        tr_frag2(lds0 + GI_KH + tr_rd16(lane, mb, 0, 0), lds0 + GI_KH + tr_rd16(lane, mb, 0, 1), lds0 + GI_KH + tr_rd16(lane, mb, 1, 0), lds0 + GI_KH + tr_rd16(lane, mb, 1, 1), kh0, kh1);
        s = __builtin_amdgcn_mfma_f32_16x16x32_bf16(kh0, vf[0], s, 0, 0, 0); s = __builtin_amdgcn_mfma_f32_16x16x32_bf16(kh1, vf[1], s, 0, 0, 0);
        S[mb] = s;
        u32x2 o; o.x = cvt_pk_bf16(s[0], s[1]); o.y = cvt_pk_bf16(s[2], s[3]);
        *(LAS u32x2*)(lds + GI_ST + elem_off(16 * w + fr, 16 * mb + 4 * fq)) = o;
    }
}
#ifndef GLA_PREFETCH
#define GLA_PREFETCH 1
#endif
template <int PASS>
__device__ __forceinline__ void gla_phase(const Args& a, LAS unsigned char* lds, int wave, int lane) {
    unsigned char* ws = a.ws;
    const unsigned lds0 = (unsigned)(size_t)lds;
    const bf16_t* Qg = (const bf16_t*)(ws + WS_Q); const bf16_t* LFg = (const bf16_t*)(ws + WS_LF); const bf16_t* Vg = (const bf16_t*)(ws + WS_V); const bf16_t* Gg = (const bf16_t*)(ws + WS_G);
    float* STATE = (float*)(ws + WS_STATE); float* DEC = (float*)(ws + WS_DEC); bf16_t* OG = (bf16_t*)(ws + WS_OG);
    const float* onw = a.in[5];
    const int g = wave, w = wave, fr = lane & 15, fq = lane >> 4;
    const int nitems = (1024 - (int)blockIdx.x + (int)gridDim.x - 1) / (int)gridDim.x, nsteps = nitems * 4;
    if (nsteps <= 0) return;
#define GLA_OFF(s) ((((size_t)((((int)blockIdx.x + ((s) >> 2) * (int)gridDim.x) >> 5) >> 3) * L + (size_t)((((int)blockIdx.x + ((s) >> 2) * (int)gridDim.x)) & 31) * 256 + ((s) & 3) * 64 + 8 * g) * 1024) + (size_t)((((int)blockIdx.x + ((s) >> 2) * (int)gridDim.x) >> 5) & 7) * 128 + 2 * lane)
    unsigned nlf[8], nq[8], nv[8], ng[8];
    { const size_t o = GLA_OFF(0);
#pragma unroll
      for (int i = 0; i < 8; ++i) { nlf[i] = *(const unsigned*)(LFg + o + (size_t)i * 1024); nv[i] = *(const unsigned*)(Vg + o + (size_t)i * 1024);
          nq[i] = (PASS == 1) ? *(const unsigned*)(Qg + o + (size_t)i * 1024) : 0u; ng[i] = (PASS == 1) ? *(const unsigned*)(Gg + o + (size_t)i * 1024) : 0u; } }
    f32x4 S[8];
    float ts0 = 0.f, ts1 = 0.f;
    for (int s = 0; s < nsteps; ++s) {
        const int item = (int)blockIdx.x + (s >> 2) * (int)gridDim.x, c = s & 3;
        const size_t ocur = GLA_OFF(s);
        if (c == 0) {
            ts0 = 0.f; ts1 = 0.f;
            if (PASS == 1) {
                const float* sp = STATE + (size_t)item * 16384 + (size_t)(16 * w + fr) * 128 + 4 * fq;
#pragma unroll
                for (int mb = 0; mb < 8; ++mb) { S[mb] = *(const f32x4*)(sp + 16 * mb);
                    u32x2 o; o.x = cvt_pk_bf16(S[mb][0], S[mb][1]); o.y = cvt_pk_bf16(S[mb][2], S[mb][3]);
                    *(LAS u32x2*)(lds + GI_ST + elem_off(16 * w + fr, 16 * mb + 4 * fq)) = o; }
            } else {
#pragma unroll
                for (int mb = 0; mb < 8; ++mb) S[mb] = (f32x4){0.f, 0.f, 0.f, 0.f};
            }
        }
        unsigned lfw[8], qw[8], vw[8], gw8[8];
        if (!GLA_PREFETCH && s > 0) {
#pragma unroll
            for (int i = 0; i < 8; ++i) { nlf[i] = *(const unsigned*)(LFg + ocur + (size_t)i * 1024); nv[i] = *(const unsigned*)(Vg + ocur + (size_t)i * 1024);
                if (PASS == 1) { nq[i] = *(const unsigned*)(Qg + ocur + (size_t)i * 1024); ng[i] = *(const unsigned*)(Gg + ocur + (size_t)i * 1024); } } }
#pragma unroll
        for (int i = 0; i < 8; ++i) { lfw[i] = nlf[i]; qw[i] = nq[i]; vw[i] = nv[i]; gw8[i] = ng[i]; }
        if (GLA_PREFETCH && s + 1 < nsteps) { const size_t o = GLA_OFF(s + 1);
#pragma unroll
            for (int i = 0; i < 8; ++i) { nlf[i] = *(const unsigned*)(LFg + o + (size_t)i * 1024); nv[i] = *(const unsigned*)(Vg + o + (size_t)i * 1024);
                if (PASS == 1) { nq[i] = *(const unsigned*)(Qg + o + (size_t)i * 1024); ng[i] = *(const unsigned*)(Gg + o + (size_t)i * 1024); } } }
        gla_prep<PASS == 1>(lds, lfw, qw, vw, g, lane, ts0, ts1);
        __syncthreads();
        bf16x8 vf[2];
        tr_frag2(lds0 + GI_V + tr_rd16(lane, w, 0, 0), lds0 + GI_V + tr_rd16(lane, w, 0, 1), lds0 + GI_V + tr_rd16(lane, w, 1, 0), lds0 + GI_V + tr_rd16(lane, w, 1, 1), vf[0], vf[1]);
        if (PASS == 1) {
            const int tb = w >> 1;
#pragma unroll
            for (int x = 0; x < 2; ++x) { const int sb = 2 * (w & 1) + x;
                f32x4 acc = (f32x4){0.f, 0.f, 0.f, 0.f};
#pragma unroll
                for (int ks = 0; ks < 4; ++ks) { const bf16x8 ka = *(const LAS bf16x8*)(lds + GI_K + row_rd16(lane, sb, ks)); const bf16x8 qb = *(const LAS bf16x8*)(lds + GI_Q + row_rd16(lane, tb, ks));
                    acc = __builtin_amdgcn_mfma_f32_16x16x32_bf16(ka, qb, acc, 0, 0, 0); }
                const int t = tb * 16 + fr, s0 = sb * 16 + 4 * fq;
#pragma unroll
                for (int r = 0; r < 4; ++r) if (s0 + r > t) acc[r] = 0.f;
                u32x2 o; o.x = cvt_pk_bf16(acc[0], acc[1]); o.y = cvt_pk_bf16(acc[2], acc[3]);
                *(LAS u32x2*)(lds + GI_A + elem_off(t, s0)) = o; }
            bf16x8 stf[4];
#pragma unroll
            for (int ks = 0; ks < 4; ++ks) stf[ks] = *(const LAS bf16x8*)(lds + GI_ST + row_rd16(lane, w, ks));
            __syncthreads();
#pragma unroll
            for (int tb2 = 0; tb2 < 4; ++tb2) {
                f32x4 acc = (f32x4){0.f, 0.f, 0.f, 0.f};
#pragma unroll
                for (int ks = 0; ks < 2; ++ks) { const bf16x8 ab = *(const LAS bf16x8*)(lds + GI_A + row_rd16(lane, tb2, ks)); acc = __builtin_amdgcn_mfma_f32_16x16x32_bf16(vf[ks], ab, acc, 0, 0, 0); }
#pragma unroll
                for (int ks = 0; ks < 4; ++ks) { const bf16x8 qb = *(const LAS bf16x8*)(lds + GI_Q + row_rd16(lane, tb2, ks)); acc = __builtin_amdgcn_mfma_f32_16x16x32_bf16(stf[ks], qb, acc, 0, 0, 0); }
                *(LAS f32x4*)((LAS float*)(lds + GI_O) + (16 * tb2 + fr) * O_PITCH + 16 * w + 4 * fq) = acc;
            }
        }
        if (PASS == 0 || c < 3) gla_state_update(lds, lds0, S, vf, w, lane);
        __syncthreads();
        if (PASS == 1) {
            const f32x2 nw = *(const f32x2*)(onw + 2 * lane);
#pragma unroll
            for (int i = 0; i < 8; ++i) { const int t = 8 * g + i;
                const f32x2 o = *(LAS f32x2*)((LAS float*)(lds + GI_O) + t * O_PITCH + 2 * lane);
                const float r = rsqrtf(wave_sum(o.x * o.x + o.y * o.y) * (1.f / 128.f) + EPS);
                *(unsigned*)(OG + ocur + (size_t)i * 1024) = cvt_pk_bf16(o.x * r * nw.x * bf_lo(gw8[i]), o.y * r * nw.y * bf_hi(gw8[i])); }
        }
        if (PASS == 0 && c == 3) {
            float* sp = STATE + (size_t)item * 16384 + (size_t)(16 * w + fr) * 128 + 4 * fq;
#pragma unroll
            for (int mb = 0; mb < 8; ++mb) *(f32x4*)(sp + 16 * mb) = S[mb];
            if (g == 0) *(f32x2*)(DEC + (size_t)item * 128 + 2 * lane) = (f32x2){__expf(ts0), __expf(ts1)};
        }
        if (c == 3) __syncthreads();
    }
#undef GLA_OFF
}
__device__ __forceinline__ void gla_scan(const Args& a) {
    float* STATE = (float*)(a.ws + WS_STATE); const float* DEC = (const float*)(a.ws + WS_DEC);
    for (int e = blockIdx.x * 512 + threadIdx.x; e < 32 * 4096; e += gridDim.x * 512) {
        const int bh = e >> 12, q = e & 4095, dk0 = (q & 31) * 4;
        f32x4 carry = (f32x4){0.f, 0.f, 0.f, 0.f};
        float* p = STATE + (size_t)bh * 32 * 16384 + (size_t)q * 4;
        const float* dp = DEC + (size_t)bh * 32 * 128 + dk0;
#pragma unroll 4
        for (int sc = 0; sc < 32; ++sc) { const f32x4 loc = *(const f32x4*)(p + (size_t)sc * 16384); const f32x4 dec = *(const f32x4*)(dp + sc * 128);
            *(f32x4*)(p + (size_t)sc * 16384) = carry; carry = dec * carry + loc; }
    }
}
constexpr int MOE_CAPROWS = T * 2 + NEXP * 256;
constexpr int LDS_MOE_TAB = 131072;

constexpr int RL_BH = 0, RL_BL = 36864, RL_LG = 73728, RL_RS = RL_LG + 8 * 2304, RL_REC = RL_RS + 8 * 64, RL_CNT = RL_REC + 5 * 2048;
__device__ __forceinline__ unsigned rt_off(int c, int k) { return (unsigned)c * 1024u + ((((unsigned)k >> 3) ^ ((unsigned)c & 15u)) << 4) + ((unsigned)k & 7u) * 2u; }
__device__ __forceinline__ void moe_route_phase(const Args& a, LAS unsigned char* lds, int layer, int cslot, const float* xin, int wave, int lane) {
    unsigned char* ws = a.ws;
    const float* wg = a.in[14] + (size_t)layer * D * 4; const float* bg = a.in[15] + layer * 4;
    const float* we = a.in[16] + (size_t)layer * D * 32; const float* be = a.in[17] + layer * 32;
    const float* nw = a.in[2] + (size_t)layer * D;
    unsigned* cnt = (unsigned*)(ws + WS_CTL) + CW_CNT + 64 * cslot;
    u32x4* list = (u32x4*)(ws + WS_LIST); bf16_t* H2 = (bf16_t*)(ws + WS_XN);
    const int tid = threadIdx.x, fr = lane & 15, fq = lane >> 4;
    const int NGW = gridDim.x * 8, ngroups = T / 16, rounds = (ngroups + NGW - 1) / NGW;
    LAS float* lgw = (LAS float*)(lds + RL_LG + wave * 2304);
    LAS float* rsw = (LAS float*)(lds + RL_RS + wave * 64);
    LAS int* re0 = (LAS int*)(lds + RL_REC); LAS int* re1 = re0 + 512; LAS float* rw0 = (LAS float*)(re1 + 512); LAS float* rw1 = rw0 + 512; LAS float* rrs = rw1 + 512;
    LAS int* lcnt = (LAS int*)(lds + RL_CNT); LAS int* lbase = lcnt + 32;
    for (int rd = 0; rd < rounds; ++rd) {
        const int grp = (int)blockIdx.x * 8 + wave + rd * NGW;
        const bool live = grp < ngroups;
        const int t = (live ? grp : 0) * 16 + fr;
        f32x4 acc[3];
#pragma unroll
        for (int n = 0; n < 3; ++n) acc[n] = (f32x4){0.f, 0.f, 0.f, 0.f};
        float ss = 0.f;
#pragma unroll 1
        for (int half = 0; half < 2; ++half) {
            __syncthreads();
            for (int i = tid; i < 36 * 512; i += 512) {
                int c, kk; float w;
                if (i < 4 * 512) { kk = i >> 2; c = i & 3; w = wg[(size_t)(half * 512 + kk) * 4 + c]; }
                else { const int q = i - 4 * 512; kk = q >> 5; c = 4 + (q & 31); w = we[(size_t)(half * 512 + kk) * 32 + (q & 31)]; }
                w *= nw[half * 512 + kk];
                const unsigned hi = f2bf(w); const float lo = w - __builtin_bit_cast(float, hi << 16);
                const unsigned o = rt_off(c, kk);
                *(LAS unsigned short*)(lds + RL_BH + o) = (unsigned short)hi; *(LAS unsigned short*)(lds + RL_BL + o) = (unsigned short)f2bf(lo);
            }
            __syncthreads();
            const float* xr = xin + (size_t)t * D + half * 512 + 8 * fq;
            bf16_t* hr = H2 + (size_t)t * D + half * 512 + 8 * fq;
#pragma unroll 4
            for (int ks = 0; ks < 16; ++ks) {
                const f32x4 xa = *(const GAS f32x4*)(xr + 32 * ks), xb = *(const GAS f32x4*)(xr + 32 * ks + 4);
                ss += (xa.x * xa.x + xa.y * xa.y) + (xa.z * xa.z + xa.w * xa.w) + (xb.x * xb.x + xb.y * xb.y) + (xb.z * xb.z + xb.w * xb.w);
                u32x4 hi; hi.x = pk2(xa.x, xa.y); hi.y = pk2(xa.z, xa.w); hi.z = pk2(xb.x, xb.y); hi.w = pk2(xb.z, xb.w);
                u32x4 lo; lo.x = pk2(xa.x - bf_lo(hi.x), xa.y - bf_hi(hi.x)); lo.y = pk2(xa.z - bf_lo(hi.y), xa.w - bf_hi(hi.y));
                          lo.z = pk2(xb.x - bf_lo(hi.z), xb.y - bf_hi(hi.z)); lo.w = pk2(xb.z - bf_lo(hi.w), xb.w - bf_hi(hi.w));
                if (live) *(GAS u32x4*)(hr + 32 * ks) = hi;
                const bf16x8 ahi = __builtin_bit_cast(bf16x8, hi), alo = __builtin_bit_cast(bf16x8, lo);
#pragma unroll
                for (int n = 0; n < 3; ++n) { const int c = (n == 2 ? 20 : 16 * n) + fr; const unsigned o = (unsigned)c * 1024u + ((((unsigned)(4 * ks + fq)) ^ ((unsigned)c & 15u)) << 4);
                    const bf16x8 bh = *(const LAS bf16x8*)(lds + RL_BH + o), bl = *(const LAS bf16x8*)(lds + RL_BL + o);
                    acc[n] = __builtin_amdgcn_mfma_f32_16x16x32_bf16(ahi, bh, acc[n], 0, 0, 0);
                    acc[n] = __builtin_amdgcn_mfma_f32_16x16x32_bf16(ahi, bl, acc[n], 0, 0, 0);
                    acc[n] = __builtin_amdgcn_mfma_f32_16x16x32_bf16(alo, bh, acc[n], 0, 0, 0); }
            }
        }
        ss += __shfl_xor(ss, 16); ss += __shfl_xor(ss, 32);
        const float rstd = rsqrtf(ss * (1.f / D) + EPS);
        if (fq == 0) rsw[fr] = rstd;
#pragma unroll
        for (int r = 0; r < 4; ++r) { const float rs = rsw[4 * fq + r];
            lgw[(4 * fq + r) * 36 + fr] = acc[0][r] * rs + (fr < 4 ? bg[fr] : be[fr - 4]);
            lgw[(4 * fq + r) * 36 + 16 + fr] = acc[1][r] * rs + be[12 + fr];
            if (fr >= 12) lgw[(4 * fq + r) * 36 + 20 + fr] = acc[2][r] * rs + be[16 + fr]; }
        if (lane < 16) {
            float lg[36];
#pragma unroll
            for (int c = 0; c < 36; ++c) lg[c] = lgw[lane * 36 + c];
            int gi = 0; float gm = lg[0];
#pragma unroll
            for (int i = 1; i < 4; ++i) if (lg[i] > gm) { gm = lg[i]; gi = i; }
            float gs = 0.f;
#pragma unroll
            for (int i = 0; i < 4; ++i) gs += expf(lg[i] - gm);
            const float gw_ = 1.0f / gs;
            float el[8];
#pragma unroll
            for (int i = 0; i < 8; ++i) el[i] = gi == 0 ? lg[4 + i] : gi == 1 ? lg[12 + i] : gi == 2 ? lg[20 + i] : lg[28 + i];
            int i0 = 0; float m0 = el[0];
#pragma unroll
            for (int i = 1; i < 8; ++i) if (el[i] > m0) { m0 = el[i]; i0 = i; }
            int i1 = -1; float m1 = -INFINITY;
#pragma unroll
            for (int i = 0; i < 8; ++i) if (i != i0 && el[i] > m1) { m1 = el[i]; i1 = i; }
            const float p1 = expf(m1 - m0);
            const int li = wave * 16 + lane;
            re0[li] = live ? gi * 8 + i0 : -1; re1[li] = gi * 8 + i1; rw0[li] = gw_ / (1.f + p1); rw1[li] = gw_ * p1 / (1.f + p1); rrs[li] = rsw[lane];
        }
        if (tid < 32) lcnt[tid] = 0;
        __syncthreads();
        int myrank0 = 0, myrank1 = 0, e0 = -1, e1 = 0; float w0 = 0.f, w1 = 0.f, rs = 0.f;
        if (tid < 128) { e0 = re0[tid]; e1 = re1[tid]; w0 = rw0[tid]; w1 = rw1[tid]; rs = rrs[tid]; }
        if (e0 >= 0) { myrank0 = __hip_atomic_fetch_add(&lcnt[e0], 1, __ATOMIC_RELAXED, __HIP_MEMORY_SCOPE_WORKGROUP); myrank1 = __hip_atomic_fetch_add(&lcnt[e1], 1, __ATOMIC_RELAXED, __HIP_MEMORY_SCOPE_WORKGROUP); }
        __syncthreads();
        if (tid < 32) { const int c = lcnt[tid]; lbase[tid] = c ? (int)__hip_atomic_fetch_add(cnt + tid, (unsigned)c, __ATOMIC_RELAXED, __HIP_MEMORY_SCOPE_AGENT) : 0; }
        __syncthreads();
        if (e0 >= 0) { const int tk = (((int)blockIdx.x * 8 + (tid >> 4) + rd * NGW) * 16) + (tid & 15);
            list[(size_t)e0 * (2 * T) + lbase[e0] + myrank0] = (u32x4){(unsigned)(tk * 2), as_u(rs), as_u(w0), 0u};
            list[(size_t)e1 * (2 * T) + lbase[e1] + myrank1] = (u32x4){(unsigned)(tk * 2 + 1), as_u(rs), as_u(w1), 0u}; }
    }
}
__device__ __forceinline__ void moe_tables(const Args& a, LAS unsigned char* lds, int layer) {
    LAS int* tst = (LAS int*)(lds + LDS_MOE_TAB); LAS int* cn = tst + 64;
    const unsigned* cnt = (const unsigned*)(a.ws + WS_CTL) + CW_CNT + 64 * layer;
    if (threadIdx.x == 0) { int acc = 0; for (int e = 0; e < NEXP; ++e) { const int c = (int)__hip_atomic_load(cnt + e, __ATOMIC_RELAXED, __HIP_MEMORY_SCOPE_AGENT); tst[e] = acc; cn[e] = c; acc += (c + 255) >> 8; } tst[NEXP] = acc; }
    __syncthreads();
}
struct MoeOrder {
    const LAS int* tst; const LAS int* cn; const u32x4* list;
    const bf16_t* A; const bf16_t* Bt; int K; size_t bstride;
    int G, c, ntot;
    __device__ bool next(int i, Unit& u) const {
        const int Lx = i * G + c; if (Lx >= ntot * 4) return false;
        u.pm = Lx >> 2; u.pn = Lx & 3; int e = 0;
#pragma unroll 1
        for (int k = 1; k < NEXP; ++k) if (tst[k] <= u.pm) e = k;
        u.e = e; u.aux = u.pm - tst[e]; return true;
    }
    __device__ __forceinline__ const char* b_base(const Unit& u) const { return (const char*)Bt + (size_t)u.e * bstride + (size_t)u.pn * 256 * K * 2; }
};
struct MoeOrder1 : MoeOrder {
    static constexpr bool GATHER = true;
    __device__ __forceinline__ const char* a_base(const Unit&) const { return (const char*)A; }
    __device__ __forceinline__ void a_offs(const Unit& u, const int (&RR)[2], const int (&CC)[2], unsigned (&o)[2][2]) const {
        const int cnte = cn[u.e]; const u32x4* le = list + (size_t)u.e * (2 * T);
#pragma unroll
        for (int h = 0; h < 2; ++h)
#pragma unroll
            for (int i = 0; i < 2; ++i) { const int rank = u.aux * 256 + h * 128 + RR[i]; const int tok = rank < cnte ? (int)(((const unsigned*)(le + rank))[0] >> 1) : 0; o[h][i] = (unsigned)(tok * K + CC[i]) * 2u; }
    }
};
struct MoeOrder2 : MoeOrder {
    static constexpr bool GATHER = false;
    __device__ __forceinline__ const char* a_base(const Unit& u) const { return (const char*)A + (size_t)u.pm * 256 * K * 2; }
    __device__ __forceinline__ void a_offs(const Unit&, const int (&)[2], const int (&)[2], unsigned (&)[2][2]) const {}
};
struct EpiAct {
    static constexpr bool PERM = true;
    bf16_t* ACT; const u32x4* list; const LAS int* cn;
    __device__ __forceinline__ void operator()(const f32x4 (&acc)[2][2][4][2], const Unit& u, int wr, int wc, int fr, int fq) const {
        const int row0 = u.pm * BM + wr * 64 + fr, col0 = u.pn * 128 + wc * 32 + 8 * fq;
        const int cnte = cn[u.e]; const u32x4* le = list + (size_t)u.e * (2 * T);
        float rs[2][4];
#pragma unroll
        for (int ai = 0; ai < 2; ++ai)
#pragma unroll
            for (int m = 0; m < 4; ++m) { const int rank = u.aux * 256 + ai * HALF + wr * 64 + m * 16 + fr; rs[ai][m] = rank < cnte ? as_f(((const unsigned*)(le + rank))[1]) : 0.f; }
#pragma unroll
        for (int ai = 0; ai < 2; ++ai)
#pragma unroll
            for (int m = 0; m < 4; ++m) { bf16_t* rowp = ACT + (size_t)(row0 + ai * HALF + m * 16) * FF + col0; const float r = rs[ai][m];
                f32x4 g0 = acc[ai][0][m][0] * r, g1 = acc[ai][0][m][1] * r; const f32x4 u0 = acc[ai][1][m][0] * r, u1 = acc[ai][1][m][1] * r;
#pragma unroll
                for (int j = 0; j < 4; ++j) { g0[j] = g0[j] * sigmoidf_(g0[j]) * u0[j]; g1[j] = g1[j] * sigmoidf_(g1[j]) * u1[j]; }
                u32x4 w; w.x = cvt_pk_bf16(g0[0], g0[1]); w.y = cvt_pk_bf16(g0[2], g0[3]); w.z = cvt_pk_bf16(g1[0], g1[1]); w.w = cvt_pk_bf16(g1[2], g1[3]);
                *(u32x4*)rowp = w; }
    }
};
struct EpiY {
    static constexpr bool PERM = true;
    bf16_t* YB; const u32x4* list; const LAS int* cn;
    __device__ __forceinline__ void operator()(const f32x4 (&acc)[2][2][4][2], const Unit& u, int wr, int wc, int fr, int fq) const {
        const int cnte = cn[u.e]; const u32x4* le = list + (size_t)u.e * (2 * T);
        const int col0 = u.pn * BM + wc * 32 + 8 * fq;
        u32x4 en[2][4];
#pragma unroll
        for (int ai = 0; ai < 2; ++ai)
#pragma unroll
            for (int m = 0; m < 4; ++m) { const int rank = u.aux * 256 + ai * HALF + wr * 64 + m * 16 + fr; en[ai][m] = le[rank < cnte ? rank : 0]; }
#pragma unroll
        for (int ai = 0; ai < 2; ++ai)
#pragma unroll
            for (int m = 0; m < 4; ++m) { const int rank = u.aux * 256 + ai * HALF + wr * 64 + m * 16 + fr;
                if (rank < cnte) { const unsigned wz = en[ai][m].z; const float w = as_f(wz);   bf16_t* rowp = YB + (size_t)en[ai][m].x * D + col0;
#pragma unroll
                    for (int bj = 0; bj < 2; ++bj) { const f32x4 v0 = acc[ai][bj][m][0] * w, v1 = acc[ai][bj][m][1] * w;
                        u32x4 o; o.x = cvt_pk_bf16(v0[0], v0[1]); o.y = cvt_pk_bf16(v0[2], v0[3]); o.z = cvt_pk_bf16(v1[0], v1[1]); o.w = cvt_pk_bf16(v1[2], v1[3]);
                        *(u32x4*)(rowp + bj * HALF) = o; } } }
    }
};
template <bool NORM>
__device__ __forceinline__ void moe_combine_phase(const Args& a, const float* xin, float* xout, int wave, int lane) {
    const bf16_t* YB = (const bf16_t*)(a.ws + WS_YB); bf16_t* XN = (bf16_t*)(a.ws + WS_XN);
    const int gw = blockIdx.x * 8 + wave, NGW = gridDim.x * 8;
    for (int t = gw; t < T; t += NGW) {
        const GAS f32x4* xr = (const GAS f32x4*)(xin + (size_t)t * D) + lane; GAS f32x4* xo = (GAS f32x4*)(xout + (size_t)t * D) + lane;
        const GAS u32x2* y0 = (const GAS u32x2*)(YB + (size_t)(2 * t) * D) + lane; const GAS u32x2* y1 = (const GAS u32x2*)(YB + (size_t)(2 * t + 1) * D) + lane;
        f32x4 v[4]; float s = 0.f;
#pragma unroll
        for (int j = 0; j < 4; ++j) { v[j] = xr[64 * j]; const u32x2 p = y0[64 * j], q = y1[64 * j];
            v[j].x += bf_lo(p.x) + bf_lo(q.x); v[j].y += bf_hi(p.x) + bf_hi(q.x); v[j].z += bf_lo(p.y) + bf_lo(q.y); v[j].w += bf_hi(p.y) + bf_hi(q.y); xo[64 * j] = v[j];
            s += (v[j].x * v[j].x + v[j].y * v[j].y) + (v[j].z * v[j].z + v[j].w * v[j].w); }
        if (NORM) { const float r = rsqrtf(wave_sum(s) * (1.f / D) + EPS); GAS u32x2* o8 = (GAS u32x2*)(XN + (size_t)t * D) + lane;
#pragma unroll
            for (int j = 0; j < 4; ++j) { u32x2 o; o.x = pk2(v[j].x * r, v[j].y * r); o.y = pk2(v[j].z * r, v[j].w * r); o8[64 * j] = o; } }
    }
}
constexpr size_t WS_K2 = 320 * MiB, WS_V2 = 384 * MiB, WS_Q2 = 448 * MiB;
constexpr size_t WS_OP = 512 * MiB;
constexpr size_t WS_LP = 704 * MiB;
constexpr size_t WS_ATT = 708 * MiB;
constexpr size_t WS_SELX = 1001 * MiB;
constexpr int CW_TOT = 16384;
constexpr float ATT_C1 = 0.08838834764831845f * 1.4426950408889634f;

__device__ __forceinline__ void att_norm_phase(const Args& a, int wave, int lane) {
    const int gw = blockIdx.x * 8 + wave, NGW = gridDim.x * 8;
    for (int m = gw; m < T; m += NGW) norm_row_bf16(a.xin + (size_t)m * D, nullptr, (bf16_t*)(a.ws + WS_XN) + (size_t)m * D, lane);
}
constexpr int LDS_KVQ_SS = 131072, LDS_KVQ_CS = 131072 + 8192;
struct EpiKVQ {
    static constexpr bool PERM = true;
    bf16_t* Ko; const float* kw; const float* qw; float* KM; LAS unsigned char* lds;
    __device__ __forceinline__ void operator()(const f32x4 (&acc)[2][2][4][2], const Unit& u, int wr, int wc, int fr, int fq) const {
        const int sec = u.pn >> 2, hp = (u.pn & 3) * 2, d0 = wc * 32 + 8 * fq;
        bf16_t* base = Ko + (size_t)sec * (64 * MiB / 2);
        f32x4 w0 = (f32x4){1.f, 1.f, 1.f, 1.f}, w1 = w0;
        LAS float* SS = (LAS float*)(lds + LDS_KVQ_SS);
        if (sec != 1) {
            const float* nw = sec == 0 ? kw : qw;
            w0 = *(const f32x4*)(nw + d0); w1 = *(const f32x4*)(nw + d0 + 4);
#pragma unroll
            for (int ai = 0; ai < 2; ++ai)
#pragma unroll
                for (int m = 0; m < 4; ++m)
#pragma unroll
                    for (int bj = 0; bj < 2; ++bj) { const f32x4 a = acc[ai][bj][m][0], b = acc[ai][bj][m][1];
                        float s = (a[0] * a[0] + a[1] * a[1]) + (a[2] * a[2] + a[3] * a[3]) + (b[0] * b[0] + b[1] * b[1]) + (b[2] * b[2] + b[3] * b[3]);
                        s += __shfl_xor(s, 16); s += __shfl_xor(s, 32);
                        if (fq == 0) SS[((ai * HALF + wr * 64 + m * 16 + fr) * 2 + bj) * 4 + wc] = s; }
            asm volatile("s_waitcnt lgkmcnt(0)" ::: "memory"); __builtin_amdgcn_s_barrier(); asm volatile("" ::: "memory");
        }
        f32x4 cs0[2], cs1[2];
#pragma unroll
        for (int bj = 0; bj < 2; ++bj) { cs0[bj] = (f32x4){0.f, 0.f, 0.f, 0.f}; cs1[bj] = cs0[bj]; }
#pragma unroll
        for (int ai = 0; ai < 2; ++ai)
#pragma unroll
            for (int m = 0; m < 4; ++m) { const int r = u.pm * BM + ai * HALF + wr * 64 + m * 16 + fr, b = r >> 13, pos = r & 8191;
#pragma unroll
                for (int bj = 0; bj < 2; ++bj) {
                    float rsv = 1.f;
                    if (sec != 1) { const f32x4 p = *(const LAS f32x4*)(SS + ((ai * HALF + wr * 64 + m * 16 + fr) * 2 + bj) * 4); rsv = rsqrtf(((p[0] + p[1]) + (p[2] + p[3])) * (1.f / HD) + EPS); }
                    const f32x4 v0 = acc[ai][bj][m][0] * rsv * w0, v1 = acc[ai][bj][m][1] * rsv * w1;
                    cs0[bj] += v0; cs1[bj] += v1;
                    u32x4 w; w.x = cvt_pk_bf16(v0[0], v0[1]); w.y = cvt_pk_bf16(v0[2], v0[3]); w.z = cvt_pk_bf16(v1[0], v1[1]); w.w = cvt_pk_bf16(v1[2], v1[3]);
                    *(u32x4*)(base + (((size_t)(b * NH + hp + bj) * L + pos) * HD + d0)) = w; } }
        if (sec == 0) {
            LAS float* CS = (LAS float*)(lds + LDS_KVQ_CS);
#pragma unroll
            for (int bj = 0; bj < 2; ++bj)
#pragma unroll
                for (int j = 0; j < 4; ++j) {
                    float a = cs0[bj][j], b2 = cs1[bj][j];
#pragma unroll
                    for (int o = 1; o < 16; o <<= 1) { a += __shfl_xor(a, o); b2 += __shfl_xor(b2, o); }
                    if (fr == 0) { CS[wr * 256 + bj * 128 + d0 + j] = a; CS[wr * 256 + bj * 128 + d0 + 4 + j] = b2; } }
            asm volatile("s_waitcnt lgkmcnt(0)" ::: "memory"); __builtin_amdgcn_s_barrier(); asm volatile("" ::: "memory");
            const int t = threadIdx.x;
            if (t < 256) { const int bb = (u.pm * BM) >> 13, nb = ((u.pm * BM) & 8191) >> 8;
                KM[(((size_t)(bb * NH + hp + (t >> 7))) * NBLK + nb) * HD + (t & 127)] = (CS[t] + CS[256 + t]) * (1.f / 256.f); }
        }
    }
};
__device__ __forceinline__ void att_post_phase(const Args& a, LAS unsigned char* lds, int rep, int wave, int lane) {
    bf16_t* Kb = (bf16_t*)(a.ws + WS_K2); bf16_t* Qb = (bf16_t*)(a.ws + WS_Q2); float* KM = (float*)(a.ws + (rep ? WS_DUMMY + 96 * MiB : WS_KM));
    const size_t wofs = rep ? (WS_DUMMY - WS_K2) / 2 : 0;
    const f32x2 kw = *(const f32x2*)(a.in[9] + 2 * lane), qw = *(const f32x2*)(a.in[11] + 2 * lane);
    LAS float* cs = (LAS float*)lds;
    for (int item = blockIdx.x; item < B * NH * NBLK; item += gridDim.x) {
        const size_t row0 = (size_t)(item >> 5) * L + (size_t)(item & 31) * 256 + 32 * wave;
        float c0 = 0.f, c1 = 0.f;
#pragma unroll 4
        for (int i = 0; i < 32; ++i) {
            unsigned* kp = (unsigned*)(Kb + (row0 + i) * HD) + lane; unsigned* qp = (unsigned*)(Qb + (row0 + i) * HD) + lane;
            const unsigned ku = *kp, qu = *qp;
            float k0 = bf_lo(ku), k1 = bf_hi(ku), q0 = bf_lo(qu), q1 = bf_hi(qu);
            const float rk = rsqrtf(wave_sum(k0 * k0 + k1 * k1) * (1.f / HD) + EPS), rq = rsqrtf(wave_sum(q0 * q0 + q1 * q1) * (1.f / HD) + EPS);
            k0 *= rk * kw.x; k1 *= rk * kw.y; q0 *= rq * qw.x; q1 *= rq * qw.y;
            c0 += k0; c1 += k1;
            kp[wofs / 2] = pk2(k0, k1); qp[(rep ? (WS_DUMMY + 64 * MiB - WS_Q2) / 4 : 0)] = pk2(q0, q1);
        }
        *(LAS f32x2*)(cs + wave * 128 + 2 * lane) = (f32x2){c0, c1};
        __syncthreads();
        if (threadIdx.x < 128) { float s = 0.f;
#pragma unroll
            for (int w8 = 0; w8 < 8; ++w8) s += cs[w8 * 128 + threadIdx.x];
            KM[(size_t)item * HD + threadIdx.x] = s * (1.f / 256.f); }
        __syncthreads();
    }
}
__device__ __forceinline__ void att_sel_phase(const Args& a, LAS unsigned char* lds, int rep, int wave, int lane) {
    const bf16_t* Qb = (const bf16_t*)(a.ws + WS_Q2); const float* KM = (const float*)(a.ws + WS_KM);
    unsigned short* LISTS = (unsigned short*)(a.ws + WS_SEL); int* CNTS = (int*)(a.ws + WS_SELCNT); unsigned* TOT = (unsigned*)(a.ws + WS_CTL) + CW_TOT + 1024 * rep; int* SELX = (int*)(a.ws + WS_SELX);
    LAS float* kms = (LAS float*)lds;
    LAS int* cnts = (LAS int*)(lds + 16384);
    const int tid = threadIdx.x;
    for (int item = blockIdx.x; item < B * NH * NBLK; item += gridDim.x) {
        const int bsel = (item >> 8) & 3, q0 = ((item & 31) + ((bsel & 2) ? 16 : 0)) & 31;
        const int bh = item >> 5, qb = (bsel & 1) ? 31 - q0 : q0, b = bh >> 3, h = bh & 7;
        for (int i = tid; i < qb * 128; i += 512) kms[i] = KM[(size_t)bh * NBLK * HD + i];
        if (tid < 32) cnts[tid] = 0;
        __syncthreads();
        if (tid < 256) {
            const size_t qrow = (size_t)bh * L + (size_t)qb * 256 + tid;
            u32x4 qv[16];
#pragma unroll
            for (int i = 0; i < 16; ++i) qv[i] = ((const GAS u32x4*)(Qb + qrow * HD))[i];
            float v0 = -INFINITY, v1 = -INFINITY, v2 = -INFINITY; int i0 = -1, i1 = -1, i2 = -1;
#pragma unroll 1
            for (int n = 0; n < qb; ++n) {
                const LAS f32x4* kp = (const LAS f32x4*)(kms + n * 128);
                float g = 0.f;
#pragma unroll
                for (int i = 0; i < 16; ++i) { const f32x4 ka = kp[2 * i], kb2 = kp[2 * i + 1];
                    g += bf_lo(qv[i].x) * ka.x + bf_hi(qv[i].x) * ka.y + bf_lo(qv[i].y) * ka.z + bf_hi(qv[i].y) * ka.w
                       + bf_lo(qv[i].z) * kb2.x + bf_hi(qv[i].z) * kb2.y + bf_lo(qv[i].w) * kb2.z + bf_hi(qv[i].w) * kb2.w; }
                if (g > v0) { v2 = v1; i2 = i1; v1 = v0; i1 = i0; v0 = g; i0 = n; }
                else if (g > v1) { v2 = v1; i2 = i1; v1 = g; i1 = n; }
                else if (g > v2) { v2 = g; i2 = n; }
            }
            const int sel[3] = {i0, i1, i2};
#pragma unroll
            for (int s = 0; s < 3; ++s) {
                const int j = sel[s];
                if (j >= 0) { const int p = __hip_atomic_fetch_add(&cnts[j], 1, __ATOMIC_RELAXED, __HIP_MEMORY_SCOPE_WORKGROUP); LISTS[((size_t)(bh * NBLK + j) * NBLK + qb) * 256 + p] = (unsigned short)(tid | (s << 8)); }
                SELX[((size_t)(b * L + qb * 256 + tid) * NH + h) * 3 + s] = j;
            }
        }
        __syncthreads();
        if (tid < qb) { const int c = cnts[tid]; CNTS[(size_t)(bh * NBLK + tid) * NBLK + qb] = c; if (c) __hip_atomic_fetch_add(TOT + bh * NBLK + tid, (unsigned)c, __ATOMIC_RELAXED, __HIP_MEMORY_SCOPE_AGENT); }
        __syncthreads();
    }
}

__device__ __forceinline__ unsigned off_a(unsigned row, unsigned ch) { return 2048u * (row >> 3) + 512u * (ch >> 2) + 64u * (row & 7) + 16u * ((ch & 3) ^ ((row >> 2) & 3)); }
__device__ __forceinline__ unsigned elem_off_a(unsigned row, unsigned col) { return off_a(row, col >> 3) + (col & 7) * 2; }
__device__ __forceinline__ unsigned rowa_base(unsigned lane) { return off_a(lane & 15, lane >> 4); }
__device__ __forceinline__ unsigned tra_base(unsigned lane, unsigned t, unsigned codd) { const unsigned g = lane >> 4, q = (lane & 15) >> 2, p = lane & 3; return off_a(8 * g + 4 * t + q, 2 * codd + (p >> 1)) + 8 * (p & 1); }
constexpr int AL_K = 0, AL_V = 32768, AL_P = 65536, AL_BT = 131072, AL_TAB = 135168;
struct QRow { int qpos; int valid; };
__device__ __forceinline__ void att_stage(LAS unsigned char* lds, const bf16_t* Kg, const bf16_t* Vg, int c, int buf, int wave) {
    const int tid = threadIdx.x;
#pragma unroll
    for (int i = 0; i < 2; ++i) { const int e = tid + 512 * i, row = 8 * (e >> 7) + ((e >> 2) & 7), ch = 4 * ((e >> 5) & 3) + ((e & 3) ^ ((row >> 2) & 3));
        const size_t o = (size_t)c * 64 * HD + (size_t)row * HD + ch * 8;
        __builtin_amdgcn_global_load_lds((const unsigned*)(Kg + o), (LAS unsigned*)(lds + AL_K + buf * 16384 + wave * 1024 + i * 8192), 16, 0, 0);
        __builtin_amdgcn_global_load_lds((const unsigned*)(Vg + o), (LAS unsigned*)(lds + AL_V + buf * 16384 + wave * 1024 + i * 8192), 16, 0, 0); }
}
template <bool OWN>
__device__ __forceinline__ void att_tile(LAS unsigned char* lds, const bf16_t* Kg, const bf16_t* Vg, const bf16_t* const (&qptr)[2], const QRow (&qr)[2], const int (&xblk)[2], int kbase,
                                         f32x4 (&O)[8][2], float (&lsum)[2], int wave, int lane) {
    const int fr = lane & 15, fq = lane >> 4;
    const unsigned lds0 = (unsigned)(size_t)lds;
    LAS unsigned char* Pw = lds + AL_P + wave * 8192;
    const LAS float* bt = (const LAS float*)(lds + AL_BT);
    const unsigned kbase_a = rowa_base(lane);
    const unsigned trb[2][2] = {{tra_base(lane, 0, 0), tra_base(lane, 0, 1)}, {tra_base(lane, 1, 0), tra_base(lane, 1, 1)}};
    const unsigned pwb[2] = {elem_off_a(fr, 4 * fq), elem_off_a(fr, 16 + 4 * fq)};
    bf16x8 qf[2][4];
#pragma unroll
    for (int x = 0; x < 2; ++x)
#pragma unroll
        for (int ks = 0; ks < 4; ++ks) qf[x][ks] = *(const GAS bf16x8*)(qptr[x] + 32 * ks + 8 * fq);
#pragma unroll
    for (int db = 0; db < 8; ++db)
#pragma unroll
        for (int x = 0; x < 2; ++x) O[db][x] = (f32x4){0.f, 0.f, 0.f, 0.f};
    lsum[0] = 0.f; lsum[1] = 0.f;
    __syncthreads();
    att_stage(lds, Kg, Vg, 0, 0, wave);
    asm volatile("s_waitcnt vmcnt(0)" ::: "memory");
    __syncthreads();
    for (int c = 0; c < 4; ++c) {
        const int buf = c & 1;
        if (c < 3) att_stage(lds, Kg, Vg, c + 1, buf ^ 1, wave);
        if (!OWN || 64 * c <= 16 * xblk[1] + 15) {
#pragma unroll 2
            for (int kb = 0; kb < 4; ++kb) {
                bf16x8 ka[4];
#pragma unroll
                for (int ks = 0; ks < 4; ++ks) ka[ks] = *(const LAS bf16x8*)(lds + AL_K + buf * 16384 + kbase_a + 4096 * kb + 512 * ks);
                f32x4 s2[2];
#pragma unroll
                for (int x = 0; x < 2; ++x) { s2[x] = (f32x4){0.f, 0.f, 0.f, 0.f};
#pragma unroll
                    for (int ks = 0; ks < 4; ++ks) s2[x] = __builtin_amdgcn_mfma_f32_16x16x32_bf16(ka[ks], qf[x][ks], s2[x], 0, 0, 0); }
                const int key0 = kbase + 64 * c + 16 * kb + 4 * fq;
                float p[2][4], bv[2][4]; int dd[2][4];
#pragma unroll
                for (int x = 0; x < 2; ++x)
#pragma unroll
                    for (int r = 0; r < 4; ++r) { dd[x][r] = qr[x].qpos - (key0 + r); bv[x][r] = bt[dd[x][r] < 0 ? 0 : (dd[x][r] > 1023 ? 1023 : dd[x][r])]; }
#pragma unroll
                for (int x = 0; x < 2; ++x)
#pragma unroll
                    for (int r = 0; r < 4; ++r) { const float ev = __builtin_amdgcn_exp2f(s2[x][r] * ATT_C1 + bv[x][r]); p[x][r] = (qr[x].valid && dd[x][r] >= 0) ? ev : 0.f; lsum[x] += p[x][r]; }
#pragma unroll
                for (int x = 0; x < 2; ++x) { u32x2 o; o.x = cvt_pk_bf16(p[x][0], p[x][1]); o.y = cvt_pk_bf16(p[x][2], p[x][3]); *(LAS u32x2*)(Pw + pwb[kb & 1] + 4096 * x + 512 * (kb >> 1)) = o; }
            }
            bf16x8 pb[2][2];
#pragma unroll
            for (int x = 0; x < 2; ++x)
#pragma unroll
                for (int ks = 0; ks < 2; ++ks) pb[x][ks] = *(const LAS bf16x8*)(Pw + kbase_a + 4096 * x + 512 * ks);
            {
                bf16x4 vl[2][2], vh[2][2];
                const unsigned vbase = lds0 + AL_V + buf * 16384;
                TR_ISSUE(vl[0][0], vh[0][0], vbase + trb[0][0], vbase + trb[1][0]); TR_ISSUE(vl[0][1], vh[0][1], vbase + trb[0][0] + 8192, vbase + trb[1][0] + 8192);
#pragma unroll
                for (int db = 0; db < 8; ++db) {
                    const int cs = db & 1, ns = cs ^ 1;
                    if (db < 7) { const unsigned vb = vbase + 512 * ((db + 1) >> 1); const int o = (db + 1) & 1;
                        TR_ISSUE(vl[ns][0], vh[ns][0], vb + trb[0][o], vb + trb[1][o]); TR_ISSUE(vl[ns][1], vh[ns][1], vb + trb[0][o] + 8192, vb + trb[1][o] + 8192);
                        TR_WAIT2(4, vl[cs][0], vh[cs][0], vl[cs][1], vh[cs][1]); }
                    else TR_WAIT2(0, vl[cs][0], vh[cs][0], vl[cs][1], vh[cs][1]);
                    const bf16x8 vf0 = tr_join(vl[cs][0], vh[cs][0]), vf1 = tr_join(vl[cs][1], vh[cs][1]);
#pragma unroll
                    for (int x = 0; x < 2; ++x) { O[db][x] = __builtin_amdgcn_mfma_f32_16x16x32_bf16(vf0, pb[x][0], O[db][x], 0, 0, 0); O[db][x] = __builtin_amdgcn_mfma_f32_16x16x32_bf16(vf1, pb[x][1], O[db][x], 0, 0, 0); }
                }
            }
        }
        asm volatile("s_waitcnt vmcnt(0)" ::: "memory");
        __syncthreads();
    }
#pragma unroll
    for (int x = 0; x < 2; ++x) { lsum[x] += __shfl_xor(lsum[x], 16); lsum[x] += __shfl_xor(lsum[x], 32); }
}
__device__ __forceinline__ void att_load_bias(const Args& a, LAS unsigned char* lds, int h) {
    LAS float* bt = (LAS float*)(lds + AL_BT); LAS float* red = (LAS float*)(lds + AL_TAB + 8192);
    const int tid = threadIdx.x;
    float m = 0.f;
    if (tid < 128) m = fabsf(a.in[11][tid]);
    else if (tid < 256) m = fabsf(a.in[9][tid - 128]);
    else m = fabsf(a.in[13][tid - 256]);
#pragma unroll
    for (int o = 1; o < 64; o <<= 1) m = fmaxf(m, __shfl_xor(m, o));
    if ((tid & 63) == 0) red[tid >> 6] = m;
    __syncthreads();
    const float mq = fmaxf(red[0], red[1]), mk = fmaxf(red[2], red[3]), mb = fmaxf(fmaxf(red[4], red[5]), fmaxf(red[6], red[7]));
    const float M = 128.f * 0.08838834764831845f * mq * mk * 1.02f + mb;
    const float* bias_tab = (const float*)(a.ws + WS_SMALL) + 2048 + h * 1024;
    for (int i = tid; i < 1024; i += 512) bt[i] = (bias_tab[i] - M) * 1.4426950408889634f;
    __syncthreads();
}
__device__ __forceinline__ void att_selatt_phase(const Args& a, LAS unsigned char* lds, int wave, int lane) {
    const bf16_t* Kb = (const bf16_t*)(a.ws + WS_K2); const bf16_t* Vb = (const bf16_t*)(a.ws + WS_V2); const bf16_t* Qb = (const bf16_t*)(a.ws + WS_Q2);
    const unsigned short* LISTS = (const unsigned short*)(a.ws + WS_SEL); const int* CNTS = (const int*)(a.ws + WS_SELCNT); const unsigned* TOT = (const unsigned*)(a.ws + WS_CTL) + CW_TOT;
    bf16_t* OP = (bf16_t*)(a.ws + WS_OP); float* LP = (float*)(a.ws + WS_LP);
    LAS int* pfx = (LAS int*)(lds + AL_TAB);
    LAS int* segs = (LAS int*)(lds + AL_TAB + 4352);
    const int fr = lane & 15, fq = lane >> 4;
    if (wave == 0) {
        int loc[16]; int s = 0;
#pragma unroll
        for (int i = 0; i < 16; ++i) { const unsigned t = __hip_atomic_load(TOT + lane * 16 + i, __ATOMIC_RELAXED, __HIP_MEMORY_SCOPE_AGENT); loc[i] = s; s += (int)((t + 255u) >> 8); }
        int inc = s;
#pragma unroll
        for (int o = 1; o < 64; o <<= 1) { const int v = __shfl_up(inc, o); if (lane >= o) inc += v; }
        const int excl = inc - s;
#pragma unroll
        for (int i = 0; i < 16; ++i) pfx[lane * 16 + i] = excl + loc[i];
        if (lane == 63) pfx[1024] = inc;
    }
    __syncthreads();
    const int ntiles = pfx[1024];
    const int vcu = (gridDim.x % 8 == 0) ? (int)((blockIdx.x % 8) * (gridDim.x / 8) + blockIdx.x / 8) : (int)blockIdx.x;
    const int g0 = (int)(((long)vcu * ntiles) / gridDim.x), g1 = (int)(((long)(vcu + 1) * ntiles) / gridDim.x);
    if (g0 >= g1) return;
    const unsigned lds0 = (unsigned)(size_t)lds;
    LAS unsigned char* Pw = lds + AL_P + wave * 8192;
    LAS float* lsw = (LAS float*)(lds + AL_TAB + 12288 + wave * 512); LAS unsigned* riw = (LAS unsigned*)(lsw + 32);
    const LAS float* bt = (const LAS float*)(lds + AL_BT);
    const unsigned kbase_a = rowa_base(lane);
    const unsigned trb[2][2] = {{tra_base(lane, 0, 0), tra_base(lane, 0, 1)}, {tra_base(lane, 1, 0), tra_base(lane, 1, 1)}};
    const unsigned pwb[2] = {elem_off_a(fr, 4 * fq), elem_off_a(fr, 16 + 4 * fq)};
#define SA_LOOKUP(g, lid_, ti_) do { int lo_ = 0, hi_ = 1024; while (hi_ - lo_ > 1) { const int mid_ = (lo_ + hi_) >> 1; if (pfx[mid_] <= (g)) lo_ = mid_; else hi_ = mid_; } lid_ = lo_; ti_ = (g) - pfx[lo_]; } while (0)
#define SA_BUILD_SEG(lid_, sb_) do { if (wave == 0) { const int j_ = (lid_) & 31; int cq_ = 0; if (lane < NBLK) { const int v_ = CNTS[(size_t)(lid_) * NBLK + lane]; cq_ = lane > j_ ? v_ : 0; } int inc_ = cq_; \
        _Pragma("unroll") for (int o_ = 1; o_ < 32; o_ <<= 1) { const int v_ = __shfl_up(inc_, o_); if (lane >= o_) inc_ += v_; } \
        if (lane < NBLK) segs[(sb_) * 64 + lane] = inc_ - cq_; if (lane == NBLK - 1) segs[(sb_) * 64 + NBLK] = inc_; } } while (0)
#define SA_ROWMETA(lid_, ti_, sb_, m_) do { const LAS int* sg_ = segs + (sb_) * 64; const int tot_ = sg_[NBLK], j_ = (lid_) & 31; \
        _Pragma("unroll") for (int x_ = 0; x_ < 2; ++x_) { const int R_ = (ti_) * 256 + 32 * wave + 16 * x_ + fr; m_[x_] = 0u; \
            if (R_ < tot_) { int lo_ = j_ + 1, hi_ = NBLK; while (hi_ - lo_ > 1) { const int mid_ = (lo_ + hi_) >> 1; if (sg_[mid_] <= R_) lo_ = mid_; else hi_ = mid_; } \
                const unsigned e_ = LISTS[((size_t)(lid_) * NBLK + lo_) * 256 + (R_ - sg_[lo_])]; m_[x_] = 0x80000000u | ((e_ >> 8) << 16) | (unsigned)(lo_ * 256 + (int)(e_ & 255u)); } } } while (0)
#define SA_QLOAD(lid_, m_) do { _Pragma("unroll") for (int x_ = 0; x_ < 2; ++x_) { const bf16_t* qp2_ = Qb + ((size_t)((lid_) >> 5) * L + (m_[x_] & 0xffffu)) * HD + 8 * fq; \
        _Pragma("unroll") for (int ks_ = 0; ks_ < 4; ++ks_) qf[x_][ks_] = *(const GAS bf16x8*)(qp2_ + 32 * ks_); } } while (0)
    int lid, ti, sb = 0, cur_h;
    SA_LOOKUP(g0, lid, ti);
    cur_h = (lid >> 5) & 7;
    att_load_bias(a, lds, cur_h);
    SA_BUILD_SEG(lid, sb);
    __syncthreads();
    unsigned mt[2];
    LAS unsigned* nmw = riw + 32;
    SA_ROWMETA(lid, ti, sb, mt);
    bf16x8 qf[2][4];
    SA_QLOAD(lid, mt);
    att_stage(lds, Kb + ((size_t)(lid >> 5) * L + (lid & 31) * 256) * HD, Vb + ((size_t)(lid >> 5) * L + (lid & 31) * 256) * HD, 0, 0, wave);
    asm volatile("s_waitcnt vmcnt(0)" ::: "memory");
    __syncthreads();
    for (int g = g0; g < g1; ++g) {
        const bool has_next = g + 1 < g1;
        int nlid = lid, nti = ti + 1;
        if (has_next) SA_LOOKUP(g + 1, nlid, nti);
        const bool new_list = has_next && nlid != lid;
        const int nsb = new_list ? (sb ^ 1) : sb;
        const int bh = lid >> 5, j = lid & 31, kbase = j * 256;
        const bf16_t* Kg = Kb + ((size_t)bh * L + kbase) * HD; const bf16_t* Vg = Vb + ((size_t)bh * L + kbase) * HD;
        bool far; { const LAS int* sg_ = segs + sb * 64; int lo_ = j + 1, hi_ = NBLK; while (hi_ - lo_ > 1) { const int mid_ = (lo_ + hi_) >> 1; if (sg_[mid_] <= ti * 256) lo_ = mid_; else hi_ = mid_; } far = lo_ - j >= 5; }
        const float bconst = bt[1023];
        f32x4 O[8][2]; float lsum[2] = {0.f, 0.f};
#pragma unroll
        for (int db = 0; db < 8; ++db)
#pragma unroll
            for (int x = 0; x < 2; ++x) O[db][x] = (f32x4){0.f, 0.f, 0.f, 0.f};
#pragma unroll 1
        for (int c = 0; c < 4; ++c) {
            const int buf = c & 1;
            if (c < 3) att_stage(lds, Kg, Vg, c + 1, buf ^ 1, wave);
            else if (has_next) att_stage(lds, Kb + ((size_t)(nlid >> 5) * L + (nlid & 31) * 256) * HD, Vb + ((size_t)(nlid >> 5) * L + (nlid & 31) * 256) * HD, 0, 0, wave);
            if (c == 0 && new_list) SA_BUILD_SEG(nlid, nsb);
            if (c == 1 && has_next) { unsigned nm[2]; SA_ROWMETA(nlid, nti, nsb, nm); if (fq == 0) { nmw[fr] = nm[0]; nmw[16 + fr] = nm[1]; } }
#pragma unroll 2
            for (int kb = 0; kb < 4; ++kb) {
                bf16x8 ka[4];
#pragma unroll
                for (int ks = 0; ks < 4; ++ks) ka[ks] = *(const LAS bf16x8*)(lds + AL_K + buf * 16384 + kbase_a + 4096 * kb + 512 * ks);
                f32x4 s2[2];
#pragma unroll
                for (int x = 0; x < 2; ++x) { s2[x] = (f32x4){0.f, 0.f, 0.f, 0.f};
#pragma unroll
                    for (int ks = 0; ks < 4; ++ks) s2[x] = __builtin_amdgcn_mfma_f32_16x16x32_bf16(ka[ks], qf[x][ks], s2[x], 0, 0, 0); }
                float p[2][4];
                if (far) {
#pragma unroll
                    for (int x = 0; x < 2; ++x)
#pragma unroll
                        for (int r = 0; r < 4; ++r) { const float ev = __builtin_amdgcn_exp2f(s2[x][r] * ATT_C1 + bconst); p[x][r] = ((int)mt[x] < 0) ? ev : 0.f; lsum[x] += p[x][r]; }
                } else {
                    const int key0 = kbase + 64 * c + 16 * kb + 4 * fq;
                    float bv[2][4]; int dd[2][4];
#pragma unroll
                    for (int x = 0; x < 2; ++x)
#pragma unroll
                        for (int r = 0; r < 4; ++r) { dd[x][r] = (int)(mt[x] & 0xffffu) - (key0 + r); bv[x][r] = bt[dd[x][r] < 0 ? 0 : (dd[x][r] > 1023 ? 1023 : dd[x][r])]; }
#pragma unroll
                    for (int x = 0; x < 2; ++x)
#pragma unroll
                        for (int r = 0; r < 4; ++r) { const float ev = __builtin_amdgcn_exp2f(s2[x][r] * ATT_C1 + bv[x][r]); p[x][r] = ((int)mt[x] < 0 && dd[x][r] >= 0) ? ev : 0.f; lsum[x] += p[x][r]; }
                }
#pragma unroll
                for (int x = 0; x < 2; ++x) { u32x2 o; o.x = cvt_pk_bf16(p[x][0], p[x][1]); o.y = cvt_pk_bf16(p[x][2], p[x][3]); *(LAS u32x2*)(Pw + pwb[kb & 1] + 4096 * x + 512 * (kb >> 1)) = o; }
            }
            if (c == 3 && has_next) { unsigned nm[2] = {nmw[fr], nmw[16 + fr]}; SA_QLOAD(nlid, nm); }
            bf16x8 pb[2][2];
#pragma unroll
            for (int x = 0; x < 2; ++x)
#pragma unroll
                for (int ks = 0; ks < 2; ++ks) pb[x][ks] = *(const LAS bf16x8*)(Pw + kbase_a + 4096 * x + 512 * ks);
            {
                bf16x4 vl[2][2], vh[2][2];
                const unsigned vbase = lds0 + AL_V + buf * 16384;
                TR_ISSUE(vl[0][0], vh[0][0], vbase + trb[0][0], vbase + trb[1][0]); TR_ISSUE(vl[0][1], vh[0][1], vbase + trb[0][0] + 8192, vbase + trb[1][0] + 8192);
#pragma unroll
                for (int db = 0; db < 8; ++db) {
                    const int cs = db & 1, ns = cs ^ 1;
                    if (db < 7) { const unsigned vb = vbase + 512 * ((db + 1) >> 1); const int o = (db + 1) & 1;
                        TR_ISSUE(vl[ns][0], vh[ns][0], vb + trb[0][o], vb + trb[1][o]); TR_ISSUE(vl[ns][1], vh[ns][1], vb + trb[0][o] + 8192, vb + trb[1][o] + 8192);
                        TR_WAIT2(4, vl[cs][0], vh[cs][0], vl[cs][1], vh[cs][1]); }
                    else TR_WAIT2(0, vl[cs][0], vh[cs][0], vl[cs][1], vh[cs][1]);
                    const bf16x8 vf0 = tr_join(vl[cs][0], vh[cs][0]), vf1 = tr_join(vl[cs][1], vh[cs][1]);
#pragma unroll
                    for (int x = 0; x < 2; ++x) { O[db][x] = __builtin_amdgcn_mfma_f32_16x16x32_bf16(vf0, pb[x][0], O[db][x], 0, 0, 0); O[db][x] = __builtin_amdgcn_mfma_f32_16x16x32_bf16(vf1, pb[x][1], O[db][x], 0, 0, 0); }
                }
            }
            asm volatile("s_waitcnt vmcnt(0)" ::: "memory");
            __syncthreads();
        }
#pragma unroll
        for (int x = 0; x < 2; ++x) { lsum[x] += __shfl_xor(lsum[x], 16); lsum[x] += __shfl_xor(lsum[x], 32); }
#pragma unroll
        for (int x = 0; x < 2; ++x) {
#pragma unroll
            for (int db = 0; db < 8; ++db) { u32x2 o; o.x = pk2(O[db][x][0], O[db][x][1]); o.y = pk2(O[db][x][2], O[db][x][3]); *(LAS u32x2*)(Pw + elem_off(16 * x + fr, 16 * db + 4 * fq)) = o; }
            if (fq == 0) { lsw[16 * x + fr] = lsum[x]; riw[16 * x + fr] = mt[x]; }
        }
#pragma unroll
        for (int i = 0; i < 8; ++i) { const int row = 4 * i + fq, ch = fr;
            const unsigned ri = riw[row];
            if (ri & 0x80000000u) { const size_t ro = ((size_t)bh * L + (ri & 0xffffu)) * 3 + ((ri >> 16) & 3u);
                *(GAS u32x4*)(OP + ro * HD + ch * 8) = *(const LAS u32x4*)(Pw + off_b(row, ch));
                if (ch == 0) LP[ro] = lsw[row]; }
        }
        if (has_next) {
            const int nh = (nlid >> 5) & 7;
            if (nh != cur_h) { __syncthreads(); att_load_bias(a, lds, nh); cur_h = nh; }
            mt[0] = nmw[fr]; mt[1] = nmw[16 + fr];
            lid = nlid; ti = nti; sb = nsb;
        }
    }
#undef SA_LOOKUP
#undef SA_BUILD_SEG
#undef SA_ROWMETA
#undef SA_QLOAD
}
__device__ __forceinline__ void att_own_phase(const Args& a, LAS unsigned char* lds, int rep, int var, int wave, int lane) {
    const bf16_t* Kb = (const bf16_t*)(a.ws + WS_K2); const bf16_t* Vb = (const bf16_t*)(a.ws + WS_V2); const bf16_t* Qb = (const bf16_t*)(a.ws + WS_Q2);
    const bf16_t* OP = (const bf16_t*)(a.ws + WS_OP); const float* LP = (const float*)(a.ws + WS_LP); bf16_t* ATT = (bf16_t*)(a.ws + (rep ? WS_DUMMY : WS_ATT));
    const int fr = lane & 15, fq = lane >> 4;
    int cur_h = -1;
    for (int item = blockIdx.x; item < B * NH * NBLK; item += gridDim.x) {
        const int bh = item >> 5, qb = item & 31, b = bh >> 3, h = bh & 7;
        __syncthreads();
        if (h != cur_h) { att_load_bias(a, lds, h); cur_h = h; }
        const bf16_t* qptr[2]; QRow qr[2]; int xblk[2] = {wave, 15 - wave};
#pragma unroll
        for (int x = 0; x < 2; ++x) { qr[x].valid = 1; qr[x].qpos = qb * 256 + 16 * xblk[x] + fr; qptr[x] = Qb + ((size_t)bh * L + qr[x].qpos) * HD; }
        f32x4 O[8][2]; float lsum[2];
        att_tile<true>(lds, Kb + ((size_t)bh * L + qb * 256) * HD, Vb + ((size_t)bh * L + qb * 256) * HD, qptr, qr, xblk, qb * 256, O, lsum, wave, lane);
        const int nsel = qb < 3 ? qb : 3;
        LAS unsigned char* Pw = lds + AL_P + wave * 8192; LAS float* lsw = (LAS float*)(lds + AL_TAB + 12288 + wave * 256);
#pragma unroll
        for (int x = 0; x < 2; ++x) {
#pragma unroll
            for (int db = 0; db < 8; ++db) { u32x2 o; o.x = pk2(O[db][x][0], O[db][x][1]); o.y = pk2(O[db][x][2], O[db][x][3]); *(LAS u32x2*)(Pw + elem_off(16 * x + fr, 16 * db + 4 * fq)) = o; }
            if (fq == 0) lsw[16 * x + fr] = lsum[x];
        }
#pragma unroll 1
        for (int i = 0; i < 8; ++i) { const int row = 4 * i + fq, ch = fr, qpos = qb * 256 + 16 * (row < 16 ? wave : 15 - wave) + (row & 15);
            const size_t ro = ((size_t)bh * L + qpos) * 3;
            u32x4 pv[3]; float lp[3];
#pragma unroll
            for (int s = 0; s < 3; ++s) { pv[s] = (u32x4){0u, 0u, 0u, 0u}; lp[s] = 0.f; if (s < nsel) { pv[s] = *(const GAS u32x4*)(OP + (ro + s) * HD + ch * 8); lp[s] = LP[ro + s]; } }
            const u32x4 ov = *(const LAS u32x4*)(Pw + off_b(row, ch));
            const float inv = __builtin_amdgcn_rcpf(lsw[row] + lp[0] + lp[1] + lp[2]);
            const unsigned o0 = ov.x, o1 = ov.y, o2 = ov.z, o3 = ov.w;
            float f[8] = {bf_lo(o0), bf_hi(o0), bf_lo(o1), bf_hi(o1), bf_lo(o2), bf_hi(o2), bf_lo(o3), bf_hi(o3)};
#pragma unroll
            for (int s = 0; s < 3; ++s) { const unsigned p0 = pv[s].x, p1 = pv[s].y, p2 = pv[s].z, p3 = pv[s].w;
                f[0] += bf_lo(p0); f[1] += bf_hi(p0); f[2] += bf_lo(p1); f[3] += bf_hi(p1); f[4] += bf_lo(p2); f[5] += bf_hi(p2); f[6] += bf_lo(p3); f[7] += bf_hi(p3); }
            u32x4 w; w.x = pk2(f[0] * inv, f[1] * inv); w.y = pk2(f[2] * inv, f[3] * inv); w.z = pk2(f[4] * inv, f[5] * inv); w.w = pk2(f[6] * inv, f[7] * inv);
            *(GAS u32x4*)(ATT + ((size_t)b * L + qpos) * D + h * HD + ch * 8) = w;
        }
    }
}
enum Phase { PH_PROLOGUE = 0, PH_INPROJ, PH_GLA_A, PH_GLA_SCAN, PH_GLA_C, PH_OUTPROJ, PH_END_S1,
             PH_M0_ROUTE = PH_END_S1, PH_M0_G1, PH_M0_G2, PH_M0_COMB, PH_END_S2,
             PH_A_NORM = PH_END_S2, PH_A_KVQ, PH_A_POST, PH_A_SEL, PH_A_SELATT, PH_A_OWN, PH_A_OPROJ, PH_END_S3,
             PH_M1_ROUTE = PH_END_S3, PH_M1_G1, PH_M1_G2, PH_M1_COMB, PH_END_S4,
             PH_COUNT = PH_END_S4 };
#ifndef DUP_MASK
#define DUP_MASK 0ull
#endif
#ifndef TVAR
#define TVAR 0
#endif
#define REPS(k) ((((DUP_MASK) >> (k)) & 1ull) ? a.rep2 : 1)
#define PHASE(k) if (IN(k)) for (int rep = 0; rep < REPS(k); ++rep)
#ifndef ROUTE_FN
#define ROUTE_FN moe_route_phase
#endif
#define REPBAR() do { if (rep) xcd_barrier(bar); } while (0)
#define MOE_PHASES(base, layer) \
    PHASE(base) { REPBAR(); ROUTE_FN(a, lds, layer, (layer) + 2 * rep, a.xin, wave, lane); } \
    SEAM(base); \
    PHASE((base) + 1) { REPBAR(); moe_tables(a, lds, layer); MoeOrder1 S; S.tst = (const LAS int*)(lds + LDS_MOE_TAB); S.cn = S.tst + 64; S.list = (const u32x4*)(ws + WS_LIST); \
        S.A = (const bf16_t*)(ws + WS_XN); S.Bt = (const bf16_t*)(ws + WS_MWIN) + (size_t)(layer) * NEXP * 1024 * 1024; S.K = D; S.bstride = (size_t)1024 * 1024 * 2; S.G = gridDim.x; S.c = vcu; S.ntot = S.tst[NEXP]; \
        EpiAct E{(bf16_t*)(ws + WS_ACT), (const u32x4*)(ws + WS_LIST), S.cn}; gemm_phase<EpiAct, MoeOrder1>(lds, S, E); } \
    SEAM((base) + 1); \
    PHASE((base) + 2) { REPBAR(); moe_tables(a, lds, layer); MoeOrder2 S; S.tst = (const LAS int*)(lds + LDS_MOE_TAB); S.cn = S.tst + 64; S.list = (const u32x4*)(ws + WS_LIST); \
        S.A = (const bf16_t*)(ws + WS_ACT); S.Bt = (const bf16_t*)(ws + WS_MWOUT) + (size_t)(layer) * NEXP * 1024 * 512; S.K = FF; S.bstride = (size_t)1024 * 512 * 2; S.G = gridDim.x; S.c = vcu; S.ntot = S.tst[NEXP]; \
        EpiY E{(bf16_t*)(ws + WS_YB), (const u32x4*)(ws + WS_LIST), S.cn}; gemm_phase<EpiY, MoeOrder2>(lds, S, E); } \
    SEAM((base) + 2); \
    PHASE((base) + 3) { REPBAR(); moe_combine_phase<(layer) == 0>(a, a.xin, rep ? (float*)(ws + WS_DUMMY) : a.out, wave, lane); }

__global__ void __launch_bounds__(512, 2) fwd(Args a) {
    extern __shared__ __attribute__((aligned(16))) unsigned char smem[];
    LAS unsigned char* lds = (LAS unsigned char*)smem;
    const int tid = threadIdx.x, lane = tid & 63, wave = __builtin_amdgcn_readfirstlane(tid >> 6);
    volatile LAS unsigned* MISC = (volatile LAS unsigned*)(lds + LDS_MISC);
    if (tid < 4) MISC[tid] = 0u;
    __syncthreads();
    unsigned* ctl = (unsigned*)(a.ws + WS_CTL);
    XcdBarrier bar = xcd_barrier_post(ctl + CW_BAR, MISC);
    const int lo = a.ph_lo, hi = a.ph_hi;
    unsigned char* ws = a.ws;
    const int vcu = (gridDim.x % 8 == 0) ? (int)((blockIdx.x % 8) * (gridDim.x / 8) + blockIdx.x / 8) : (int)blockIdx.x;
#ifndef ENABLE_MASK
#define ENABLE_MASK (~0ull)
#endif
#define IN(k) ((((ENABLE_MASK) >> (k)) & 1ull) && lo <= (k) && (k) < hi)
#define SEAM(k) do { if (IN(k) && IN((k) + 1)) xcd_barrier(bar); } while (0)
    PHASE(PH_PROLOGUE) { REPBAR(); p0_prologue(a, lds, wave, lane); }
    SEAM(PH_PROLOGUE);
    PHASE(PH_INPROJ) { REPBAR();
        DenseOrder S; S.init((const bf16_t*)(ws + WS_XN), (const bf16_t*)(ws + WS_WIN), T, 4096, D, gridDim.x, blockIdx.x);
        EpiHG E{(bf16_t*)(ws + WS_Q), (const float*)(ws + WS_SMALL)};
        gemm_phase<EpiHG, DenseOrder>(lds, S, E);
    }
    SEAM(PH_INPROJ);
    PHASE(PH_GLA_A) { REPBAR(); gla_phase<0>(a, lds, wave, lane); }
    SEAM(PH_GLA_A);
    if (IN(PH_GLA_SCAN)) gla_scan(a);
    SEAM(PH_GLA_SCAN);
    PHASE(PH_GLA_C) { REPBAR(); gla_phase<1>(a, lds, wave, lane); }
    SEAM(PH_GLA_C);
    PHASE(PH_OUTPROJ) { REPBAR();
        DenseOrder S; S.init((const bf16_t*)(ws + WS_OG), (const bf16_t*)(ws + WS_WOUT), T, D, D, gridDim.x, blockIdx.x);
        EpiRes E{a.out, a.in[0], D};
        gemm_phase<EpiRes, DenseOrder>(lds, S, E);
    }
    SEAM(PH_OUTPROJ);
    MOE_PHASES(PH_M0_ROUTE, 0)
    SEAM(PH_M0_COMB);
    if (IN(PH_A_NORM) && !IN(PH_M0_COMB)) att_norm_phase(a, wave, lane);
    if (IN(PH_A_NORM) && !IN(PH_M0_COMB)) SEAM(PH_A_NORM);
    PHASE(PH_A_KVQ) { REPBAR();
        DenseOrder S; S.init((const bf16_t*)(ws + WS_XN), (const bf16_t*)(ws + WS_WKVQ), T, 3072, D, gridDim.x, blockIdx.x);
        EpiKVQ E{(bf16_t*)(ws + WS_K2), a.in[9], a.in[11], (float*)(ws + WS_KM), lds};
        gemm_phase<EpiKVQ, DenseOrder>(lds, S, E);
    }
    SEAM(PH_A_KVQ);
    PHASE(PH_A_SEL) { REPBAR(); att_sel_phase(a, lds, rep, wave, lane); }
    SEAM(PH_A_SEL);
    PHASE(PH_A_SELATT) { REPBAR(); att_selatt_phase(a, lds, wave, lane); }
    SEAM(PH_A_SELATT);
    PHASE(PH_A_OWN) { REPBAR(); att_own_phase(a, lds, rep, rep ? TVAR : 0, wave, lane); }
    SEAM(PH_A_OWN);
    PHASE(PH_A_OPROJ) { REPBAR();
        DenseOrder S; S.init((const bf16_t*)(ws + WS_ATT), (const bf16_t*)(ws + WS_WO), T, D, D, gridDim.x, blockIdx.x);
        EpiRes E{rep ? (float*)(ws + WS_DUMMY) : a.out, a.xin, D};
        gemm_phase<EpiRes, DenseOrder>(lds, S, E);
    }
    SEAM(PH_A_OPROJ);
    MOE_PHASES(PH_M1_ROUTE, 1)
#undef IN
#undef SEAM
}
}

static int g_grid = 0;
static void fast_launch(void* const* d_in, const float* xin, float* d_out, void* d_ws, hipStream_t stream, int lo, int hi, bool per_phase) {
    if (g_grid == 0) {
        int dev = 0, cus = 0;
        if (hipGetDevice(&dev) != hipSuccess || hipDeviceGetAttribute(&cus, hipDeviceAttributeMultiprocessorCount, dev) != hipSuccess) { fprintf(stderr, "kernel_launch: device query failed\n"); g_grid = -1; return; }
        if (hipFuncSetAttribute((const void*)fk::fwd, hipFuncAttributeMaxDynamicSharedMemorySize, fk::LDS_BYTES) != hipSuccess) { fprintf(stderr, "kernel_launch: hipFuncSetAttribute failed\n"); g_grid = -1; return; }
        int per_cu = 0;
        if (hipOccupancyMaxActiveBlocksPerMultiprocessor(&per_cu, (const void*)fk::fwd, 512, fk::LDS_BYTES) != hipSuccess || per_cu < 1) fprintf(stderr, "kernel_launch: occupancy query says %d\n", per_cu);
        (void)hipGetLastError();
        g_grid = cus;
    }
    if (g_grid < 0) return;
    fk::Args a{};
    for (int i = 0; i < 20; ++i) a.in[i] = (const float*)d_in[i];
    a.out = d_out; a.xin = xin; a.ws = (unsigned char*)d_ws; a.rep2 = 2;
    (void)hipMemsetAsync((char*)d_ws + fk::WS_CTL, 0, fk::CTL_ZERO_BYTES, stream);
    if (per_phase) {
        for (int p = lo; p < hi; ++p) { a.ph_lo = p; a.ph_hi = p + 1; hipLaunchKernelGGL(fk::fwd, dim3(g_grid), dim3(512), fk::LDS_BYTES, stream, a); }
    } else {
        a.ph_lo = lo; a.ph_hi = hi;
        hipLaunchKernelGGL(fk::fwd, dim3(g_grid), dim3(512), fk::LDS_BYTES, stream, a);
    }
    const hipError_t le = hipPeekAtLastError();
    if (le != hipSuccess) fprintf(stderr, "kernel_launch: launch failed: %s\n", hipGetErrorName(le));
}


extern "C" void kernel_launch(void* const* d_in, const int* in_sizes, int n_in, void* d_out, int out_size, void* d_ws, size_t ws_size, hipStream_t stream) {
    if (n_in != 20 || out_size != fk::T * fk::D || ws_size < fk::WS_END) { fprintf(stderr, "kernel_launch: unexpected shapes n_in %d out %d ws %zu\n", n_in, out_size, ws_size); return; }
    float* X = (float*)d_out; unsigned char* ws = (unsigned char*)d_ws;
    const size_t N = (size_t)fk::T * fk::D;
#if DBG_STAGE == 0
    fast_launch(d_in, X, X, d_ws, stream, fk::PH_PROLOGUE, fk::PH_END_S4, HYB_PER_PHASE);
#else
    float* TMP = (float*)(ws + 800 * fk::MiB); unsigned short* FB = (unsigned short*)(ws + 928 * fk::MiB); double* ACC = (double*)(ws + 1000 * fk::MiB);
    (void)hipMemsetAsync(ACC, 0, 64, stream);
#if DBG_STAGE == 1
    fast_launch(d_in, X, TMP, d_ws, stream, fk::PH_PROLOGUE, fk::PH_END_S1, HYB_PER_PHASE);
    hipLaunchKernelGGL(dbg::k_store, dim3(4096), dim3(256), 0, stream, (const float*)TMP, (const float*)d_in[0], FB, N);
    slow::stage1(d_in, X, ws, stream);
    hipLaunchKernelGGL(dbg::k_cmp, dim3(4096), dim3(256), 0, stream, (const unsigned short*)FB, (const float*)X, (const float*)d_in[0], 0, ACC, N);
    slow::stage_moe(d_in, X, ws, stream, 0);
    slow::stage3(d_in, X, ws, stream);
    slow::stage_moe(d_in, X, ws, stream, 1);
#elif DBG_STAGE == 2
    slow::stage1(d_in, X, ws, stream);
    fast_launch(d_in, X, TMP, d_ws, stream, fk::PH_PROLOGUE, fk::PH_PROLOGUE + 1, HYB_PER_PHASE);
    fast_launch(d_in, X, TMP, d_ws, stream, fk::PH_M0_ROUTE, fk::PH_END_S2, HYB_PER_PHASE);
    hipLaunchKernelGGL(dbg::k_store, dim3(4096), dim3(256), 0, stream, (const float*)TMP, (const float*)X, FB, N);
    slow::stage_moe(d_in, X, ws, stream, 0);
    hipLaunchKernelGGL(dbg::k_cmp, dim3(4096), dim3(256), 0, stream, (const unsigned short*)FB, (const float*)(ws + 672 * fk::MiB), (const float*)nullptr, 1, ACC, N);
    slow::stage3(d_in, X, ws, stream);
    slow::stage_moe(d_in, X, ws, stream, 1);
#elif DBG_STAGE == 3
    slow::stage1(d_in, X, ws, stream);
    slow::stage_moe(d_in, X, ws, stream, 0);
    fast_launch(d_in, X, TMP, d_ws, stream, fk::PH_PROLOGUE, fk::PH_PROLOGUE + 1, HYB_PER_PHASE);
    fast_launch(d_in, X, TMP, d_ws, stream, fk::PH_A_NORM, fk::PH_END_S3, HYB_PER_PHASE);
    hipLaunchKernelGGL(dbg::k_store, dim3(4096), dim3(256), 0, stream, (const float*)TMP, (const float*)X, FB, N);
    slow::stage3(d_in, X, ws, stream, (const int*)(ws + fk::WS_SELX), (float*)(ws + 672 * fk::MiB));
    hipLaunchKernelGGL(dbg::k_cmp, dim3(4096), dim3(256), 0, stream, (const unsigned short*)FB, (const float*)(ws + 672 * fk::MiB), (const float*)nullptr, 2, ACC, N);
    slow::stage_moe(d_in, X, ws, stream, 1);
#endif
    hipLaunchKernelGGL(dbg::k_scale, dim3(4096), dim3(256), 0, stream, X, (const double*)ACC, N);
#endif
}
```
